# Optimizing an MI355X kernel written in HIP

```python
import math
import jax, jax.numpy as jnp
from jax import lax
import numpy as np

D_MODEL = 1024
BATCH = 8
SEQ = 8192
DEPTH = 2

RMS_EPS = 1e-6
N_MIX_GROUPS = 4
GROUP_W = D_MODEL // N_MIX_GROUPS
D_MIX = N_MIX_GROUPS * GROUP_W

HGRN_HEADS = 4
HGRN_DK = GROUP_W // HGRN_HEADS
HGRN_DV = GROUP_W // HGRN_HEADS
HGRN_CHUNK = 64

S5_CH = 16
S5_GROUPS = GROUP_W // S5_CH
S5_STATE = 64
S5_DT_MIN = 1e-3
S5_DT_MAX = 1e-1

RWKV_HS = 64
RWKV_HEADS = GROUP_W // RWKV_HS
RWKV_W_LORA = 64
RWKV_A_LORA = 64
RWKV_V_LORA = 32
RWKV_G_LORA = 128
RWKV_GN_EPS = 64e-5
RWKV_SIZES = (GROUP_W, GROUP_W, GROUP_W, RWKV_W_LORA, RWKV_A_LORA, RWKV_G_LORA)
RWKV_COLS = 3 * GROUP_W + RWKV_W_LORA + RWKV_A_LORA + RWKV_G_LORA

LRU_HEADS = 4
LRU_HD = GROUP_W // LRU_HEADS
LRU_CONV = 4
LRU_C = 8.0

MOE_GROUPS = 4
MOE_PER_GROUP = 8
N_EXPERTS = MOE_GROUPS * MOE_PER_GROUP
MOE_TOPK = 2
D_EXPERT = 512

COL_SIZES = (GROUP_W, GROUP_W, GROUP_W, GROUP_W, GROUP_W, RWKV_COLS, GROUP_W, GROUP_W)
D_IN = 7 * GROUP_W + RWKV_COLS

kernel_name = "hybrid_parallel_heads_hier_moe"


def _splits(sizes):
    return np.cumsum(np.array(sizes))[:-1].tolist()


def rms_norm(x, w, eps=RMS_EPS):
    xf = x.astype(jnp.float32)
    y = xf * lax.rsqrt(jnp.mean(xf * xf, axis=-1, keepdims=True) + eps)
    return (y * w.astype(jnp.float32)).astype(x.dtype)


def _shift(p):
    return jnp.pad(p, ((0, 0), (1, 0), (0, 0)))[:, :-1]


def hgrn2_mixer(q_raw, f_raw, i_raw, g_raw, lb, norm_w):
    f32 = jnp.float32
    B, T, _ = q_raw.shape
    n_chunks = T // HGRN_CHUNK
    q = jax.nn.silu(q_raw.astype(f32))
    fx = f_raw.astype(f32)
    log_f = jnp.logaddexp(jnp.log(lb), jnp.log1p(-lb) + jax.nn.log_sigmoid(fx))
    k = (1.0 - lb) * jax.nn.sigmoid(-fx)
    v = jax.nn.silu(i_raw.astype(f32))

    def to_chunks(t, d):
        return t.reshape(B, n_chunks, HGRN_CHUNK, HGRN_HEADS, d).transpose(1, 0, 3, 2, 4)

    tri = jnp.tril(jnp.ones((HGRN_CHUNK, HGRN_CHUNK), dtype=bool))

    def chunk_step(S, inp):
        qc, lfc, kc, vc = inp
        b = jnp.cumsum(lfc, axis=2)
        rel = b[:, :, :, None, :] - b[:, :, None, :, :]
        decay = jnp.exp(jnp.where(tri[:, :, None], rel, -jnp.inf))
        scores = jnp.einsum('bhtk,bhsk,bhtsk->bhts', qc, kc, decay)
        o = (jnp.einsum('bhts,bhsv->bhtv', scores, vc)
             + jnp.einsum('bhtk,bhkv->bhtv', qc * jnp.exp(b), S))
        b_end = b[:, :, -1:, :]
        S = (jnp.exp(b_end[:, :, 0, :])[..., None] * S
             + jnp.einsum('bhsk,bhsv->bhkv', kc * jnp.exp(b_end - b), vc))
        return S, o

    S0 = jnp.zeros((B, HGRN_HEADS, HGRN_DK, HGRN_DV), f32)
    _, o = lax.scan(chunk_step, S0, (to_chunks(q, HGRN_DK), to_chunks(log_f, HGRN_DK),
                                     to_chunks(k, HGRN_DK), to_chunks(v, HGRN_DV)))
    o = o.transpose(1, 0, 3, 2, 4).reshape(B, T, HGRN_HEADS, HGRN_DV)
    o = o * lax.rsqrt(jnp.mean(o * o, axis=-1, keepdims=True) + RMS_EPS)
    o = o * norm_w.astype(f32).reshape(HGRN_HEADS, HGRN_DV)
    o = o.reshape(B, T, GROUP_W) * jax.nn.silu(g_raw.astype(f32))
    return o.astype(q_raw.dtype)


def s5_mixer(u, lam_re, lam_im, log_dt, b_re, b_im, c_re, c_im, d_skip, w_glu):
    f32 = jnp.float32
    B, T, _ = u.shape
    uf = u.astype(f32)
    ug = uf.reshape(B, T, S5_GROUPS, S5_CH)
    lr, li = lam_re.astype(f32), lam_im.astype(f32)
    dt = jnp.exp(log_dt.astype(f32))[:, None]
    mag = jnp.exp(lr * dt)
    a_re, a_im = mag * jnp.cos(li * dt), mag * jnp.sin(li * dt)
    den = lr * lr + li * li
    kap_re = ((a_re - 1.0) * lr + a_im * li) / den
    kap_im = (a_im * lr - (a_re - 1.0) * li) / den
    br, bi = b_re.astype(f32), b_im.astype(f32)
    bb_re = kap_re[..., None] * br - kap_im[..., None] * bi
    bb_im = kap_re[..., None] * bi + kap_im[..., None] * br
    bu_re = jnp.einsum('btgc,gpc->tbgp', ug, bb_re)
    bu_im = jnp.einsum('btgc,gpc->tbgp', ug, bb_im)
    a_re_t = jnp.broadcast_to(a_re, (T, 1, S5_GROUPS, S5_STATE))
    a_im_t = jnp.broadcast_to(a_im, (T, 1, S5_GROUPS, S5_STATE))

    def combine(e1, e2):
        a1r, a1i, b1r, b1i = e1
        a2r, a2i, b2r, b2i = e2
        return (a2r * a1r - a2i * a1i, a2r * a1i + a2i * a1r,
                a2r * b1r - a2i * b1i + b2r, a2r * b1i + a2i * b1r + b2i)

    _, _, x_re, x_im = lax.associative_scan(combine, (a_re_t, a_im_t, bu_re, bu_im), axis=0)
    y = (jnp.einsum('tbgp,gcp->btgc', x_re, c_re.astype(f32))
         - jnp.einsum('tbgp,gcp->btgc', x_im, c_im.astype(f32))).reshape(B, T, GROUP_W)
    y = jax.nn.gelu(y + d_skip * uf)
    za, zb = jnp.split(y @ w_glu.astype(f32), 2, axis=-1)
    return (za * jax.nn.sigmoid(zb)).astype(u.dtype)


def rwkv7_mixer(p, mu, w0, w2, a0, a2, g2, k_k, k_a, r_k, ln_w, ln_b, v_first, v_mix):
    f32 = jnp.float32
    B, T, _ = p.shape
    pf = p.astype(f32)
    pf = pf + mu * (_shift(pf) - pf)
    r, k, v, wd, ad, gd = jnp.split(pf, _splits(RWKV_SIZES), axis=-1)
    w = -jax.nn.softplus(-(w0 + jnp.tanh(wd) @ w2)) - 0.5
    decay = jnp.exp(-jnp.exp(w))
    a = jax.nn.sigmoid(a0 + ad @ a2)
    g = jax.nn.sigmoid(gd) @ g2

    def heads(t):
        return t.reshape(B, T, RWKV_HEADS, RWKV_HS)

    kk = heads(k * k_k)
    kk = kk / jnp.maximum(jnp.sqrt(jnp.sum(kk * kk, axis=-1, keepdims=True)), 1e-12)
    k = k * (1.0 + (a - 1.0) * k_a)
    if v_mix is None:
        v_first = v
    else:
        v0, v1, v2 = v_mix
        v = v + (v_first - v) * jax.nn.sigmoid(v0 + (v @ v1) @ v2)
    rh, kh, vh = heads(r), heads(k), heads(v)
    bh = kk * heads(a)

    def tm(t):
        return t.transpose(1, 0, 2, 3)

    def step(S, inp):
        r_t, w_t, k_t, v_t, kk_t, b_t = inp
        sa = jnp.einsum('bhvk,bhk->bhv', S, -kk_t)
        S = (S * w_t[:, :, None, :] + sa[..., None] * b_t[:, :, None, :]
             + v_t[..., None] * k_t[:, :, None, :])
        return S, jnp.einsum('bhvk,bhk->bhv', S, r_t)

    S0 = jnp.zeros((B, RWKV_HEADS, RWKV_HS, RWKV_HS), f32)
    _, y = lax.scan(step, S0, (tm(rh), tm(heads(decay)), tm(kh), tm(vh), tm(kk), tm(bh)))
    y = y.transpose(1, 0, 2, 3)
    mean = jnp.mean(y, axis=-1, keepdims=True)
    var = jnp.mean((y - mean) ** 2, axis=-1, keepdims=True)
    y = ((y - mean) * lax.rsqrt(var + RWKV_GN_EPS) * ln_w.reshape(RWKV_HEADS, RWKV_HS)
         + ln_b.reshape(RWKV_HEADS, RWKV_HS))
    y = y + jnp.sum(rh * kh * r_k.reshape(RWKV_HEADS, RWKV_HS), axis=-1, keepdims=True) * vh
    out = y.reshape(B, T, GROUP_W) * g
    return out.astype(p.dtype), v_first


def rglru_mixer(xg, xr, conv_w, conv_b, wa, ba, wx, bx, lam):
    f32 = jnp.float32
    B, T, _ = xr.shape
    xc = lax.conv_general_dilated(xr.astype(f32), conv_w.astype(f32)[:, None, :], window_strides=(1,),
                                  padding=[(LRU_CONV - 1, 0)], dimension_numbers=('NWC', 'WIO', 'NWC'),
                                  feature_group_count=GROUP_W) + conv_b
    xh = xc.reshape(B, T, LRU_HEADS, LRU_HD)
    r = jax.nn.sigmoid(jnp.einsum('bthi,hij->bthj', xh, wa).reshape(B, T, GROUP_W) + ba)
    gi = jax.nn.sigmoid(jnp.einsum('bthi,hij->bthj', xh, wx).reshape(B, T, GROUP_W) + bx)
    log_a = -LRU_C * r * jax.nn.softplus(-lam)
    u = jnp.sqrt(-jnp.expm1(2.0 * log_a)) * (gi * xc)

    def combine(e1, e2):
        a1, b1 = e1
        a2, b2 = e2
        return (a1 * a2, a2 * b1 + b2)

    _, h = lax.associative_scan(combine, (jnp.exp(log_a), u), axis=1)
    return (jax.nn.gelu(xg.astype(f32)) * h).astype(xg.dtype)


def hier_moe(h, coarse_w, coarse_b, fine_w, fine_b, w_gate, w_up, w_down):
    B, T, D = h.shape
    xt = h.reshape(B * T, D)
    coarse = (xt @ coarse_w + coarse_b).astype(jnp.float32)
    p_coarse = jax.nn.softmax(coarse, axis=-1)
    gsel = jnp.argmax(coarse, axis=-1)
    g_onehot = jax.nn.one_hot(gsel, MOE_GROUPS, dtype=jnp.float32)
    p_g = jnp.sum(p_coarse * g_onehot, axis=-1, keepdims=True)
    fine = (jnp.einsum('nd,gde->nge', xt, fine_w) + fine_b).astype(jnp.float32)
    fine_sel = jnp.einsum('ng,nge->ne', g_onehot, fine)
    top_v, top_i = lax.top_k(fine_sel, MOE_TOPK)
    w_top = p_g * jax.nn.softmax(top_v, axis=-1)
    expert_ids = gsel[:, None] * MOE_PER_GROUP + top_i
    combine = jnp.einsum('nk,nke->ne', w_top,
                         jax.nn.one_hot(expert_ids, N_EXPERTS, dtype=jnp.float32)).astype(xt.dtype)
    y = jnp.zeros_like(xt)
    for e in range(N_EXPERTS):
        he = jax.nn.silu(xt @ w_gate[e]) * (xt @ w_up[e])
        y = y + combine[:, e:e + 1] * (he @ w_down[e])
    return y.reshape(B, T, D)


def setup_inputs(seed: int = 0) -> dict:
    key = jax.random.key(seed)
    ks = iter(jax.random.split(key, 64))
    L, D, G = DEPTH, D_MODEL, GROUP_W

    def nrm(shape, scale):
        return scale * jax.random.normal(next(ks), shape, jnp.float32)

    def gain(shape):
        return 1.0 + nrm(shape, 0.02)

    def unif(shape, lo, hi):
        return jax.random.uniform(next(ks), shape, jnp.float32, minval=lo, maxval=hi)

    inputs = {
        "x": nrm((BATCH, SEQ, D), 1.0),
        "norm1_w": gain((L, D)),
        "w_in": nrm((L, D, D_IN), D ** -0.5),
        "hgrn_lb_logits": nrm((L, G), 0.5),
        "hgrn_norm_w": gain((L, G)),
        "s5_lambda_re": -0.5 + nrm((L, S5_GROUPS, S5_STATE), 0.01),
        "s5_lambda_im": jnp.pi * jnp.arange(S5_STATE, dtype=jnp.float32) + nrm((L, S5_GROUPS, S5_STATE), 0.01),
        "s5_log_dt": unif((L, S5_GROUPS), math.log(S5_DT_MIN), math.log(S5_DT_MAX)),
        "s5_b_re": nrm((L, S5_GROUPS, S5_STATE, S5_CH), (2 * S5_CH) ** -0.5),
        "s5_b_im": nrm((L, S5_GROUPS, S5_STATE, S5_CH), (2 * S5_CH) ** -0.5),
        "s5_c_re": nrm((L, S5_GROUPS, S5_CH, S5_STATE), S5_STATE ** -0.5),
        "s5_c_im": nrm((L, S5_GROUPS, S5_CH, S5_STATE), S5_STATE ** -0.5),
        "s5_d": nrm((L, G), 1.0),
        "s5_w_glu": nrm((L, G, 2 * G), G ** -0.5),
        "rwkv_mu": unif((L, RWKV_COLS), 0.0, 1.0),
        "rwkv_w0": unif((L, G), -6.0, 1.0),
        "rwkv_w2": nrm((L, RWKV_W_LORA, G), RWKV_W_LORA ** -0.5),
        "rwkv_a0": nrm((L, G), 0.1),
        "rwkv_a2": nrm((L, RWKV_A_LORA, G), RWKV_A_LORA ** -0.5),
        "rwkv_g2": nrm((L, RWKV_G_LORA, G), RWKV_G_LORA ** -0.5),
        "rwkv_k_k": 0.85 + nrm((L, G), 0.02),
        "rwkv_k_a": gain((L, G)),
        "rwkv_r_k": nrm((L, G), 0.1),
        "rwkv_v0": 1.0 + nrm((L - 1, G), 0.1),
        "rwkv_v1": nrm((L - 1, G, RWKV_V_LORA), G ** -0.5),
        "rwkv_v2": nrm((L - 1, RWKV_V_LORA, G), RWKV_V_LORA ** -0.5),
        "rwkv_ln_w": gain((L, G)),
        "rwkv_ln_b": nrm((L, G), 0.02),
        "lru_conv_w": nrm((L, LRU_CONV, G), LRU_CONV ** -0.5),
        "lru_conv_b": nrm((L, G), 0.02),
        "lru_wa": nrm((L, LRU_HEADS, LRU_HD, LRU_HD), LRU_HD ** -0.5),
        "lru_ba": nrm((L, G), 0.02),
        "lru_wx": nrm((L, LRU_HEADS, LRU_HD, LRU_HD), LRU_HD ** -0.5),
        "lru_bx": nrm((L, G), 0.02),
        "lru_lambda": None,
        "merge_gain": None,
    }
    a_lru = unif((L, G), 0.9, 0.999) ** (1.0 / LRU_C)
    inputs["lru_lambda"] = jnp.log(a_lru) - jnp.log1p(-a_lru)
    inputs["merge_gain"] = gain((L, D_MIX))
    inputs["w_out"] = nrm((L, D_MIX, D), D_MIX ** -0.5)
    inputs["norm2_w"] = gain((L, D))
    inputs["moe_coarse_w"] = nrm((L, D, MOE_GROUPS), D ** -0.5)
    inputs["moe_coarse_b"] = nrm((L, MOE_GROUPS), 0.01)
    inputs["moe_fine_w"] = nrm((L, MOE_GROUPS, D, MOE_PER_GROUP), D ** -0.5)
    inputs["moe_fine_b"] = nrm((L, MOE_GROUPS, MOE_PER_GROUP), 0.01)
    inputs["moe_w_gate"] = nrm((L, N_EXPERTS, D, D_EXPERT), D ** -0.5)
    inputs["moe_w_up"] = nrm((L, N_EXPERTS, D, D_EXPERT), D ** -0.5)
    inputs["moe_w_down"] = nrm((L, N_EXPERTS, D_EXPERT, D), D_EXPERT ** -0.5)
    inputs["final_norm_w"] = gain((D,))
    return inputs


def reference(x, norm1_w, w_in, hgrn_lb_logits, hgrn_norm_w, s5_lambda_re, s5_lambda_im, s5_log_dt,
              s5_b_re, s5_b_im, s5_c_re, s5_c_im, s5_d, s5_w_glu, rwkv_mu, rwkv_w0, rwkv_w2, rwkv_a0,
              rwkv_a2, rwkv_g2, rwkv_k_k, rwkv_k_a, rwkv_r_k, rwkv_v0, rwkv_v1, rwkv_v2, rwkv_ln_w,
              rwkv_ln_b, lru_conv_w, lru_conv_b, lru_wa, lru_ba, lru_wx, lru_bx, lru_lambda,
              merge_gain, w_out, norm2_w, moe_coarse_w, moe_coarse_b, moe_fine_w, moe_fine_b,
              moe_w_gate, moe_w_up, moe_w_down, final_norm_w):
    B, T, D = x.shape
    lb_all = jnp.cumsum(jax.nn.softmax(hgrn_lb_logits.astype(jnp.float32), axis=0), axis=0)
    lb_all = lb_all - lb_all[:1]
    h = x
    v_first = None
    for l in range(DEPTH):
        hn = rms_norm(h, norm1_w[l])
        proj = hn @ w_in[l]
        hq, hf, hi, hg, su, rw, lg, lx = jnp.split(proj, _splits(COL_SIZES), axis=-1)
        o_a = hgrn2_mixer(hq, hf, hi, hg, lb_all[l], hgrn_norm_w[l])
        o_b = s5_mixer(su, s5_lambda_re[l], s5_lambda_im[l], s5_log_dt[l], s5_b_re[l], s5_b_im[l],
                       s5_c_re[l], s5_c_im[l], s5_d[l], s5_w_glu[l])
        v_mix = None if l == 0 else (rwkv_v0[l - 1], rwkv_v1[l - 1], rwkv_v2[l - 1])
        o_c, v_first = rwkv7_mixer(rw, rwkv_mu[l], rwkv_w0[l], rwkv_w2[l], rwkv_a0[l], rwkv_a2[l],
                                   rwkv_g2[l], rwkv_k_k[l], rwkv_k_a[l], rwkv_r_k[l], rwkv_ln_w[l],
                                   rwkv_ln_b[l], v_first, v_mix)
        o_d = rglru_mixer(lg, lx, lru_conv_w[l], lru_conv_b[l], lru_wa[l], lru_ba[l], lru_wx[l],
                          lru_bx[l], lru_lambda[l])
        mix = jnp.concatenate([o_a, o_b, o_c, o_d], axis=-1).reshape(B, T, N_MIX_GROUPS, GROUP_W)
        mix = rms_norm(mix, merge_gain[l].reshape(N_MIX_GROUPS, GROUP_W)).reshape(B, T, D_MIX)
        h = h + mix @ w_out[l]
        h = h + hier_moe(rms_norm(h, norm2_w[l]), moe_coarse_w[l], moe_coarse_b[l], moe_fine_w[l],
                         moe_fine_b[l], moe_w_gate[l], moe_w_up[l], moe_w_down[l])
    return rms_norm(h, final_norm_w)
```

```cpp
#include <hip/hip_runtime.h>
#include <cstdio>
#include <cstdint>
#include <cstring>

#define LAS __attribute__((address_space(3)))
#define GAS __attribute__((address_space(1)))

namespace pg8 {
#define PG8_LAS __attribute__((address_space(3)))
typedef unsigned short bf16_t;
typedef short bf16x8 __attribute__((ext_vector_type(8)));
typedef float f32x4 __attribute__((ext_vector_type(4)));
typedef unsigned u32x4 __attribute__((ext_vector_type(4)));
typedef int v8i __attribute__((ext_vector_type(8)));
constexpr int BM = 256, BK = 64, HALF = 128, HTB = HALF * BK * 2  , STAGE_BYTES = 8 * HTB, NXCD = 8, WGM = 8;

__host__ __device__ __forceinline__ int lds_byte(int r, int c) { const int st = (r >> 4) * 2 + (c >> 5), rr = r & 15, cc = c & 31, ob = rr * 64 + cc * 2; return st * 1024 + (ob ^ (((ob >> 9) & 1) << 5)); }
__host__ __device__ __forceinline__ void stage_rc(int b, int& R, int& C) { const int st = b / 1024, sb = b % 1024, swz = sb ^ (((sb >> 9) & 1) << 5); R = (st >> 1) * 16 + swz / 64; C = (st & 1) * 32 + (swz % 64) / 2; }
__host__ __device__ __forceinline__ int perm32(int rho) { const int n = rho >> 4, i = rho & 15; return 8 * (i >> 2) + 4 * n + (i & 3); }

struct Unit { int pm, pn; };
struct Gemm { const bf16_t* A; const bf16_t* Bt; int M, N, K; const int* rowsrc; int nsrc; int lda; };

struct StaticOrder {
    int nM, nN, nwg, G, c; const PG8_LAS int* tile_e; size_t estride;
    __device__ void init(int nM_, int nN_, int G_, int c_) { nM = nM_; nN = nN_; nwg = nM * nN; G = G_; c = c_; tile_e = nullptr; estride = 0; }
    __device__ bool next(int i, Unit& u) const {
        const long L = (long)i * G + c; if (L >= nwg) return false;
        int wgid = (int)L; { const int q = nwg / NXCD, r = nwg % NXCD, xcd = wgid % NXCD, off = wgid / NXCD; wgid = (xcd < r ? xcd * (q + 1) : r * (q + 1) + (xcd - r) * q) + off; }
        const int nig = WGM * nN, gid = wgid / nig, fm = gid * WGM, gsz = (nM - fm) < WGM ? (nM - fm) : WGM;
        u.pm = fm + ((wgid % nig) % gsz); u.pn = (wgid % nig) / gsz; return true;
    }
    __device__ __forceinline__ size_t boff(const Unit& u, size_t tstep) const { return (size_t)u.pn * tstep + (tile_e ? (size_t)tile_e[u.pm] * estride : (size_t)0); }
    __device__ __forceinline__ void a_ready(const Unit&) const {}
    __device__ __forceinline__ void done(const Unit&) const {}
};

__device__ __forceinline__ unsigned cvt_pk_bf16(float lo, float hi) { unsigned r; asm volatile("v_cvt_pk_bf16_f32 %0, %1, %2" : "=v"(r) : "v"(lo), "v"(hi)); return r; }

__device__ __forceinline__ float sat8(float x) { return __builtin_amdgcn_fmed3f(x, -448.f, 448.f); }
struct EpiBf16 {
    static constexpr bool PERM = true, AFTER_DRAIN = false;
    bf16_t* O; int ldc;
    __device__ __forceinline__ void operator()(const f32x4 (&acc)[2][2][4][2], const Unit& u, int wr, int wc, int fr, int fq) const {
        const int row0 = u.pm * BM + wr * 64 + fr, col0 = u.pn * BM + wc * 32 + 8 * fq;
#pragma unroll
        for (int ai = 0; ai < 2; ++ai)
#pragma unroll
            for (int m = 0; m < 4; ++m) { bf16_t* rowp = O + (size_t)(row0 + ai * HALF + m * 16) * ldc + col0;
#pragma unroll
                for (int bj = 0; bj < 2; ++bj) { const f32x4 v0 = acc[ai][bj][m][0], v1 = acc[ai][bj][m][1];
                    u32x4 w; w.x = cvt_pk_bf16(v0[0], v0[1]); w.y = cvt_pk_bf16(v0[2], v0[3]); w.z = cvt_pk_bf16(v1[0], v1[1]); w.w = cvt_pk_bf16(v1[2], v1[3]);
                    *(u32x4*)(rowp + bj * HALF) = w; } }
    }
};
struct EpiLogits {
    static constexpr bool PERM = true, AFTER_DRAIN = false;
    float* O;
    __device__ __forceinline__ void operator()(const f32x4 (&acc)[2][2][4][2], const Unit& u, int wr, int wc, int fr, int fq) const {
        const int row0 = u.pm * BM + wr * 64 + fr, col0 = wc * 32 + 8 * fq;
        if (col0 < 72) {
#pragma unroll
            for (int ai = 0; ai < 2; ++ai)
#pragma unroll
                for (int m = 0; m < 4; ++m) { float* rowp = O + (size_t)(row0 + ai * HALF + m * 16) * 72 + col0; *(f32x4*)rowp = acc[ai][0][m][0]; *(f32x4*)(rowp + 4) = acc[ai][0][m][1]; }
        }
    }
};
template <int MODE> struct EpiGated {
    static constexpr bool PERM = true, AFTER_DRAIN = false;
    bf16_t* O; int ldc;
    __device__ __forceinline__ void operator()(const f32x4 (&acc)[2][2][4][2], const Unit& u, int wr, int wc, int fr, int fq) const {
        const int row0 = u.pm * BM + wr * 64 + fr, col0 = u.pn * HALF + wc * 32 + 8 * fq;
#pragma unroll
        for (int ai = 0; ai < 2; ++ai)
#pragma unroll
            for (int m = 0; m < 4; ++m) { bf16_t* rowp = O + (size_t)(row0 + ai * HALF + m * 16) * ldc + col0;
                float o[8];
#pragma unroll
                for (int n = 0; n < 2; ++n)
#pragma unroll
                    for (int j = 0; j < 4; ++j) { const float a = acc[ai][0][m][n][j], b = acc[ai][1][m][n][j];
                        o[n * 4 + j] = (MODE == 0) ? (a / (1.f + __expf(-a))) * b : a / (1.f + __expf(-b)); }
                u32x4 w; w.x = cvt_pk_bf16(o[0], o[1]); w.y = cvt_pk_bf16(o[2], o[3]); w.z = cvt_pk_bf16(o[4], o[5]); w.w = cvt_pk_bf16(o[6], o[7]);
                *(u32x4*)rowp = w; }
    }
};
template <bool RF32> struct EpiResB {
    static constexpr bool PERM = true, AFTER_DRAIN = false;
    bf16_t* C; const void* R; int ldc, ldr;
    __device__ __forceinline__ void operator()(const f32x4 (&acc)[2][2][4][2], const Unit& u, int wr, int wc, int fr, int fq) const {
        const int row0 = u.pm * BM + wr * 64 + fr, col0 = u.pn * BM + wc * 32 + 8 * fq;
#pragma unroll
        for (int ai = 0; ai < 2; ++ai)
#pragma unroll
            for (int m = 0; m < 4; ++m) { const size_t row = (size_t)(row0 + ai * HALF + m * 16);
#pragma unroll
                for (int bj = 0; bj < 2; ++bj) { float r[8];
                    if constexpr (RF32) { const f32x4 a = *(const f32x4*)((const float*)R + row * ldr + col0 + bj * HALF), b = *(const f32x4*)((const float*)R + row * ldr + col0 + bj * HALF + 4);
                        r[0] = a[0]; r[1] = a[1]; r[2] = a[2]; r[3] = a[3]; r[4] = b[0]; r[5] = b[1]; r[6] = b[2]; r[7] = b[3]; }
                    else { const u32x4 w = *(const u32x4*)((const bf16_t*)R + row * ldr + col0 + bj * HALF);
                        r[0] = __builtin_bit_cast(float, w.x << 16); r[1] = __builtin_bit_cast(float, w.x & 0xffff0000u); r[2] = __builtin_bit_cast(float, w.y << 16); r[3] = __builtin_bit_cast(float, w.y & 0xffff0000u);
                        r[4] = __builtin_bit_cast(float, w.z << 16); r[5] = __builtin_bit_cast(float, w.z & 0xffff0000u); r[6] = __builtin_bit_cast(float, w.w << 16); r[7] = __builtin_bit_cast(float, w.w & 0xffff0000u); }
                    const f32x4 v0 = acc[ai][bj][m][0], v1 = acc[ai][bj][m][1];
                    u32x4 o; o.x = cvt_pk_bf16(v0[0] + r[0], v0[1] + r[1]); o.y = cvt_pk_bf16(v0[2] + r[2], v0[3] + r[3]); o.z = cvt_pk_bf16(v1[0] + r[4], v1[1] + r[5]); o.w = cvt_pk_bf16(v1[2] + r[6], v1[3] + r[7]);
                    *(u32x4*)(C + row * ldc + col0 + bj * HALF) = o; } }
    }
};
struct EpiGatedF8 {
    static constexpr bool PERM = true, AFTER_DRAIN = false;
    unsigned char* O; int ldc;
    __device__ __forceinline__ void operator()(const f32x4 (&acc)[2][2][4][2], const Unit& u, int wr, int wc, int fr, int fq) const {
        const int row0 = u.pm * BM + wr * 64 + fr, col0 = u.pn * HALF + wc * 32 + 8 * fq;
#pragma unroll
        for (int ai = 0; ai < 2; ++ai)
#pragma unroll
            for (int m = 0; m < 4; ++m) { unsigned char* rowp = O + (size_t)(row0 + ai * HALF + m * 16) * ldc + col0;
                float o[8];
#pragma unroll
                for (int n = 0; n < 2; ++n)
#pragma unroll
                    for (int j = 0; j < 4; ++j) { const float a = acc[ai][0][m][n][j], b = acc[ai][1][m][n][j]; o[n * 4 + j] = sat8((a / (1.f + __expf(-a))) * b); }
                int w0 = 0, w1 = 0;
                w0 = __builtin_amdgcn_cvt_pk_fp8_f32(o[0], o[1], w0, false); w0 = __builtin_amdgcn_cvt_pk_fp8_f32(o[2], o[3], w0, true);
                w1 = __builtin_amdgcn_cvt_pk_fp8_f32(o[4], o[5], w1, false); w1 = __builtin_amdgcn_cvt_pk_fp8_f32(o[6], o[7], w1, true);
                unsigned long long pk = (unsigned long long)(unsigned)w0 | ((unsigned long long)(unsigned)w1 << 32); *(unsigned long long*)rowp = pk; }
    }
};
struct EpiF8 {
    static constexpr bool PERM = true, AFTER_DRAIN = false;
    unsigned char* O; int ldc; float sc;
    __device__ __forceinline__ void operator()(const f32x4 (&acc)[2][2][4][2], const Unit& u, int wr, int wc, int fr, int fq) const {
        const int row0 = u.pm * BM + wr * 64 + fr, col0 = u.pn * BM + wc * 32 + 8 * fq;
#pragma unroll
        for (int ai = 0; ai < 2; ++ai)
#pragma unroll
            for (int m = 0; m < 4; ++m) { unsigned char* rowp = O + (size_t)(row0 + ai * HALF + m * 16) * ldc + col0;
#pragma unroll
                for (int bj = 0; bj < 2; ++bj) { const f32x4 v0 = acc[ai][bj][m][0] * sc, v1 = acc[ai][bj][m][1] * sc; int w0 = 0, w1 = 0;
                    w0 = __builtin_amdgcn_cvt_pk_fp8_f32(sat8(v0[0]), sat8(v0[1]), w0, false); w0 = __builtin_amdgcn_cvt_pk_fp8_f32(sat8(v0[2]), sat8(v0[3]), w0, true);
                    w1 = __builtin_amdgcn_cvt_pk_fp8_f32(sat8(v1[0]), sat8(v1[1]), w1, false); w1 = __builtin_amdgcn_cvt_pk_fp8_f32(sat8(v1[2]), sat8(v1[3]), w1, true);
                    *(unsigned long long*)(rowp + bj * HALF) = (unsigned long long)(unsigned)w0 | ((unsigned long long)(unsigned)w1 << 32); } }
    }
};
struct EpiResF32 {
    static constexpr bool PERM = false, AFTER_DRAIN = false;
    float* C; const float* R; int ldc;
    __device__ __forceinline__ void operator()(const f32x4 (&acc)[2][2][4][2], const Unit& u, int wr, int wc, int fr, int fq) const {
        const int row0 = u.pm * BM + wr * 64 + fr, col0 = u.pn * BM + wc * 32 + 4 * fq;
#pragma unroll
        for (int ai = 0; ai < 2; ++ai)
#pragma unroll
            for (int m = 0; m < 4; ++m) { const size_t ro = (size_t)(row0 + ai * HALF + m * 16) * ldc + col0;
#pragma unroll
                for (int bj = 0; bj < 2; ++bj)
#pragma unroll
                    for (int n = 0; n < 2; ++n) { const f32x4 r = *(const f32x4*)(R + ro + bj * HALF + n * 16); *(f32x4*)(C + ro + bj * HALF + n * 16) = acc[ai][bj][m][n] + r; } }
    }
};


template <class Epi, class Sched, bool ALIGN_EPI = false, bool SP2 = false, bool GATH = false, bool F8 = false>
__device__ __forceinline__ void gemm_phase(PG8_LAS unsigned char* lds, const Gemm g, const Sched& S, const Epi& E) {
    static_assert(!GATH || SP2, "the gathered-A variant exists for the SP2 loop only");
    const int tid = threadIdx.x, wid = __builtin_amdgcn_readfirstlane(tid >> 6), lane = tid & 63, wr = wid >> 2, wc = wid & 3, fr = lane & 15, fq = lane >> 4;
    const int K = g.K, nt = K / BK, ldA = g.lda ? g.lda : K;
    unsigned voffA[2], voffB[2];
#pragma unroll
    for (int i = 0; i < 2; ++i) { int R, C; stage_rc(tid * 16 + i * 8192, R, C); const int Rb = Epi::PERM ? ((R & ~31) + perm32(R & 31)) : R;
        voffA[i] = (unsigned)(R * ldA + C) * 2u; voffB[i] = (unsigned)(Rb * K + C) * 2u; }
    const size_t kstep = (size_t)(BK * 2);
    const size_t hstep = (size_t)HALF * K * 2;
    const size_t tstep = 2 * hstep;
    const size_t hstepA = (size_t)HALF * ldA * 2, tstepA = 2 * hstepA;
    const unsigned ldsw = (unsigned)wid * 1024u;
    const int aoff = lds_byte(wr * 64 + fr, fq * 8), boff = lds_byte(wc * 32 + fr, fq * 8);
#define PG8_SA(b, h) (((b) * 2 + (h)) * HTB)
#define PG8_SB(b, h) ((4 + (b) * 2 + (h)) * HTB)
#define PG8_STAGE(bufoff, gbase, voff) do { _Pragma("unroll") for (int _i = 0; _i < 2; ++_i) \
        __builtin_amdgcn_global_load_lds((const unsigned*)((const char*)(gbase) + (voff)[_i]), (PG8_LAS unsigned*)(lds + (bufoff) + ldsw + _i * 8192), 16, 0, 0); } while (0)
#define PG8_STAGE_G(bufoff, gbase, v0, v1) do { \
        __builtin_amdgcn_global_load_lds((const unsigned*)((const char*)(gbase) + (v0)), (PG8_LAS unsigned*)(lds + (bufoff) + ldsw), 16, 0, 0); \
        __builtin_amdgcn_global_load_lds((const unsigned*)((const char*)(gbase) + (v1)), (PG8_LAS unsigned*)(lds + (bufoff) + ldsw + 8192), 16, 0, 0); } while (0)
#define PG8_LDA(dst, b, h) do { if constexpr (F8) { _Pragma("unroll") for (int m = 0; m < 4; ++m) { const u32x4 lo_ = *(const PG8_LAS u32x4*)(lds + PG8_SA(b, h) + aoff + m * 2048), hi_ = *(const PG8_LAS u32x4*)(lds + PG8_SA(b, h) + aoff + 1024 + m * 2048); \
            dst##8[m] = (v8i){(int)lo_.x, (int)lo_.y, (int)lo_.z, (int)lo_.w, (int)hi_.x, (int)hi_.y, (int)hi_.z, (int)hi_.w}; } } \
        else { _Pragma("unroll") for (int m = 0; m < 4; ++m) _Pragma("unroll") for (int k = 0; k < 2; ++k) dst[m][k] = *(const PG8_LAS bf16x8*)(lds + PG8_SA(b, h) + aoff + m * 2048 + k * 1024); } } while (0)
#define PG8_LDB(dst, b, h) do { if constexpr (F8) { _Pragma("unroll") for (int n = 0; n < 2; ++n) { const u32x4 lo_ = *(const PG8_LAS u32x4*)(lds + PG8_SB(b, h) + boff + n * 2048), hi_ = *(const PG8_LAS u32x4*)(lds + PG8_SB(b, h) + boff + 1024 + n * 2048); \
            dst##8[n] = (v8i){(int)lo_.x, (int)lo_.y, (int)lo_.z, (int)lo_.w, (int)hi_.x, (int)hi_.y, (int)hi_.z, (int)hi_.w}; } } \
        else { _Pragma("unroll") for (int n = 0; n < 2; ++n) _Pragma("unroll") for (int k = 0; k < 2; ++k) dst[n][k] = *(const PG8_LAS bf16x8*)(lds + PG8_SB(b, h) + boff + n * 2048 + k * 1024); } } while (0)
#define PG8_MMA(ai, bj, At, Bt) do { __builtin_amdgcn_s_setprio(1); \
        if constexpr (F8) { _Pragma("unroll") for (int m = 0; m < 4; ++m) _Pragma("unroll") for (int n = 0; n < 2; ++n) \
            asm volatile("v_mfma_scale_f32_16x16x128_f8f6f4 %0, %1, %2, %0, %3, %4 op_sel_hi:[0,0,0]" : "+v"(acc[ai][bj][m][n]) : "v"(Bt##8[n]), "v"(At##8[m]), "v"(sc8_), "v"(sc8_)); } \
        else { _Pragma("unroll") for (int m = 0; m < 4; ++m) _Pragma("unroll") for (int n = 0; n < 2; ++n) _Pragma("unroll") for (int k = 0; k < 2; ++k) \
            acc[ai][bj][m][n] = __builtin_amdgcn_mfma_f32_16x16x32_bf16(Bt[n][k], At[m][k], acc[ai][bj][m][n], 0, 0, 0); } \
        __builtin_amdgcn_s_setprio(0); } while (0)
#define PG8_WAIT_V(n) asm volatile("s_waitcnt vmcnt(" #n ")" ::: "memory")
#define PG8_WAIT_L(n) asm volatile("s_waitcnt lgkmcnt(" #n ")" ::: "memory")
#define PG8_BAR __builtin_amdgcn_s_barrier()
#define PG8_SCHED __builtin_amdgcn_sched_barrier(0)
#define PG8_SCHED8 do { if constexpr (F8) __builtin_amdgcn_sched_barrier(0); } while (0)
    Unit cur, nxt; int ui = 0;
    if (!S.next(0, cur)) return;
    unsigned gc[2][2] = {{0u, 0u}, {0u, 0u}}, gn[2][2] = {{0u, 0u}, {0u, 0u}};
    int gR[2] = {0, 0}, gC[2] = {0, 0};
    if constexpr (GATH) {
#pragma unroll
        for (int i = 0; i < 2; ++i) stage_rc(tid * 16 + i * 8192, gR[i], gC[i]);
#pragma unroll
        for (int h = 0; h < 2; ++h)
#pragma unroll
            for (int i = 0; i < 2; ++i) { unsigned src = (unsigned)g.rowsrc[cur.pm * BM + h * HALF + gR[i]]; src = src < (unsigned)g.nsrc ? src : (unsigned)(g.nsrc - 1); gc[h][i] = (src * (unsigned)K + (unsigned)gC[i]) * 2u; }
    }
    f32x4 acc[2][2][4][2];
#pragma unroll
    for (int a = 0; a < 2; ++a)
#pragma unroll
        for (int b = 0; b < 2; ++b)
#pragma unroll
            for (int m = 0; m < 4; ++m)
#pragma unroll
                for (int n = 0; n < 2; ++n) acc[a][b][m][n] = (f32x4){0.f, 0.f, 0.f, 0.f};
    const int sc8_ = 0x7c7c7c7c;
    bf16x8 At[4][2], B0[2][2], B1[2][2]; v8i At8[4], B08[2], B18[2];
    const char* cA = GATH ? (const char*)g.A : (const char*)g.A + (size_t)cur.pm * tstepA; const char* cB = (const char*)g.Bt + S.boff(cur, tstep);
    S.a_ready(cur);
    if constexpr (SP2) {
        PG8_STAGE(PG8_SB(0, 0), cB, voffB); PG8_STAGE(PG8_SB(0, 1), cB + hstep, voffB);
        if constexpr (GATH) { PG8_STAGE_G(PG8_SA(0, 0), cA, gc[0][0], gc[0][1]); PG8_STAGE_G(PG8_SA(0, 1), cA, gc[1][0], gc[1][1]); } else { PG8_STAGE(PG8_SA(0, 0), cA, voffA); PG8_STAGE(PG8_SA(0, 1), cA + hstepA, voffA); }
        if (wr == 1) PG8_BAR;
        PG8_WAIT_V(2); PG8_BAR;
        PG8_STAGE(PG8_SB(1, 0), cB + kstep, voffB); if constexpr (GATH) PG8_STAGE_G(PG8_SA(1, 0), cA + kstep, gc[0][0], gc[0][1]); else PG8_STAGE(PG8_SA(1, 0), cA + kstep, voffA); PG8_STAGE(PG8_SB(1, 1), cB + hstep + kstep, voffB);
        PG8_WAIT_V(6); PG8_BAR;
    } else {
        PG8_STAGE(PG8_SB(0, 0), cB, voffB); PG8_STAGE(PG8_SA(0, 0), cA, voffA); PG8_STAGE(PG8_SB(0, 1), cB + hstep, voffB); PG8_STAGE(PG8_SA(0, 1), cA + hstepA, voffA);
        if (wr == 1) PG8_BAR;
        PG8_WAIT_V(4); PG8_BAR;
        PG8_STAGE(PG8_SB(1, 0), cB + kstep, voffB); PG8_STAGE(PG8_SA(1, 0), cA + kstep, voffA); PG8_STAGE(PG8_SB(1, 1), cB + hstep + kstep, voffB);
        PG8_WAIT_V(6); PG8_BAR;
    }
    for (;;) {
        const bool has_next = S.next(ui + 1, nxt);
        const char* nA = GATH ? cA : (has_next ? (const char*)g.A + (size_t)nxt.pm * tstepA : cA); const char* nB = has_next ? (const char*)g.Bt + S.boff(nxt, tstep) : cB;
        if constexpr (GATH) {
#pragma unroll
            for (int h = 0; h < 2; ++h)
#pragma unroll
                for (int i = 0; i < 2; ++i) { gn[h][i] = gc[h][i];
                    if (has_next) { unsigned src = (unsigned)g.rowsrc[nxt.pm * BM + h * HALF + gR[i]]; src = src < (unsigned)g.nsrc ? src : (unsigned)(g.nsrc - 1); gn[h][i] = (src * (unsigned)K + (unsigned)gC[i]) * 2u; } }
        }
#pragma nounroll
        for (int t = 0; t < nt; t += 2) {
            const bool last = (t == nt - 2);
            const char* a1 = cA + (size_t)(t + 1) * kstep;
            const char* a2 = last ? nA : cA + (size_t)(t + 2) * kstep; const char* b2 = last ? nB : cB + (size_t)(t + 2) * kstep;
            const char* a3 = a2 + kstep; const char* b3 = b2 + kstep;
            if (last && has_next) S.a_ready(nxt);
            if constexpr (SP2) {
            PG8_LDB(B0, 0, 0); PG8_LDB(B1, 0, 1); PG8_SCHED; PG8_LDA(At, 0, 0); if constexpr (GATH) PG8_STAGE_G(PG8_SA(1, 1), a1, gc[1][0], gc[1][1]); else PG8_STAGE(PG8_SA(1, 1), a1 + hstepA, voffA);
            PG8_WAIT_V(8); PG8_WAIT_L(0); PG8_BAR; PG8_SCHED8; PG8_MMA(0, 0, At, B0); PG8_MMA(0, 1, At, B1); PG8_SCHED8; PG8_BAR; PG8_SCHED;
            PG8_LDA(At, 0, 1); PG8_STAGE(PG8_SB(0, 0), b2, voffB); PG8_STAGE(PG8_SB(0, 1), b2 + hstep, voffB); if constexpr (GATH) PG8_STAGE_G(PG8_SA(0, 0), a2, last ? gn[0][0] : gc[0][0], last ? gn[0][1] : gc[0][1]); else PG8_STAGE(PG8_SA(0, 0), a2, voffA);
            PG8_WAIT_V(8); PG8_WAIT_L(0); PG8_BAR; PG8_SCHED8; PG8_MMA(1, 0, At, B0); PG8_MMA(1, 1, At, B1); PG8_SCHED8; PG8_BAR; PG8_SCHED;
            PG8_LDB(B0, 1, 0); PG8_LDB(B1, 1, 1); PG8_SCHED; PG8_LDA(At, 1, 0); if constexpr (GATH) PG8_STAGE_G(PG8_SA(0, 1), a2, last ? gn[1][0] : gc[1][0], last ? gn[1][1] : gc[1][1]); else PG8_STAGE(PG8_SA(0, 1), a2 + hstepA, voffA);
            PG8_WAIT_V(8); PG8_WAIT_L(0); PG8_BAR; PG8_SCHED8; PG8_MMA(0, 0, At, B0); PG8_MMA(0, 1, At, B1); PG8_SCHED8; PG8_BAR; PG8_SCHED;
            PG8_LDA(At, 1, 1); PG8_STAGE(PG8_SB(1, 0), b3, voffB); PG8_STAGE(PG8_SB(1, 1), b3 + hstep, voffB); if constexpr (GATH) PG8_STAGE_G(PG8_SA(1, 0), a3, last ? gn[0][0] : gc[0][0], last ? gn[0][1] : gc[0][1]); else PG8_STAGE(PG8_SA(1, 0), a3, voffA);
            PG8_WAIT_V(8); PG8_WAIT_L(0); PG8_BAR; PG8_SCHED8; PG8_MMA(1, 0, At, B0); PG8_MMA(1, 1, At, B1); PG8_SCHED8; PG8_BAR; PG8_SCHED;
            } else {
            PG8_LDB(B0, 0, 0); PG8_SCHED; PG8_LDA(At, 0, 0); PG8_STAGE(PG8_SA(1, 1), a1 + hstepA, voffA);
            PG8_WAIT_L(8); PG8_BAR; PG8_WAIT_L(0); PG8_MMA(0, 0, At, B0); PG8_BAR; PG8_SCHED;
            PG8_LDB(B1, 0, 1); PG8_STAGE(PG8_SB(0, 0), b2, voffB);
            PG8_BAR; PG8_WAIT_L(0); PG8_MMA(0, 1, At, B1); PG8_BAR;
            PG8_LDA(At, 0, 1); PG8_STAGE(PG8_SA(0, 0), a2, voffA);
            PG8_BAR; PG8_WAIT_L(0); PG8_MMA(1, 0, At, B0); PG8_BAR; PG8_SCHED;
            PG8_STAGE(PG8_SB(0, 1), b2 + hstep, voffB);
            PG8_WAIT_V(6); PG8_BAR; PG8_MMA(1, 1, At, B1); PG8_BAR;
            PG8_LDB(B0, 1, 0); PG8_SCHED; PG8_LDA(At, 1, 0); PG8_STAGE(PG8_SA(0, 1), a2 + hstepA, voffA);
            PG8_WAIT_L(8); PG8_BAR; PG8_WAIT_L(0); PG8_MMA(0, 0, At, B0); PG8_BAR; PG8_SCHED;
            PG8_LDB(B1, 1, 1); PG8_STAGE(PG8_SB(1, 0), b3, voffB);
            PG8_BAR; PG8_WAIT_L(0); PG8_MMA(0, 1, At, B1); PG8_BAR;
            PG8_LDA(At, 1, 1); PG8_STAGE(PG8_SA(1, 0), a3, voffA);
            PG8_BAR; PG8_WAIT_L(0); PG8_MMA(1, 0, At, B0); PG8_BAR; PG8_SCHED;
            PG8_STAGE(PG8_SB(1, 1), b3 + hstep, voffB);
            PG8_WAIT_V(6); PG8_BAR; PG8_MMA(1, 1, At, B1); PG8_BAR;
            }
        }
        if constexpr (F8) asm volatile("s_nop 15\n\ts_nop 15" ::: "memory");
        if constexpr (ALIGN_EPI) { if (wr == 0) PG8_BAR; }
        if constexpr (!Epi::AFTER_DRAIN) { E(acc, cur, wr, wc, fr, fq); S.done(cur); }
        if (!has_next) break;
#pragma unroll
        for (int a = 0; a < 2; ++a)
#pragma unroll
            for (int b = 0; b < 2; ++b)
#pragma unroll
                for (int m = 0; m < 4; ++m)
#pragma unroll
                    for (int n = 0; n < 2; ++n) acc[a][b][m][n] = (f32x4){0.f, 0.f, 0.f, 0.f};
        cur = nxt; cA = nA; cB = nB; ++ui;
        if constexpr (GATH) {
#pragma unroll
            for (int h = 0; h < 2; ++h)
#pragma unroll
                for (int i = 0; i < 2; ++i) gc[h][i] = gn[h][i]; }
        if constexpr (ALIGN_EPI) { if (wr == 1) PG8_BAR; }
    }
    PG8_WAIT_V(0);
    if constexpr (!ALIGN_EPI) { if (wr == 0) PG8_BAR; }
    PG8_BAR;
    if constexpr (Epi::AFTER_DRAIN) { E.fused(acc, cur, wr, wc, fr, fq, lds, wid, lane); S.done(cur); }
#undef PG8_SA
#undef PG8_SB
#undef PG8_STAGE
#undef PG8_STAGE_G
#undef PG8_LDA
#undef PG8_LDB
#undef PG8_MMA
#undef PG8_WAIT_V
#undef PG8_WAIT_L
#undef PG8_BAR
#undef PG8_SCHED
#undef PG8_SCHED8
}
}


constexpr int NB = 8, T = 8192, D = 1024, NTOK = NB * T, DIN = 2816, NL = 2, GW = 256;
constexpr int NWAVES = 8, NTHR = 512;
constexpr int HP = 2048;
constexpr int NEXP = 32, DEXP = 512;
constexpr int MAXTILES = (2 * NTOK) / 256 + NEXP;
constexpr int SROWS = MAXTILES * 256;
constexpr int C_HQ = 0, C_HF = 256, C_HI = 512, C_HG = 768, C_SU = 1024, C_RW = 1280, C_LG = 2304, C_LX = 2560;

constexpr size_t MiB = 1u << 20;
constexpr size_t WS_CTL = 0, CTL_ZERO_BYTES = 1 * MiB;
constexpr size_t WL_STRIDE = 105 * MiB;
constexpr size_t WO_IN = 0, WO_OUT = 6 * MiB, WO_GLU = 8 * MiB, WO_GU = 9 * MiB, WO_DN = 73 * MiB, WO_RT = 8 * MiB + 512 * 1024;
constexpr size_t WS_W = 1 * MiB;
constexpr size_t S5_STRIDE = 9 * MiB;
constexpr size_t S5O_F3 = 0, S5O_F1 = 4 * MiB, S5O_A16 = 8 * MiB;
constexpr size_t WS_S5 = 211 * MiB;
constexpr size_t WS_ACT = 229 * MiB;
constexpr size_t WS_PROJ = 357 * MiB;
constexpr size_t WS_MIX = 709 * MiB;
constexpr size_t WS_YG = WS_MIX + 128 * MiB;
constexpr size_t WS_VF = 869 * MiB;
constexpr size_t WS_HU = 901 * MiB;
constexpr size_t WS_XS = 933 * MiB;
constexpr size_t WS_ROUTE = 965 * MiB;
constexpr size_t WS_TCNT = 967 * MiB;
constexpr size_t WS_LG = 968 * MiB;
constexpr size_t WS_END = 986 * MiB;
static_assert(WS_PROJ + (size_t)NTOK * DIN * 2 <= WS_MIX && WS_PROJ + (size_t)SROWS * D * 2 <= WS_MIX, "proj region");
static_assert(WS_MIX + (size_t)SROWS * DEXP * 2 <= WS_VF, "mix region");
constexpr int CW_BAR = 4096;
constexpr int CW_CNT = 8192;
constexpr int CW_CUR = 8192 + 256;

constexpr int RING_BYTES = 131072;
constexpr int LDSCTL_OFF = RING_BYTES;
constexpr int LDS_TILE_E = LDSCTL_OFF + 64;
constexpr int LDS_MISC = LDS_TILE_E + MAXTILES * 4;
constexpr int LDS_BYTES = 147456;
static_assert(LDS_MISC + 1024 <= LDS_BYTES, "LDS map");

typedef unsigned short bf16;
typedef float f32x4 __attribute__((ext_vector_type(4)));
typedef float f32x2 __attribute__((ext_vector_type(2)));
typedef unsigned u32x4 __attribute__((ext_vector_type(4)));
typedef unsigned u32x2 __attribute__((ext_vector_type(2)));
typedef short bf16x8 __attribute__((ext_vector_type(8)));

typedef __bf16 hwbf2 __attribute__((ext_vector_type(2)));
__device__ __forceinline__ unsigned cvt2(float lo, float hi) { const f32x2 v = {lo, hi}; return __builtin_bit_cast(unsigned, __builtin_convertvector(v, hwbf2)); }
__device__ __forceinline__ unsigned pk2(float lo, float hi) { return cvt2(lo, hi); }
__device__ __forceinline__ unsigned f2bf(float f) { return cvt2(f, 0.f) & 0xffffu; }
__device__ __forceinline__ float bf2f(unsigned b) { return __builtin_bit_cast(float, b << 16); }
__device__ __forceinline__ float bflo(unsigned w) { return __builtin_bit_cast(float, w << 16); }
__device__ __forceinline__ float bfhi(unsigned w) { return __builtin_bit_cast(float, w & 0xffff0000u); }
__device__ __forceinline__ void unpack8(const u32x4 w, float (&o)[8]) { o[0] = bflo(w.x); o[1] = bfhi(w.x); o[2] = bflo(w.y); o[3] = bfhi(w.y); o[4] = bflo(w.z); o[5] = bfhi(w.z); o[6] = bflo(w.w); o[7] = bfhi(w.w); }
__device__ __forceinline__ float frcp(float x) { return __builtin_amdgcn_rcpf(x); }
__device__ __forceinline__ float sigmoidf_(float x) { return frcp(1.f + __expf(-x)); }
__device__ __forceinline__ float siluf_(float x) { return x * frcp(1.f + __expf(-x)); }
__device__ __forceinline__ float softplusf_(float x) { return x > 15.f ? x : __logf(1.f + __expf(x)); }
__device__ __forceinline__ float gelu_tanh(float x) { const float u = 0.7978845608028654f * (x + 0.044715f * x * x * x); return x * frcp(1.f + __expf(-2.f * u)); }
#define DPPF(v, ctrl) __builtin_bit_cast(float, __builtin_amdgcn_update_dpp(0, __builtin_bit_cast(int, (v)), (ctrl), 0xf, 0xf, true))
__device__ __forceinline__ float row16_sum(float v) {
    v += DPPF(v, 0xB1);
    v += DPPF(v, 0x4E);
    v += DPPF(v, 0x141);
    v += DPPF(v, 0x140);
    return v;
}
__device__ __forceinline__ float wave_sum(float v) {
    v = row16_sum(v);
    return (__builtin_bit_cast(float, __builtin_amdgcn_readlane(__builtin_bit_cast(int, v), 0)) + __builtin_bit_cast(float, __builtin_amdgcn_readlane(__builtin_bit_cast(int, v), 16)))
         + (__builtin_bit_cast(float, __builtin_amdgcn_readlane(__builtin_bit_cast(int, v), 32)) + __builtin_bit_cast(float, __builtin_amdgcn_readlane(__builtin_bit_cast(int, v), 48)));
}
__device__ __forceinline__ float half_sum(float v, int lane) {
    v = row16_sum(v);
    const float a = __builtin_bit_cast(float, __builtin_amdgcn_readlane(__builtin_bit_cast(int, v), 0)) + __builtin_bit_cast(float, __builtin_amdgcn_readlane(__builtin_bit_cast(int, v), 16));
    const float b = __builtin_bit_cast(float, __builtin_amdgcn_readlane(__builtin_bit_cast(int, v), 32)) + __builtin_bit_cast(float, __builtin_amdgcn_readlane(__builtin_bit_cast(int, v), 48));
    return (lane & 32) ? b : a;
}
#define PIN1(a) asm volatile("" : "+v"(a))
#define PIN2(v) asm volatile("" : "+v"((v).x), "+v"((v).y))
#define PIN4(v) asm volatile("" : "+v"((v).x), "+v"((v).y), "+v"((v).z), "+v"((v).w))
#define LDS_WAIT() asm volatile("s_waitcnt lgkmcnt(0)" ::: "memory")
#define LDS_BARRIER() do { asm volatile("s_waitcnt lgkmcnt(0)" ::: "memory"); __builtin_amdgcn_s_barrier(); asm volatile("" ::: "memory"); } while (0)


#define XB_TMO      128
#define XB_XCNT(j)  (256  + 64 * (j))
#define XB_XSUB(j)  (1280 + 64 * (j))
#define XB_XGEN(j)  (2304 + 64 * (j))
#define XB_TOP      3328
#define XB_TOPGEN   3392
#define XCD_BAR_WORDS 3456
#define XB_SPIN_CAP (1u << 18)

__device__ __forceinline__ unsigned xb_ld(unsigned* p)              { return __hip_atomic_load(p, __ATOMIC_RELAXED, __HIP_MEMORY_SCOPE_AGENT); }
__device__ __forceinline__ unsigned xb_add(unsigned* p, unsigned v) { return __hip_atomic_fetch_add(p, v, __ATOMIC_RELAXED, __HIP_MEMORY_SCOPE_AGENT); }
__device__ __forceinline__ unsigned xb_xcc_id() { return (unsigned)__builtin_amdgcn_s_getreg((3 << 11) | 20) & 0xFu; }
#define XB_SPIN(cond, bar) do { unsigned _sp = 0; while (cond) { __builtin_amdgcn_s_sleep(1); \
    if ((++_sp & 255u) == 0u) { if (xb_ld(&(bar)[XB_TMO])) break; if (_sp > XB_SPIN_CAP) { atomicAdd(&(bar)[XB_TMO], 1u); break; } } } } while (0)

struct XcdBarrier {
    unsigned* bar; unsigned x;
    volatile LAS unsigned* st;
};

__device__ __forceinline__ XcdBarrier xcd_barrier_post(unsigned* bar, volatile LAS unsigned* st) {
    XcdBarrier b; b.bar = bar; b.x = xb_xcc_id(); b.st = st;
    if (threadIdx.x == 0) (void)xb_add(&bar[XB_XCNT(b.x)], 1u);
    return b;
}
__device__ __forceinline__ void xcd_barrier_complete(unsigned* bar, unsigned x, unsigned& nloc, unsigned& nx) {
    const unsigned G = gridDim.x * gridDim.y * gridDim.z;
    unsigned sum, cnt, mine, sp = 0u;
    for (;;) {
        sum = 0u; cnt = 0u; mine = 0u;
#pragma unroll
        for (unsigned j = 0; j < 16; ++j) { const unsigned c = xb_ld(&bar[XB_XCNT(j)]); sum += c; cnt += (c > 0u) ? 1u : 0u; mine = (j == x) ? c : mine; }
        if (sum == G) break;
        __builtin_amdgcn_s_sleep(1);
        if ((++sp & 255u) == 0u) { if (xb_ld(&bar[XB_TMO])) break; if (sp > XB_SPIN_CAP) { atomicAdd(&bar[XB_TMO], 1u); break; } }
    }
    nloc = mine > 0u ? mine : 1u; nx = cnt > 0u ? cnt : 1u;
}

__device__ __forceinline__ void xcd_barrier(const XcdBarrier& b) {
    asm volatile("s_waitcnt vmcnt(0)" ::: "memory");
    __syncthreads();
    if (threadIdx.x == 0) {
        unsigned* bar = b.bar;
        __builtin_amdgcn_s_waitcnt(0);
        unsigned nloc = b.st[0], nx = b.st[1];
        if (nloc == 0u) { xcd_barrier_complete(bar, b.x, nloc, nx); b.st[0] = nloc; b.st[1] = nx; }
        const unsigned old = xb_add(&bar[XB_XSUB(b.x)], 1u);
        const unsigned gen = old / nloc;
        if (old + 1u == (gen + 1u) * nloc) {
            __builtin_amdgcn_fence(__ATOMIC_RELEASE, "agent");
            asm volatile("s_waitcnt vmcnt(0)" ::: "memory");
            const unsigned og = xb_add(&bar[XB_TOP], 1u);
            const unsigned tg = og / nx;
            if (og + 1u == (tg + 1u) * nx) xb_add(&bar[XB_TOPGEN], 1u);
            else XB_SPIN(xb_ld(&bar[XB_TOPGEN]) == tg, bar);
            __builtin_amdgcn_fence(__ATOMIC_ACQUIRE, "agent");
            xb_add(&bar[XB_XGEN(b.x)], 1u);
            asm volatile("s_waitcnt vmcnt(0)" ::: "memory");
        } else {
            XB_SPIN(xb_ld(&bar[XB_XGEN(b.x)]) == gen, bar);
            __builtin_amdgcn_fence(__ATOMIC_ACQUIRE, "agent");
            asm volatile("s_waitcnt vmcnt(0)" ::: "memory");
        }
    }
    __syncthreads();
}


struct Params { const float* in[46]; float* out; unsigned char* ws; int ph_lo, ph_hi; };
enum { I_X = 0, I_NORM1, I_WIN, I_HLB, I_HNW, I_S5LR, I_S5LI, I_S5DT, I_S5BR, I_S5BI, I_S5CR, I_S5CI, I_S5D, I_S5GLU, I_RMU, I_RW0, I_RW2, I_RA0, I_RA2, I_RG2,
       I_RKK, I_RKA, I_RRK, I_RV0, I_RV1, I_RV2, I_RLNW, I_RLNB, I_LCW, I_LCB, I_LWA, I_LBA, I_LWX, I_LBX, I_LLAM, I_MGAIN, I_WOUT, I_NORM2, I_MCW, I_MCB, I_MFW, I_MFB,
       I_MWG, I_MWU, I_MWD, I_FNW };

__device__ __forceinline__ void transpose_item(const float* W, int ldw, int k0, int n0, bf16* dst, int K, LAS float* scr, int lane) {
#pragma unroll 8
    for (int i = 0; i < 32; ++i) { const int kk = 2 * i + (lane >> 5); scr[kk * 33 + (lane & 31)] = W[(size_t)(k0 + kk) * ldw + n0 + (lane & 31)]; }
    LDS_WAIT(); asm volatile("" ::: "memory");
    const int c = lane & 7;
#pragma unroll
    for (int j = 0; j < 4; ++j) { const int n = (lane >> 3) + 8 * j; const LAS float* s = scr + (8 * c) * 33 + n;
        u32x4 o; o.x = pk2(s[0 * 33], s[1 * 33]); o.y = pk2(s[2 * 33], s[3 * 33]); o.z = pk2(s[4 * 33], s[5 * 33]); o.w = pk2(s[6 * 33], s[7 * 33]);
        *(u32x4*)(dst + (size_t)n * K + k0 + 8 * c) = o; }
    LDS_WAIT(); asm volatile("" ::: "memory");
}
__device__ __forceinline__ void transpose_item_f8(const float* W, int ldw, int k0, int n0, unsigned char* dst, int Kb, float sc, LAS float* scr, int lane) {
#pragma unroll 8
    for (int i = 0; i < 32; ++i) { const int kk = 2 * i + (lane >> 5); scr[kk * 33 + (lane & 31)] = W[(size_t)(k0 + kk) * ldw + n0 + (lane & 31)]; }
    LDS_WAIT(); asm volatile("" ::: "memory");
    const int c = lane & 7;
#pragma unroll
    for (int j = 0; j < 4; ++j) { const int n = (lane >> 3) + 8 * j; const LAS float* p = scr + (8 * c) * 33 + n; int w0 = 0, w1 = 0;
        w0 = __builtin_amdgcn_cvt_pk_fp8_f32(p[0 * 33] * sc, p[1 * 33] * sc, w0, false); w0 = __builtin_amdgcn_cvt_pk_fp8_f32(p[2 * 33] * sc, p[3 * 33] * sc, w0, true);
        w1 = __builtin_amdgcn_cvt_pk_fp8_f32(p[4 * 33] * sc, p[5 * 33] * sc, w1, false); w1 = __builtin_amdgcn_cvt_pk_fp8_f32(p[6 * 33] * sc, p[7 * 33] * sc, w1, true);
        *(unsigned long long*)(dst + (size_t)n * Kb + k0 + 8 * c) = (unsigned long long)(unsigned)w0 | ((unsigned long long)(unsigned)w1 << 32); }
    LDS_WAIT(); asm volatile("" ::: "memory");
}
constexpr int IT_IN = 16 * 88, IT_OUT = 16 * 32, IT_GLU = 4 * 16, IT_EXP = 32 * 256, IT_LAYER = IT_IN + IT_OUT + IT_GLU + 3 * IT_EXP;
__device__ __forceinline__ void prologue_item(const Params& P, int it, LAS float* scr, int lane) {
    const int l = it / IT_LAYER; int r = it % IT_LAYER;
    bf16* wl = (bf16*)(P.ws + WS_W + (size_t)l * WL_STRIDE);
    if (r < IT_IN) { const int kb = r / 88, nb = r % 88; transpose_item(P.in[I_WIN] + (size_t)l * D * DIN, DIN, 64 * kb, 32 * nb, (bf16*)((unsigned char*)wl + WO_IN) + (size_t)(32 * nb) * D, D, scr, lane); return; } r -= IT_IN;
    if (r < IT_OUT) { const int kb = r / 32, nb = r % 32; transpose_item(P.in[I_WOUT] + (size_t)l * D * D, D, 64 * kb, 32 * nb, (bf16*)((unsigned char*)wl + WO_OUT) + (size_t)(32 * nb) * D, D, scr, lane); return; } r -= IT_OUT;
    if (r < IT_GLU) { const int kb = r / 16, nb = r % 16, n0 = 32 * nb, nn = n0 & 255, drow = (nn >> 7) * 256 + (nn & 127) + ((n0 >> 8) ? 128 : 0);
        transpose_item(P.in[I_S5GLU] + (size_t)l * 256 * 512, 512, 64 * kb, n0, (bf16*)((unsigned char*)wl + WO_GLU) + (size_t)drow * 256, 256, scr, lane); return; } r -= IT_GLU;
    if (r < 2 * IT_EXP) { const int up = r / IT_EXP; r %= IT_EXP; const int e = r >> 8, q = r & 255, kb = q >> 4, nb = q & 15, n0 = 32 * nb, drow = (n0 >> 7) * 256 + (n0 & 127) + (up ? 128 : 0);
        transpose_item_f8(P.in[up ? I_MWU : I_MWG] + (size_t)(l * NEXP + e) * D * DEXP, DEXP, 64 * kb, n0, (unsigned char*)wl + WO_GU + (size_t)e * D * D + (size_t)drow * D, D, 64.f, scr, lane); return; } r -= 2 * IT_EXP;
    { const int e = r >> 8, q = r & 255, kb = q >> 5, nb = q & 31;
      transpose_item_f8(P.in[I_MWD] + (size_t)(l * NEXP + e) * DEXP * D, D, 64 * kb, 32 * nb, (unsigned char*)wl + WO_DN + (size_t)e * D * DEXP + (size_t)(32 * nb) * DEXP, DEXP, 64.f, scr, lane); }
}
__device__ __forceinline__ void rms_store_bf16(const f32x4 (&v)[4], const float* gain, bf16* orow, int lane) {
    float s = 0.f;
#pragma unroll
    for (int j = 0; j < 4; ++j) s += (v[j].x * v[j].x + v[j].y * v[j].y) + (v[j].z * v[j].z + v[j].w * v[j].w);
    const float rstd = 1.f / sqrtf(wave_sum(s) * (1.f / D) + 1e-6f);
    u32x2* o8 = (u32x2*)orow + lane;
#pragma unroll
    for (int j = 0; j < 4; ++j) { const f32x4 g = *((const f32x4*)gain + lane + 64 * j); u32x2 w; w.x = pk2(v[j].x * rstd * g.x, v[j].y * rstd * g.y); w.y = pk2(v[j].z * rstd * g.z, v[j].w * rstd * g.w); o8[64 * j] = w; }
}
__device__ __forceinline__ void s5_pow(float lr, float li, double dt, int j, float& ar, float& ai) {
    const double m = exp((double)lr * dt * (double)j); double ang = (double)li * dt * (double)j; ang -= 6.283185307179586 * rint(ang * 0.15915494309189535);
    ar = (float)(m * cos(ang)); ai = (float)(m * sin(ang));
}
__device__ __forceinline__ void s5_consts_unit(const Params& P, int l, int g, LAS unsigned char* lds, int tid) {
    LAS float* PW = (LAS float*)lds;
    LAS float* BBr = PW + 64 * 17 * 2;
    LAS float* BBi = BBr + 1024;
    LAS float* Cr = BBi + 1024;
    LAS float* Ci = Cr + 1024;
    LAS float* KT = Ci + 1024;
    const int lg = l * 16 + g;
    const double dt = exp((double)P.in[I_S5DT][lg]);
    const float* lrp = P.in[I_S5LR] + (size_t)lg * 64; const float* lip = P.in[I_S5LI] + (size_t)lg * 64;
    for (int idx = tid; idx < 64 * 17; idx += NTHR) { const int p = idx / 17, j = idx % 17; float ar, ai; s5_pow(lrp[p], lip[p], dt, j, ar, ai); PW[idx * 2] = ar; PW[idx * 2 + 1] = ai; }
    for (int idx = tid; idx < 1024; idx += NTHR) { const int p = idx >> 4, c = idx & 15; const float lr = lrp[p], li = lip[p]; float ar, ai; s5_pow(lr, li, dt, 1, ar, ai);
        const float den = lr * lr + li * li, kr = ((ar - 1.f) * lr + ai * li) / den, ki = (ai * lr - (ar - 1.f) * li) / den;
        const float br = P.in[I_S5BR][((size_t)lg * 64 + p) * 16 + c], bi = P.in[I_S5BI][((size_t)lg * 64 + p) * 16 + c];
        BBr[idx] = kr * br - ki * bi; BBi[idx] = kr * bi + ki * br;
        Cr[idx] = P.in[I_S5CR][(size_t)lg * 1024 + idx]; Ci[idx] = P.in[I_S5CI][(size_t)lg * 1024 + idx]; }
    __syncthreads();
    for (int idx = tid; idx < 4096; idx += NTHR) { const int j = idx >> 8, c = (idx >> 4) & 15, cp = idx & 15; float acc = 0.f;
        for (int p = 0; p < 64; ++p) { const float ar = PW[(p * 17 + j) * 2], ai = PW[(p * 17 + j) * 2 + 1], br = BBr[p * 16 + cp], bi = BBi[p * 16 + cp], cr = Cr[c * 64 + p], ci = Ci[c * 64 + p];
            const float zr = ar * br - ai * bi, zi = ar * bi + ai * br; acc += cr * zr - ci * zi; }
        KT[idx] = acc; }
    __syncthreads();
    unsigned char* sb = P.ws + WS_S5 + (size_t)l * S5_STRIDE;
    bf16* F3 = (bf16*)(sb + S5O_F3) + (size_t)g * 98304; bf16* F1 = (bf16*)(sb + S5O_F1) + (size_t)g * 32768; float* A16 = (float*)(sb + S5O_A16) + (size_t)g * 128;
    for (int idx = tid; idx < 98304; idx += NTHR) { const int j = idx & 7, ln = (idx >> 3) & 63, fk = idx >> 9, ks = fk % 12, rt = fk / 12; const int row = 16 * rt + (ln & 15), k = 32 * ks + 8 * (ln >> 4) + j, t = row >> 4, c = row & 15; float val;
        if (k < 256) { const int s2 = k >> 4, cp = k & 15; val = (s2 <= t) ? KT[((t - s2) * 16 + c) * 16 + cp] : 0.f; }
        else { const int n = k - 256, p = n & 63; const float ar = PW[(p * 17 + t + 1) * 2], ai = PW[(p * 17 + t + 1) * 2 + 1], cr = Cr[c * 64 + p], ci = Ci[c * 64 + p]; val = (n < 64) ? (cr * ar - ci * ai) : -(cr * ai + ci * ar); }
        F3[idx] = (bf16)f2bf(val); }
    for (int idx = tid; idx < 32768; idx += NTHR) { const int j = idx & 7, ln = (idx >> 3) & 63, fk = idx >> 9, ks = fk & 7, rt = fk >> 3; const int n = 16 * rt + (ln & 15), k = 32 * ks + 8 * (ln >> 4) + j, p = n & 63, s2 = k >> 4, cp = k & 15;
        const float ar = PW[(p * 17 + 15 - s2) * 2], ai = PW[(p * 17 + 15 - s2) * 2 + 1], br = BBr[p * 16 + cp], bi = BBi[p * 16 + cp];
        F1[idx] = (bf16)f2bf((n < 64) ? (ar * br - ai * bi) : (ar * bi + ai * br)); }
    if (tid < 64) { A16[tid * 2] = PW[(tid * 17 + 16) * 2]; A16[tid * 2 + 1] = PW[(tid * 17 + 16) * 2 + 1]; }
    __syncthreads();
}
__device__ __forceinline__ void ph_prologue(const Params& P, LAS unsigned char* lds, int tid, int lane, int wave) {
    for (int u = blockIdx.x; u < NL * 16; u += gridDim.x) s5_consts_unit(P, u >> 4, u & 15, lds, tid);
    LAS float* scr = (LAS float*)(lds + wave * 16384);
    const int gw = blockIdx.x * NWAVES + wave, NGW = gridDim.x * NWAVES;
    for (int it = gw; it < NL * IT_LAYER; it += NGW) prologue_item(P, it, scr, lane);
    for (int idx = blockIdx.x * NTHR + tid; idx < NL * 256 * 1024; idx += gridDim.x * NTHR) { const int l = idx >> 18, n = (idx >> 10) & 255, k = idx & 1023; float val = 0.f;
        if (n < 72) { const int j = n % 36; const float w = (j < 4) ? P.in[I_MCW][((size_t)l * D + k) * 4 + j] : P.in[I_MFW][(((size_t)l * 4 + ((j - 4) >> 3)) * D + k) * 8 + ((j - 4) & 7)]; val = w * P.in[I_NORM2][(size_t)l * D + k]; }
        const unsigned hi = f2bf(val); const float rem = val - __builtin_bit_cast(float, hi << 16);
        ((bf16*)(P.ws + WS_W + (size_t)l * WL_STRIDE + WO_RT))[(size_t)n * D + k] = (bf16)((n >= 36) ? f2bf(rem) : hi); }
    bf16* act = (bf16*)(P.ws + WS_ACT);
    for (int m = gw; m < NTOK; m += NGW) {
        const f32x4* xr = (const f32x4*)(P.in[I_X] + (size_t)m * D) + lane; f32x4 v[4];
#pragma unroll
        for (int j = 0; j < 4; ++j) v[j] = xr[64 * j];
        rms_store_bf16(v, P.in[I_NORM1], act + (size_t)m * D, lane);
    }
}


__device__ __forceinline__ u32x4 ldg16(const bf16* p) { return *(const u32x4*)p; }

#define MF(a, b, c) __builtin_amdgcn_mfma_f32_16x16x32_bf16((a), (b), (c), 0, 0, 0)
__device__ __forceinline__ u32x2 pack4(const f32x4 d) { u32x2 w; w.x = cvt2(d[0], d[1]); w.y = cvt2(d[2], d[3]); return w; }
__device__ __forceinline__ bf16x8 cat8(const u32x2 lo, const u32x2 hi) { u32x4 w; w.x = lo.x; w.y = lo.y; w.z = hi.x; w.w = hi.y; return __builtin_bit_cast(bf16x8, w); }
__device__ __forceinline__ bf16x8 pack_lo(const f32x4 d) { return cat8(pack4(d), (u32x2){0u, 0u}); }
__device__ __forceinline__ bf16x8 pack2(const f32x4 a, const f32x4 b) { return cat8(pack4(a), pack4(b)); }

__device__ __forceinline__ void role_hgrn(const Params& P, int l, int b, int hd, LAS unsigned char* lds, int tid, int lane, int wave) {
    LAS float* LF = (LAS float*)lds; LAS float* Oa = LF + 1024; LAS float* GamC = Oa + 1024;
    LAS bf16* Qh = (LAS bf16*)(GamC + 64); LAS bf16* Kt = Qh + 16 * 72; LAS bf16* KbarT = Kt + 16 * 72; LAS bf16* VmTb = KbarT + 64 * 24;
    const bf16* proj = (const bf16*)(P.ws + WS_PROJ); bf16* mix = (bf16*)(P.ws + WS_MIX);
    const int tl = tid & 255, tt = tl >> 4, j4 = (tl & 15) * 4, r = lane & 15, q = lane >> 4;
    f32x4 lb = {0.f, 0.f, 0.f, 0.f};
    if (l > 0) {
#pragma unroll
        for (int i = 0; i < 4; ++i) { const int c = hd * 64 + j4 + i; lb[i] = 1.f / (1.f + expf(P.in[I_HLB][c] - P.in[I_HLB][256 + c])); } }
    const f32x4 nw = *(const f32x4*)(P.in[I_HNW] + l * 256 + hd * 64 + j4);
    f32x4 st[4];
#pragma unroll
    for (int i = 0; i < 4; ++i) st[i] = (f32x4){0.f, 0.f, 0.f, 0.f};
    const bf16* pr0 = proj + ((size_t)b * T + tt) * DIN + hd * 64 + j4;
    u32x2 n0, n1; f32x4 qv = lb, kkv = lb, lfv = lb, sgc = lb, sgn = lb;
    if (wave < 4) { n0 = *(const u32x2*)(pr0 + C_HQ); n1 = *(const u32x2*)(pr0 + C_HF); } else { n0 = *(const u32x2*)(pr0 + C_HI); n1 = *(const u32x2*)(pr0 + C_HG); }
#define HG_STAGE_A(c) do { u32x2 rq = n0, rf = n1; PIN2(rq); PIN2(rf); \
        { const int cn_ = (c) + 1 < T / 16 ? (c) + 1 : T / 16 - 1; const bf16* pn = pr0 + (size_t)cn_ * 16 * DIN; n0 = *(const u32x2*)(pn + C_HQ); n1 = *(const u32x2*)(pn + C_HF); } \
        const f32x4 fx = {bflo(rf.x), bfhi(rf.x), bflo(rf.y), bfhi(rf.y)}, qx = {bflo(rq.x), bfhi(rq.x), bflo(rq.y), bfhi(rq.y)}; \
        _Pragma("unroll") for (int i = 0; i < 4; ++i) { const float e = __expf(fminf(-fx[i], 80.f)), ri_ = frcp(1.f + e); const float f = lb[i] + (1.f - lb[i]) * ri_; kkv[i] = (1.f - lb[i]) * e * ri_; lfv[i] = __logf(f); qv[i] = siluf_(qx[i]); } \
        *(LAS f32x4*)(LF + tt * 64 + j4) = lfv; } while (0)
#define HG_STAGE_V(c) do { u32x2 ri = n0, rg = n1; PIN2(ri); PIN2(rg); \
        { const int cn_ = (c) + 1 < T / 16 ? (c) + 1 : T / 16 - 1; const bf16* pn = pr0 + (size_t)cn_ * 16 * DIN; n0 = *(const u32x2*)(pn + C_HI); n1 = *(const u32x2*)(pn + C_HG); } \
        const f32x4 ix = {bflo(ri.x), bfhi(ri.x), bflo(ri.y), bfhi(ri.y)}, gx = {bflo(rg.x), bfhi(rg.x), bflo(rg.y), bfhi(rg.y)}; f32x4 vv; LAS bf16* VmT_ = VmTb + ((c) & 1) * 1536; \
        _Pragma("unroll") for (int i = 0; i < 4; ++i) { vv[i] = siluf_(ix[i]); sgn[i] = siluf_(gx[i]); } \
        { const u32x2 vp = pack4(vv); VmT_[(j4 + 0) * 24 + tt] = (bf16)(vp.x & 0xffffu); VmT_[(j4 + 1) * 24 + tt] = (bf16)(vp.x >> 16); VmT_[(j4 + 2) * 24 + tt] = (bf16)(vp.y & 0xffffu); VmT_[(j4 + 3) * 24 + tt] = (bf16)(vp.y >> 16); } } while (0)
#define HG_STAGE_B(c) do { f32x4 ce = {0.f, 0.f, 0.f, 0.f}, ct = ce; \
        _Pragma("unroll") for (int s2 = 0; s2 < 16; ++s2) { const f32x4 w4 = *(const LAS f32x4*)(LF + s2 * 64 + j4); if (s2 < tt) ce += w4; ct += w4; } \
        const f32x4 ci = ce + lfv; f32x4 qh, kt, kb; \
        _Pragma("unroll") for (int i = 0; i < 4; ++i) { qh[i] = qv[i] * __expf(ci[i]); kt[i] = kkv[i] * __expf(fminf(-ci[i], 80.f)); kb[i] = kkv[i] * __expf(ct[i] - ci[i]); } \
        *(LAS u32x2*)(Qh + tt * 72 + j4) = pack4(qh); *(LAS u32x2*)(Kt + tt * 72 + j4) = pack4(kt); \
        { const u32x2 kbp = pack4(kb); KbarT[(j4 + 0) * 24 + tt] = (bf16)(kbp.x & 0xffffu); KbarT[(j4 + 1) * 24 + tt] = (bf16)(kbp.x >> 16); KbarT[(j4 + 2) * 24 + tt] = (bf16)(kbp.y & 0xffffu); KbarT[(j4 + 3) * 24 + tt] = (bf16)(kbp.y >> 16); } \
        if (tt == 0) { f32x4 gc; _Pragma("unroll") for (int i = 0; i < 4; ++i) gc[i] = __expf(ct[i]); *(LAS f32x4*)(GamC + j4) = gc; } } while (0)
    if (wave < 4) HG_STAGE_A(0); else { HG_STAGE_V(0); sgc = sgn; }
    __syncthreads();
    if (wave < 4) HG_STAGE_B(0);
    __syncthreads();
    if (wave < 4) {
#pragma unroll 1
        for (int c = 0; c < T / 16; ++c) { const int cn = c + 1 < T / 16 ? c + 1 : T / 16 - 1;
            HG_STAGE_A(cn); LDS_BARRIER(); HG_STAGE_B(cn); LDS_BARRIER(); }
    } else {
#pragma unroll 1
        for (int c = 0; c < T / 16; ++c) { const int cn = c + 1 < T / 16 ? c + 1 : T / 16 - 1;
            { const int vt = wave - 4; const f32x4 z4 = {0.f, 0.f, 0.f, 0.f}; f32x4 AT = z4, o = z4; const LAS bf16* VmT_ = VmTb + (c & 1) * 1536;
#pragma unroll
              for (int ks = 0; ks < 2; ++ks) AT = MF(*(const LAS bf16x8*)(Kt + r * 72 + ks * 32 + q * 8), *(const LAS bf16x8*)(Qh + r * 72 + ks * 32 + q * 8), AT);
#pragma unroll
              for (int i = 0; i < 4; ++i) AT[i] = (4 * q + i <= r) ? AT[i] : 0.f;
              const u32x2 vmB = *(const LAS u32x2*)(VmT_ + (16 * vt + r) * 24 + 4 * q); const bf16x8 bV = cat8(vmB, (u32x2){0u, 0u});
#pragma unroll
              for (int ks = 0; ks < 2; ++ks) o = MF(cat8(*(const LAS u32x2*)(Qh + r * 72 + 32 * ks + 4 * q), *(const LAS u32x2*)(Qh + r * 72 + 32 * ks + 16 + 4 * q)), pack2(st[2 * ks], st[2 * ks + 1]), o);
              o = MF(pack_lo(AT), bV, o);
#pragma unroll
              for (int i = 0; i < 4; ++i) Oa[(4 * q + i) * 64 + 16 * vt + r] = o[i];
#pragma unroll
              for (int kt = 0; kt < 4; ++kt) { const f32x4 g4 = *(const LAS f32x4*)(GamC + 16 * kt + 4 * q);
                  st[kt] = MF(cat8(*(const LAS u32x2*)(KbarT + (16 * kt + r) * 24 + 4 * q), (u32x2){0u, 0u}), bV, st[kt] * g4); } }
            LDS_BARRIER();
            { const f32x4 o4 = *(const LAS f32x4*)(Oa + tt * 64 + j4);
              const float ss = row16_sum((o4[0] * o4[0] + o4[1] * o4[1]) + (o4[2] * o4[2] + o4[3] * o4[3])); const float rs = __builtin_amdgcn_rsqf(ss * (1.f / 64.f) + 1e-6f);
              *(u32x2*)(mix + ((size_t)b * T + c * 16 + tt) * D + hd * 64 + j4) = pack4(o4 * rs * nw * sgc);
              HG_STAGE_V(cn); sgc = sgn; }
            LDS_BARRIER(); }
    }
#undef HG_STAGE_A
#undef HG_STAGE_V
#undef HG_STAGE_B
}

__device__ __forceinline__ f32x4 mma_tile(const LAS bf16* A, int lda, const LAS bf16* Bt, int ldb, int K, int lane) {
    f32x4 acc = {0.f, 0.f, 0.f, 0.f}; const int r = lane & 15, q = lane >> 4;
    for (int k0 = 0; k0 < K; k0 += 32) { const bf16x8 a = *(const LAS bf16x8*)(A + r * lda + k0 + q * 8); const bf16x8 b = *(const LAS bf16x8*)(Bt + r * ldb + k0 + q * 8);
        acc = __builtin_amdgcn_mfma_f32_16x16x32_bf16(a, b, acc, 0, 0, 0); }
    return acc;
}
__device__ __forceinline__ void lds_load_wT(const float* W, int ldw, int n0, int N, int K, LAS bf16* Wt, int ldt, int tid) {
#pragma unroll 2
    for (int idx = tid; idx < K * N; idx += NTHR) { const int k = idx / N, n = idx % N; Wt[n * ldt + k] = (bf16)f2bf(W[(size_t)k * ldw + n0 + n]); }
}

__device__ __forceinline__ void role_lru(const Params& P, int l, int b, int hd, LAS unsigned char* lds, int tid, int lane, int wave) {
    LAS float* XR = (LAS float*)lds; LAS float* LG = XR + 67 * 64; LAS float* XC = LG + 4096; LAS float* RL = XC + 4096; LAS float* GL = RL + 4096;
    LAS bf16* XCb = (LAS bf16*)(GL + 4096); LAS bf16* WaT = XCb + 64 * 72; LAS bf16* WxT = WaT + 64 * 72; LAS float* CWL = (LAS float*)(WxT + 64 * 72);
    const bf16* proj = (const bf16*)(P.ws + WS_PROJ); bf16* mix = (bf16*)(P.ws + WS_MIX);
    const int tt = tid >> 3, c8 = (tid & 7) * 8;
    lds_load_wT(P.in[I_LWA] + (size_t)(l * 4 + hd) * 4096, 64, 0, 64, 64, WaT, 72, tid);
    lds_load_wT(P.in[I_LWX] + (size_t)(l * 4 + hd) * 4096, 64, 0, 64, 64, WxT, 72, tid);
    if (tid < 320) { const int jj = tid >> 6, c = tid & 63; CWL[tid] = (jj < 4) ? P.in[I_LCW][(size_t)l * 4 * 256 + jj * 256 + hd * 64 + c] : P.in[I_LCB][l * 256 + hd * 64 + c]; }
    if (tid < 24) {
#pragma unroll
        for (int i = 0; i < 8; ++i) XR[(tid >> 3) * 64 + c8 + i] = 0.f; }
    float pba[2], pbx[2], pspl[2];
#pragma unroll
    for (int h2 = 0; h2 < 2; ++h2) { const int j = ((wave >> 2) * 2 + h2) * 16 + (lane & 15), c = l * 256 + hd * 64 + j; pba[h2] = P.in[I_LBA][c]; pbx[h2] = P.in[I_LBX][c]; pspl[h2] = log1pf(expf(-P.in[I_LLAM][c])); }
    float hstate = 0.f;
    const bf16* px = proj + ((size_t)b * T + tt) * DIN + C_LX + hd * 64 + c8; const bf16* pgp = proj + ((size_t)b * T + tt) * DIN + C_LG + hd * 64 + c8;
    u32x4 nx = ldg16(px), ngt = ldg16(pgp);
    __syncthreads();
#pragma unroll 1
    for (int blk = 0; blk < T / 64; ++blk) {
        const int t0 = blk * 64;
        {   float x[8], g[8]; unpack8(nx, x); unpack8(ngt, g);
            if (blk + 1 < T / 64) { nx = ldg16(px + (size_t)(t0 + 64) * DIN); ngt = ldg16(pgp + (size_t)(t0 + 64) * DIN); }
#pragma unroll
            for (int i = 0; i < 8; ++i) { XR[(tt + 3) * 64 + c8 + i] = x[i]; LG[tt * 64 + c8 + i] = g[i]; }
        }
        LDS_BARRIER();
        {   float xc[8];
#pragma unroll
            for (int i = 0; i < 8; ++i) { const int c = c8 + i; float a = CWL[256 + c];
#pragma unroll
                for (int jj = 0; jj < 4; ++jj) a += CWL[jj * 64 + c] * XR[(tt + jj) * 64 + c];
                XC[tt * 64 + c] = a; xc[i] = a; }
            u32x4 w; w.x = cvt2(xc[0], xc[1]); w.y = cvt2(xc[2], xc[3]); w.z = cvt2(xc[4], xc[5]); w.w = cvt2(xc[6], xc[7]); *(LAS u32x4*)(XCb + tt * 72 + c8) = w; }
        LDS_BARRIER();
        {   const int tt4 = wave & 3, r = lane & 15, q = lane >> 4;
#pragma unroll
            for (int h2 = 0; h2 < 2; ++h2) { const int nt = (wave >> 2) * 2 + h2, j = nt * 16 + r;
                const f32x4 ar = mma_tile(XCb + tt4 * 16 * 72, 72, WaT + nt * 16 * 72, 72, 64, lane), ag = mma_tile(XCb + tt4 * 16 * 72, 72, WxT + nt * 16 * 72, 72, 64, lane);
#pragma unroll
                for (int i = 0; i < 4; ++i) { const int t = tt4 * 16 + q * 4 + i; const float rr = sigmoidf_(ar[i] + pba[h2]), gi = sigmoidf_(ag[i] + pbx[h2]); const float la = -8.f * rr * pspl[h2];
                    const float e2 = __expf(2.f * la); RL[t * 64 + j] = __expf(la); GL[t * 64 + j] = sqrtf(1.f - e2) * gi * XC[t * 64 + j]; } }
            if (tid < 24) {
#pragma unroll
                for (int i = 0; i < 8; ++i) XR[(tid >> 3) * 64 + c8 + i] = XR[(64 + (tid >> 3)) * 64 + c8 + i]; }
        }
        LDS_BARRIER();
        if (tid < 64) {
#pragma unroll 8
            for (int t = 0; t < 64; ++t) { hstate = RL[t * 64 + tid] * hstate + GL[t * 64 + tid]; XC[t * 64 + tid] = hstate; } }
        LDS_BARRIER();
        {   u32x4 w; float o[8];
#pragma unroll
            for (int i = 0; i < 8; ++i) o[i] = gelu_tanh(LG[tt * 64 + c8 + i]) * XC[tt * 64 + c8 + i];
            w.x = cvt2(o[0], o[1]); w.y = cvt2(o[2], o[3]); w.z = cvt2(o[4], o[5]); w.w = cvt2(o[6], o[7]);
            *(u32x4*)(mix + ((size_t)b * T + t0 + tt) * D + 768 + hd * 64 + c8) = w; }
        LDS_BARRIER();
    }
}

__device__ __forceinline__ void s5_stage_u(const bf16* proj, int b, int g, int t0, LAS unsigned char* UL, int tid) {
#pragma unroll
    for (int rep = 0; rep < 4; ++rep) { const int tk = rep * 256 + (tid >> 1), half = tid & 1; const u32x4 v = ldg16(proj + ((size_t)b * T + t0 + tk) * DIN + C_SU + g * 16 + half * 8);
        const int cl = tk >> 4, s = tk & 15; *(LAS u32x4*)(UL + (cl >> 4) * 8192 + ((s * 16 + (cl & 15)) * 32 + half * 16)) = v; }
}
__device__ __forceinline__ void role_s5(const Params& P, int l, int b, int g, LAS unsigned char* lds, int tid, int lane, int wave) {
    LAS unsigned char* UL = lds; LAS unsigned char* XL = lds + 32768; LAS float* ES = (LAS float*)(lds + 49152);
    const bf16* proj = (const bf16*)(P.ws + WS_PROJ); bf16* yg = (bf16*)(P.ws + WS_YG);
    const unsigned char* sb = P.ws + WS_S5 + (size_t)l * S5_STRIDE;
    const bf16* F3 = (const bf16*)(sb + S5O_F3) + (size_t)g * 98304; const bf16* F1 = (const bf16*)(sb + S5O_F1) + (size_t)g * 32768; const float* A16 = (const float*)(sb + S5O_A16) + (size_t)g * 128;
    float* Hu = (float*)(P.ws + WS_HU) + (size_t)(b * 16 + g) * 512 * 128; float* Xs = (float*)(P.ws + WS_XS) + (size_t)(b * 16 + g) * 512 * 128;
    const int c16 = lane & 15, q = lane >> 4;
    {
        bf16x8 af[8];
#pragma unroll
        for (int ks = 0; ks < 8; ++ks) af[ks] = *(const bf16x8*)(F1 + ((size_t)(wave * 8 + ks) * 64 + lane) * 8);
#pragma unroll 1
        for (int it = 0; it < 8; ++it) {
            s5_stage_u(proj, b, g, it * 1024, UL, tid);
            __syncthreads();
#pragma unroll 1
            for (int ct = 0; ct < 4; ++ct) { f32x4 acc = {0.f, 0.f, 0.f, 0.f};
#pragma unroll
                for (int ks = 0; ks < 8; ++ks) { const bf16x8 bv = *(const LAS bf16x8*)(UL + ct * 8192 + (((2 * ks + (q >> 1)) * 16 + c16) * 32 + (q & 1) * 16)); acc = __builtin_amdgcn_mfma_f32_16x16x32_bf16(af[ks], bv, acc, 0, 0, 0); }
                *(f32x4*)(Hu + (size_t)(it * 64 + ct * 16 + c16) * 128 + 16 * wave + 4 * q) = acc; }
            __syncthreads();
        }
    }
    __threadfence(); __syncthreads();
    {
        const float ar = A16[lane * 2], ai = A16[lane * 2 + 1]; const float* hb = Hu + (size_t)(wave * 64) * 128; float xr = 0.f, xi = 0.f;
#pragma unroll 8
        for (int j = 0; j < 64; ++j) { const float hr = hb[j * 128 + lane], hi = hb[j * 128 + 64 + lane]; const float nr = ar * xr - ai * xi + hr, ni = ar * xi + ai * xr + hi; xr = nr; xi = ni; }
        ES[wave * 128 + lane] = xr; ES[wave * 128 + 64 + lane] = xi;
        __syncthreads();
        float pr = ar, pi = ai;
#pragma unroll
        for (int i = 0; i < 6; ++i) { const float nr = pr * pr - pi * pi, ni = 2.f * pr * pi; pr = nr; pi = ni; }
        float cr = 0.f, ci = 0.f;
        for (int w2 = 0; w2 < wave; ++w2) { const float er = ES[w2 * 128 + lane], ei = ES[w2 * 128 + 64 + lane]; const float nr = pr * cr - pi * ci + er, ni = pr * ci + pi * cr + ei; cr = nr; ci = ni; }
        xr = cr; xi = ci; float* xb = Xs + (size_t)(wave * 64) * 128;
#pragma unroll 8
        for (int j = 0; j < 64; ++j) { const float hr = hb[j * 128 + lane], hi = hb[j * 128 + 64 + lane]; xb[j * 128 + lane] = xr; xb[j * 128 + 64 + lane] = xi; const float nr = ar * xr - ai * xi + hr, ni = ar * xi + ai * xr + hi; xr = nr; xi = ni; }
    }
    __threadfence(); __syncthreads();
    {
        bf16x8 af[2][12];
#pragma unroll
        for (int r2 = 0; r2 < 2; ++r2)
#pragma unroll
            for (int ks = 0; ks < 12; ++ks) af[r2][ks] = *(const bf16x8*)(F3 + ((size_t)((2 * wave + r2) * 12 + ks) * 64 + lane) * 8);
        float dsk[4];
#pragma unroll
        for (int i = 0; i < 4; ++i) dsk[i] = P.in[I_S5D][l * 256 + g * 16 + 4 * q + i];
#pragma unroll 1
        for (int it = 0; it < 8; ++it) {
            s5_stage_u(proj, b, g, it * 1024, UL, tid);
#pragma unroll
            for (int rep = 0; rep < 4; ++rep) { const int cl = rep * 16 + (tid >> 5), n4 = (tid & 31) * 4; const f32x4 x = *(const f32x4*)(Xs + (size_t)(it * 64 + cl) * 128 + n4);
                u32x2 w; w.x = pk2(x.x, x.y); w.y = pk2(x.z, x.w);
                *(LAS u32x2*)(XL + (cl >> 4) * 4096 + ((((n4 >> 5) * 4 + ((n4 >> 3) & 3)) * 16 + (cl & 15)) * 16 + (n4 & 7) * 2)) = w; }
            __syncthreads();
#pragma unroll 1
            for (int ct = 0; ct < 4; ++ct) { f32x4 acc0 = {0.f, 0.f, 0.f, 0.f}, acc1 = {0.f, 0.f, 0.f, 0.f};
#pragma unroll
                for (int ks = 0; ks < 8; ++ks) { const bf16x8 bv = *(const LAS bf16x8*)(UL + ct * 8192 + (((2 * ks + (q >> 1)) * 16 + c16) * 32 + (q & 1) * 16));
                    acc0 = __builtin_amdgcn_mfma_f32_16x16x32_bf16(af[0][ks], bv, acc0, 0, 0, 0); acc1 = __builtin_amdgcn_mfma_f32_16x16x32_bf16(af[1][ks], bv, acc1, 0, 0, 0); }
#pragma unroll
                for (int ks = 0; ks < 4; ++ks) { const bf16x8 bv = *(const LAS bf16x8*)(XL + ct * 4096 + ((ks * 4 + q) * 16 + c16) * 16);
                    acc0 = __builtin_amdgcn_mfma_f32_16x16x32_bf16(af[0][8 + ks], bv, acc0, 0, 0, 0); acc1 = __builtin_amdgcn_mfma_f32_16x16x32_bf16(af[1][8 + ks], bv, acc1, 0, 0, 0); }
#pragma unroll
                for (int r2 = 0; r2 < 2; ++r2) { const int t = 2 * wave + r2; const f32x4 acc = r2 ? acc1 : acc0;
                    const u32x2 uw = *(const LAS u32x2*)(UL + ct * 8192 + ((t * 16 + c16) * 32 + (4 * q) * 2));
                    const float y0 = gelu_tanh(acc[0] + dsk[0] * bflo(uw.x)), y1 = gelu_tanh(acc[1] + dsk[1] * bfhi(uw.x)), y2 = gelu_tanh(acc[2] + dsk[2] * bflo(uw.y)), y3 = gelu_tanh(acc[3] + dsk[3] * bfhi(uw.y));
                    u32x2 o; o.x = pk2(y0, y1); o.y = pk2(y2, y3);
                    *(u32x2*)(yg + ((size_t)b * T + it * 1024 + (ct * 16 + c16) * 16 + t) * 256 + g * 16 + 4 * q) = o; } }
            __syncthreads();
        }
    }
}

__device__ __forceinline__ void rw_load8(const bf16* cur, const bf16* prev, const float* mu, float (&o)[8]) {
    float p[8], q[8]; unpack8(ldg16(cur), p);
    if (prev) unpack8(ldg16(prev), q); else {
#pragma unroll
        for (int i = 0; i < 8; ++i) q[i] = 0.f; }
    const f32x4 m0 = *(const f32x4*)mu, m1 = *(const f32x4*)(mu + 4);
#pragma unroll
    for (int i = 0; i < 4; ++i) { o[i] = p[i] + m0[i] * (q[i] - p[i]); o[4 + i] = p[4 + i] + m1[i] * (q[4 + i] - p[4 + i]); }
}
__device__ __forceinline__ void rw_mix8(const u32x4 c, const u32x4 pv, const LAS float* mu, float (&o)[8]) {
    float p[8], q[8]; unpack8(c, p); unpack8(pv, q);
    const f32x4 m0 = *(const LAS f32x4*)mu, m1 = *(const LAS f32x4*)(mu + 4);
#pragma unroll
    for (int i = 0; i < 4; ++i) { o[i] = p[i] + m0[i] * (q[i] - p[i]); o[4 + i] = p[4 + i] + m1[i] * (q[4 + i] - p[4 + i]); }
}
__device__ __forceinline__ void st8f(LAS float* d, const float (&o)[8]) { *(LAS f32x4*)d = (f32x4){o[0], o[1], o[2], o[3]}; *(LAS f32x4*)(d + 4) = (f32x4){o[4], o[5], o[6], o[7]}; }
__device__ __forceinline__ void st8b(LAS bf16* d, const float (&o)[8]) { u32x4 w; w.x = cvt2(o[0], o[1]); w.y = cvt2(o[2], o[3]); w.z = cvt2(o[4], o[5]); w.w = cvt2(o[6], o[7]); *(LAS u32x4*)d = w; }
constexpr int RW_SLAB = 64, RW_NSLAB = 8, RW_RING = 3, RW_RUN = 8;
constexpr size_t RWB_STRIDE = 18944;
constexpr int RWB_WQ = 0, RWB_BB = 4096, RWB_KB = 6144, RWB_VM = 8192, RWB_GC = 10240, RWB_W2 = 10496, RWB_YL = 12544, RWB_G = 14592, RWB_BON = 16640;
constexpr int CW_TMO = 64, CW_RWP = 16384, CW_RWC = 32768;
static_assert((size_t)32 * RW_RING * RW_SLAB * RWB_STRIDE <= (size_t)128 * MiB, "bundle ring fits the ACT buffer");
__device__ __forceinline__ unsigned char* rw_bundle(const Params& P, int seq, int chunk) { return P.ws + WS_ACT + (size_t)((seq * RW_RING + ((chunk >> 6) % RW_RING)) * RW_SLAB + (chunk & 63)) * RWB_STRIDE; }
#define RLX_AGENT __ATOMIC_RELAXED, __HIP_MEMORY_SCOPE_AGENT
__device__ __forceinline__ void st_wt8(void* p, u32x2 v) { __hip_atomic_store((unsigned long long*)p, (unsigned long long)v.x | ((unsigned long long)v.y << 32), RLX_AGENT); }
__device__ __forceinline__ void wait_ge(unsigned* word, unsigned want, unsigned* tmo) {
    unsigned spins = 0;
    while ((unsigned)__builtin_amdgcn_readfirstlane(__hip_atomic_load(word, RLX_AGENT)) < want) {
        __builtin_amdgcn_s_sleep(2);
        if (++spins > (1u << 20)) { __hip_atomic_store(tmo, 1u, RLX_AGENT); break; }
        if ((spins & 1023u) == 0u && __builtin_amdgcn_readfirstlane(__hip_atomic_load(tmo, RLX_AGENT))) break;
    }
}
__device__ __forceinline__ void rwkv_producer(const Params& P, int l, int hd, int gp, int NPG, LAS unsigned char* lds, int tid, int lane, int wave) {
    unsigned* ctl = (unsigned*)(P.ws + WS_CTL);
    LAS bf16* W2T = (LAS bf16*)lds;
    LAS bf16* A2T = W2T + 64 * 72;
    LAS bf16* G2T = A2T + 64 * 72;
    LAS bf16* V1T = G2T + 64 * 136;
    LAS bf16* V2T = V1T + 32 * 264;
    LAS bf16* TWD = V2T + 64 * 40;
    LAS bf16* ADb = TWD + 16 * 72;
    LAS bf16* SGD = ADb + 16 * 72;
    LAS bf16* VALb = SGD + 16 * 136;
    LAS bf16* VHb = VALb + 16 * 264;
    LAS float* R = (LAS float*)(VHb + 16 * 40); LAS float* K = R + 1024; LAS float* V = K + 1024; LAS float* WL = V + 1024; LAS float* KK = WL + 1024; LAS float* Bb = KK + 1024;
    LAS float* G = Bb + 1024; LAS float* Y = G + 1024; LAS float* RK = Y + 1024  ; LAS float* AL = RK + 16; LAS float* VG = AL + 1024;
    LAS bf16* KKh = TWD; LAS bf16* Rh = KKh + 16 * 72; LAS bf16* Bt = Rh + 16 * 72; LAS bf16* Kt = Bt + 16 * 72; LAS bf16* BbarT = Kt + 16 * 72; LAS bf16* KbarT = BbarT + 64 * 24;
    LAS bf16* VmT = (LAS bf16*)AL; LAS bf16* KKhT = VmT + 64 * 24; LAS bf16* RhT = KKhT + 64 * 24; LAS float* GamC = (LAS float*)(RhT + 64 * 24); LAS bf16* WQ = (LAS bf16*)(GamC + 64); LAS float* MU = (LAS float*)(WQ + 32 * 72); LAS float* PT = MU + 1024;
    const bf16* proj = (const bf16*)(P.ws + WS_PROJ); bf16* mix = (bf16*)(P.ws + WS_MIX); bf16* vf = (bf16*)(P.ws + WS_VF);
    const float* mu_base = P.in[I_RMU] + (size_t)l * 1024;
    lds_load_wT(P.in[I_RW2] + (size_t)l * 64 * 256, 256, hd * 64, 64, 64, W2T, 72, tid);
    lds_load_wT(P.in[I_RA2] + (size_t)l * 64 * 256, 256, hd * 64, 64, 64, A2T, 72, tid);
    lds_load_wT(P.in[I_RG2] + (size_t)l * 128 * 256, 256, hd * 64, 64, 128, G2T, 136, tid);
    if (l > 0) { lds_load_wT(P.in[I_RV1], 32, 0, 32, 256, V1T, 264, tid); lds_load_wT(P.in[I_RV2], 256, hd * 64, 64, 32, V2T, 40, tid); }
    const int tt0 = tid >> 5, l320 = tid & 31;
    for (int i = tid; i < 1024; i += NTHR) MU[i] = mu_base[i];
    if (tid < 64) { const int c = l * 256 + hd * 64 + tid; PT[tid] = P.in[I_RW0][c]; PT[64 + tid] = P.in[I_RA0][c]; PT[128 + tid] = P.in[I_RKK][c]; PT[192 + tid] = P.in[I_RKA][c]; PT[256 + tid] = P.in[I_RRK][c];
        PT[320 + tid] = (l > 0) ? P.in[I_RV0][hd * 64 + tid] : 0.f; PT[384 + tid] = P.in[I_RLNW][c]; PT[448 + tid] = P.in[I_RLNB][c]; }
    const int segA = l320 >> 3, chA = l320 & 7, colA = (segA == 0 ? hd * 64 : segA == 1 ? 256 + hd * 64 : segA == 2 ? 768 : 832) + chA * 8, colB = 896 + (l320 & 15) * 8;
    const bool hasB = l320 < 16, hasC = (l > 0) || (l320 >= 16 && l320 < 24); const int colC = (l > 0) ? 512 + l320 * 8 : 512 + hd * 64 + (l320 & 7) * 8;
    const u32x4 zero4 = {0u, 0u, 0u, 0u};
    __syncthreads();
#pragma unroll 1
    for (int u = gp; u < 512; u += NPG) {
    const int slab = u >> 6, b = (u >> 3) & 7, run = u & 7, seq = b * 4 + hd, cfirst = slab * RW_SLAB + run * RW_RUN;
    if (slab >= RW_RING) { if (wave == 0) wait_ge(ctl + CW_RWC + l * 1024 + seq * 16, (unsigned)(slab - RW_RING + 1), ctl + CW_TMO); __syncthreads(); }
    const bf16* rowp = proj + ((size_t)b * T + tt0) * DIN + C_RW; const bf16* vfp = vf + ((size_t)b * T + tt0) * 256 + hd * 64 + l320 * 2;
    u32x4 nAc, nAp, nBc = zero4, nBp = zero4, nCc = zero4, nCp = zero4; unsigned nvf = 0u;
    {   const bf16* rn = rowp + (size_t)(cfirst * 16) * DIN; const bool hp = (cfirst * 16 + tt0) > 0;
        nAc = ldg16(rn + colA); nAp = hp ? ldg16(rn - DIN + colA) : zero4;
        if (hasB) { nBc = ldg16(rn + colB); nBp = hp ? ldg16(rn - DIN + colB) : zero4; }
        if (hasC) { nCc = ldg16(rn + colC); nCp = hp ? ldg16(rn - DIN + colC) : zero4; }
        if (l > 0) nvf = *(const unsigned*)(vfp + (size_t)(cfirst * 16) * 256); }
    PIN4(nAc); PIN4(nAp); PIN4(nBc); PIN4(nBp); PIN4(nCc); PIN4(nCp); PIN1(nvf);
#pragma unroll 1
    for (int blk = cfirst; blk < cfirst + RW_RUN; ++blk) {
        const int t0 = blk * 16; int tidl = tid; asm volatile("" : "+v"(tidl));
        const int tt = tidl >> 5, l32 = tidl & 31, lane = tidl & 63;
        const u32x4 rAc = nAc, rAp = nAp, rBc = nBc, rBp = nBp, rCc = nCc, rCp = nCp; const unsigned rvf = nvf;
        {
            const int tn = (blk + 1 < cfirst + RW_RUN) ? t0 + 16 : t0; const bf16* rn = rowp + (size_t)tn * DIN; const int cB_ = hasB ? colB : colA, cC_ = hasC ? colC : colA;
            nAc = ldg16(rn + colA); nAp = ldg16(rn - DIN + colA);
            nBc = ldg16(rn + cB_); nBp = ldg16(rn - DIN + cB_);
            nCc = ldg16(rn + cC_); nCp = ldg16(rn - DIN + cC_);
            if (l > 0) nvf = *(const unsigned*)(vfp + (size_t)tn * 256); }
        unsigned char* bp = rw_bundle(P, seq, blk);
        {   float o[8];
            rw_mix8(rAc, rAp, MU + colA, o);
            if (segA == 0) st8f(R + tt * 64 + chA * 8, o); else if (segA == 1) st8f(K + tt * 64 + chA * 8, o);
            else if (segA == 2) {
#pragma unroll
                for (int i = 0; i < 8; ++i) { const float e = __expf(2.f * o[i]); o[i] = 1.f - 2.f * frcp(e + 1.f); }
                st8b(TWD + tt * 72 + chA * 8, o); }
            else st8b(ADb + tt * 72 + chA * 8, o);
            if (hasB) { rw_mix8(rBc, rBp, MU + colB, o);
#pragma unroll
                for (int i = 0; i < 8; ++i) o[i] = sigmoidf_(o[i]);
                st8b(SGD + tt * 136 + (l32 & 15) * 8, o); }
            if (hasC) { rw_mix8(rCc, rCp, MU + colC, o);
                if (l == 0) st8f(V + tt * 64 + (l32 & 7) * 8, o);
                else { st8b(VALb + tt * 264 + l32 * 8, o); if ((l32 >> 3) == hd) st8f(V + tt * 64 + (l32 & 7) * 8, o); } }
        }
        LDS_BARRIER();
        {   const int r = lane & 15, q = lane >> 4;
            if (wave < 4) { const f32x4 cw_ = mma_tile(TWD, 72, W2T + wave * 16 * 72, 72, 64, lane), ca = mma_tile(ADb, 72, A2T + wave * 16 * 72, 72, 64, lane);
#pragma unroll
                for (int i = 0; i < 4; ++i) { WL[(q * 4 + i) * 64 + wave * 16 + r] = cw_[i]; AL[(q * 4 + i) * 64 + wave * 16 + r] = ca[i]; }
                if (l > 0 && wave < 2) { const f32x4 ch_ = mma_tile(VALb, 264, V1T + wave * 16 * 264, 264, 256, lane);
#pragma unroll
                    for (int i = 0; i < 4; ++i) VHb[(q * 4 + i) * 40 + wave * 16 + r] = (bf16)f2bf(ch_[i]); } }
            else { const int nt = wave - 4; const f32x4 cg = mma_tile(SGD, 136, G2T + nt * 16 * 136, 136, 128, lane);
#pragma unroll
                for (int i = 0; i < 4; ++i) G[(q * 4 + i) * 64 + nt * 16 + r] = cg[i]; }
        }
        LDS_BARRIER();
        if (l > 0) {
            if (wave < 4) { const int r = lane & 15, q = lane >> 4; const f32x4 cv = mma_tile(VHb, 40, V2T + wave * 16 * 40, 40, 32, lane);
#pragma unroll
                for (int i = 0; i < 4; ++i) VG[(q * 4 + i) * 64 + wave * 16 + r] = cv[i]; }
            LDS_BARRIER();
        }
        {   const int j2 = l32 * 2; float ssq = 0.f, rk = 0.f; float kkv[2], av[2], vv2[2];
            const size_t tok = (size_t)b * T + t0 + tt;
#pragma unroll
            for (int i = 0; i < 2; ++i) { const int j = j2 + i, x = tt * 64 + j;
                const float wl = -softplusf_(-(PT[j] + WL[x])) - 0.5f; WL[x] = -__expf(wl);
                const float a = sigmoidf_(PT[64 + j] + AL[x]); av[i] = a;
                const float kr = K[x]; kkv[i] = kr * PT[128 + j]; ssq += kkv[i] * kkv[i];
                const float km = kr * (1.f + (a - 1.f) * PT[192 + j]); K[x] = km;
                float v = V[x];
                if (l > 0) { const float vfv = i ? bfhi(rvf) : bflo(rvf); v = v + (vfv - v) * sigmoidf_(PT[320 + j] + VG[x]); V[x] = v; }
                vv2[i] = v;
                rk += R[x] * km * PT[256 + j]; }
            if (l == 0) *(unsigned*)(vf + tok * 256 + hd * 64 + j2) = cvt2(vv2[0], vv2[1]);
            ssq = half_sum(ssq, lane); rk = half_sum(rk, lane);
            const float inv = frcp(fmaxf(sqrtf(ssq), 1e-12f));
#pragma unroll
            for (int i = 0; i < 2; ++i) { const int x = tt * 64 + j2 + i; const float kn = kkv[i] * inv; KK[x] = kn; Bb[x] = kn * av[i]; }
            if (l32 == 0) RK[tt] = rk;
        }
        LDS_BARRIER();
        {   const int j2 = l32 * 2; float ce0 = 0.f, ce1 = 0.f, ct0 = 0.f, ct1 = 0.f;
#pragma unroll
            for (int s2 = 0; s2 < 16; ++s2) { const f32x2 w2 = *(const LAS f32x2*)(WL + s2 * 64 + j2); if (s2 < tt) { ce0 += w2.x; ce1 += w2.y; } ct0 += w2.x; ct1 += w2.y; }
            const f32x2 wme = *(const LAS f32x2*)(WL + tt * 64 + j2); const float ci0 = ce0 + wme.x, ci1 = ce1 + wme.y;
            const float ex0 = __expf(ce0), ex1 = __expf(ce1), in0 = __expf(ci0), in1 = __expf(ci1), ng0 = __expf(-ci0), ng1 = __expf(-ci1), br0 = __expf(ct0 - ci0), br1 = __expf(ct1 - ci1);
            const int x = tt * 64 + j2; const f32x2 kk2 = *(const LAS f32x2*)(KK + x), r2 = *(const LAS f32x2*)(R + x), b2 = *(const LAS f32x2*)(Bb + x), k2 = *(const LAS f32x2*)(K + x), v2_ = *(const LAS f32x2*)(V + x);
            const unsigned kkh = cvt2(kk2.x * ex0, kk2.y * ex1), rh = cvt2(r2.x * in0, r2.y * in1);
            *(LAS unsigned*)(KKh + tt * 72 + j2) = kkh; *(LAS unsigned*)(Rh + tt * 72 + j2) = rh;
            *(LAS unsigned*)(Bt + tt * 72 + j2) = cvt2(b2.x * ng0, b2.y * ng1); *(LAS unsigned*)(Kt + tt * 72 + j2) = cvt2(k2.x * ng0, k2.y * ng1);
            KKhT[j2 * 24 + tt] = (bf16)(kkh & 0xffffu); KKhT[(j2 + 1) * 24 + tt] = (bf16)(kkh >> 16); RhT[j2 * 24 + tt] = (bf16)(rh & 0xffffu); RhT[(j2 + 1) * 24 + tt] = (bf16)(rh >> 16);
            { const unsigned bb = cvt2(b2.x * br0, b2.y * br1), kb = cvt2(k2.x * br0, k2.y * br1); BbarT[j2 * 24 + tt] = (bf16)(bb & 0xffffu); BbarT[(j2 + 1) * 24 + tt] = (bf16)(bb >> 16); KbarT[j2 * 24 + tt] = (bf16)(kb & 0xffffu); KbarT[(j2 + 1) * 24 + tt] = (bf16)(kb >> 16); }
            { const unsigned vv = cvt2(v2_.x, v2_.y); VmT[j2 * 24 + tt] = (bf16)(vv & 0xffffu); VmT[(j2 + 1) * 24 + tt] = (bf16)(vv >> 16); }
            if (tt == 0) { GamC[j2] = __expf(ct0); GamC[j2 + 1] = __expf(ct1); }
        }
        LDS_BARRIER();
        PIN4(nAc); PIN4(nAp); PIN4(nBc); PIN4(nBp); PIN4(nCc); PIN4(nCp); PIN1(nvf);
        u32x2 vmB = {0u, 0u};
        {   const int r = lane & 15, q = lane >> 4; const f32x4 z4 = {0.f, 0.f, 0.f, 0.f};
            f32x4 NT = z4, Nn = z4, ArbT = z4;
#pragma unroll
            for (int ks = 0; ks < 2; ++ks) { const bf16x8 fb = *(const LAS bf16x8*)(Bt + r * 72 + ks * 32 + q * 8), fk = *(const LAS bf16x8*)(KKh + r * 72 + ks * 32 + q * 8), fr = *(const LAS bf16x8*)(Rh + r * 72 + ks * 32 + q * 8);
                NT = MF(fb, fk, NT); Nn = MF(fk, fb, Nn); ArbT = MF(fb, fr, ArbT); }
#pragma unroll
            for (int i = 0; i < 4; ++i) { const int rr = 4 * q + i; NT[i] = (rr < r) ? NT[i] : 0.f; Nn[i] = (r < rr) ? Nn[i] : 0.f; ArbT[i] = (rr <= r) ? ArbT[i] : 0.f; }
            const f32x4 N2 = MF(pack_lo(NT), pack_lo(Nn), z4), N2T = MF(pack_lo(Nn), pack_lo(NT), z4);
            const f32x4 N4 = MF(pack_lo(N2T), pack_lo(N2), z4), N4T = MF(pack_lo(N2), pack_lo(N2T), z4);
            const f32x4 N8T = MF(pack_lo(N4), pack_lo(N4T), z4);
            const bf16x8 aN8 = pack_lo(N8T), aN4 = pack_lo(N4T), aN2 = pack_lo(N2T), aN1 = pack_lo(-NT);
            if (wave < 4) {
                const int kt = wave; const u32x2 zb = *(const LAS u32x2*)(KKhT + (16 * kt + r) * 24 + 4 * q);
                f32x4 z = {bflo(zb.x), bfhi(zb.x), bflo(zb.y), bfhi(zb.y)};
                z = MF(aN8, pack_lo(z), z); z = MF(aN4, pack_lo(z), z); z = MF(aN2, pack_lo(z), z); z = MF(aN1, pack_lo(z), z);
                const u32x2 rb = *(const LAS u32x2*)(RhT + (16 * kt + r) * 24 + 4 * q); const f32x4 rc = {bflo(rb.x), bfhi(rb.x), bflo(rb.y), bfhi(rb.y)};
                const f32x4 qe = MF(pack_lo(-ArbT), pack_lo(z), rc);
#pragma unroll
                for (int i = 0; i < 4; ++i) { WQ[(4 * q + i) * 72 + 16 * kt + r] = (bf16)f2bf(z[i]); WQ[(16 + 4 * q + i) * 72 + 16 * kt + r] = (bf16)f2bf(qe[i]); }
            } else {
                const int vt = wave - 4; f32x4 AakT = z4, ArkT = z4;
#pragma unroll
                for (int ks = 0; ks < 2; ++ks) { const bf16x8 fkt = *(const LAS bf16x8*)(Kt + r * 72 + ks * 32 + q * 8), fk = *(const LAS bf16x8*)(KKh + r * 72 + ks * 32 + q * 8), fr = *(const LAS bf16x8*)(Rh + r * 72 + ks * 32 + q * 8);
                    AakT = MF(fkt, fk, AakT); ArkT = MF(fkt, fr, ArkT); }
#pragma unroll
                for (int i = 0; i < 4; ++i) { const int rr = 4 * q + i; AakT[i] = (rr < r) ? AakT[i] : 0.f; ArkT[i] = (rr <= r) ? ArkT[i] : 0.f; }
                vmB = *(const LAS u32x2*)(VmT + (16 * vt + r) * 24 + 4 * q);
                f32x4 z = MF(pack_lo(AakT), cat8(vmB, (u32x2){0u, 0u}), z4);
                z = MF(aN8, pack_lo(z), z); z = MF(aN4, pack_lo(z), z); z = MF(aN2, pack_lo(z), z); z = MF(aN1, pack_lo(z), z);
                const f32x4 yl_ = MF(pack2(ArkT, -ArbT), cat8(vmB, pack4(z)), z4);
                st_wt8(bp + RWB_W2 + (vt * 64 + lane) * 8, pack4(z)); st_wt8(bp + RWB_YL + (vt * 64 + lane) * 8, pack4(yl_));
            }
        }
        LDS_BARRIER();
        {
            { const int row = tidl >> 4, pc = tidl & 15, rr = row & 15, half = row >> 4, ks = pc >> 3, hi = (pc >> 2) & 1, qq = pc & 3;
              st_wt8(bp + RWB_WQ + (((2 * ks + half) * 64 + qq * 16 + rr) * 2 + hi) * 8, *(const LAS u32x2*)(WQ + row * 72 + pc * 4)); }
            for (int idx = tidl; idx < 768; idx += NTHR) { const int arr = idx >> 8, pi = idx & 255, row = pi >> 2, pc = pi & 3; const LAS bf16* src = (arr == 0 ? BbarT : arr == 1 ? KbarT : VmT) + row * 24 + pc * 4;
                const int ln = pc * 16 + (row & 15), t4 = row >> 4;
                st_wt8(bp + (arr < 2 ? RWB_BB + ((t4 * 64 + ln) * 2 + arr) * 8 : RWB_VM + (t4 * 64 + ln) * 8), *(const LAS u32x2*)src); }
            if (tidl < 32) st_wt8(bp + RWB_GC + tidl * 8, *(const LAS u32x2*)(GamC + tidl * 2));
            if (tidl < 256) { const int t = tidl >> 4, v4 = (tidl & 15) * 4; const f32x4 g4 = *(const LAS f32x4*)(G + t * 64 + v4); const f32x4 v4f = *(const LAS f32x4*)(V + t * 64 + v4); const float rkt = RK[t];
                st_wt8(bp + RWB_G + (t * 64 + v4) * 2, pack4(g4)); st_wt8(bp + RWB_BON + (t * 64 + v4) * 2, pack4(v4f * rkt)); }
        }
        LDS_BARRIER();
    }
    asm volatile("s_waitcnt vmcnt(0)" ::: "memory");
    __syncthreads();
    if (tid == 0) __hip_atomic_fetch_add(ctl + CW_RWP + l * 4096 + (seq * 8 + slab) * 16, 1u, RLX_AGENT);
    }
}
struct RwOps { u32x4 w[4]; u32x4 bk[4]; u32x2 vm, w2, yl; f32x4 gc[4]; };
__device__ __forceinline__ void rw_ops_load(RwOps& o, const unsigned char* bp, int vt, int r, int q, int lane) {
#pragma unroll
    for (int f = 0; f < 4; ++f) { o.w[f] = *(const u32x4*)(bp + RWB_WQ + (f * 64 + lane) * 16); o.bk[f] = *(const u32x4*)(bp + RWB_BB + (f * 64 + lane) * 16); o.gc[f] = *(const f32x4*)(bp + RWB_GC + (16 * f + 4 * q) * 4); }
    o.vm = *(const u32x2*)(bp + RWB_VM + (vt * 64 + lane) * 8); o.w2 = *(const u32x2*)(bp + RWB_W2 + (vt * 64 + lane) * 8); o.yl = *(const u32x2*)(bp + RWB_YL + (vt * 64 + lane) * 8);
}
__device__ __forceinline__ void rwkv_consumer(const Params& P, int l, int b, int hd, LAS unsigned char* lds, int tid, int lane, int wave) {
    LAS float* Yb = (LAS float*)lds;
    unsigned* ctl = (unsigned*)(P.ws + WS_CTL); const int seq = b * 4 + hd;
    unsigned* prod = ctl + CW_RWP + l * 4096 + seq * 8 * 16; unsigned* cons = ctl + CW_RWC + l * 1024 + seq * 16; unsigned* tmo = ctl + CW_TMO;
    bf16* mix = (bf16*)(P.ws + WS_MIX);
    const int r = lane & 15, q = lane >> 4, vt = wave & 3;
    f32x4 st[4];
#pragma unroll
    for (int i = 0; i < 4; ++i) st[i] = (f32x4){0.f, 0.f, 0.f, 0.f};
    const int ot = (tid >> 4) & 15, ov4 = (tid & 15) * 4;
    const f32x4 lnw = *(const f32x4*)(P.in[I_RLNW] + l * 256 + hd * 64 + ov4), lnb = *(const f32x4*)(P.in[I_RLNB] + l * 256 + hd * 64 + ov4);
    if (wave == 0) { wait_ge(prod, (unsigned)RW_RUN, tmo); __builtin_amdgcn_fence(__ATOMIC_ACQUIRE, "agent"); asm volatile("s_waitcnt vmcnt(0)" ::: "memory"); }
    __syncthreads();
    RwOps opA, opB; u32x2 gA = {0u, 0u}, bA = gA, gB = gA, bB = gA;
    if (wave >= 4) { rw_ops_load(opA, rw_bundle(P, seq, 0), vt, r, q, lane); rw_ops_load(opB, rw_bundle(P, seq, 1), vt, r, q, lane); }
    else { const unsigned char* bp = rw_bundle(P, seq, 0); gA = *(const u32x2*)(bp + RWB_G + (ot * 64 + ov4) * 2); bA = *(const u32x2*)(bp + RWB_BON + (ot * 64 + ov4) * 2); }
    u32x2* const dummy = (u32x2*)(P.ws + WS_LG) + tid;
#define RW_OUT(cp, GG, BN, DST) do { \
        const f32x4 y = *(const LAS f32x4*)(Yb + ((cp) & 1) * 1024 + ot * 64 + ov4); \
        const float mean = row16_sum((y[0] + y[1]) + (y[2] + y[3])) * (1.f / 64.f); const f32x4 d = y - mean; \
        const float var = row16_sum((d[0] * d[0] + d[1] * d[1]) + (d[2] * d[2] + d[3] * d[3])) * (1.f / 64.f); const float rs = __builtin_amdgcn_rsqf(var + 64e-5f); \
        const f32x4 o = (d * rs * lnw + lnb + (BN)) * (GG); \
        *(DST) = pack4(o); } while (0)
#define RW_SLABCHK(c) do { if ((((c) + 2) & 63) == 0 && (c) + 2 < T / 16) { \
            if (wave == 0) { wait_ge(prod + (((c) + 2) >> 6) * 16, (unsigned)RW_RUN, tmo); __builtin_amdgcn_fence(__ATOMIC_ACQUIRE, "agent"); asm volatile("s_waitcnt vmcnt(0)" ::: "memory"); } \
            __syncthreads(); } } while (0)
#define RW_REC(c, OP) do { RW_SLABCHK(c); \
            f32x4 d1 = {0.f, 0.f, 0.f, 0.f}, d2 = {0.f, 0.f, 0.f, 0.f}; \
            _Pragma("unroll") for (int ks = 0; ks < 2; ++ks) { const bf16x8 bS = pack2(st[2 * ks], st[2 * ks + 1]); d1 = MF(__builtin_bit_cast(bf16x8, OP.w[2 * ks]), bS, d1); d2 = MF(__builtin_bit_cast(bf16x8, OP.w[2 * ks + 1]), bS, d2); } \
            const f32x4 w2f = {bflo(OP.w2.x), bfhi(OP.w2.x), bflo(OP.w2.y), bfhi(OP.w2.y)}, ylf = {bflo(OP.yl.x), bfhi(OP.yl.x), bflo(OP.yl.y), bfhi(OP.yl.y)}; \
            const f32x4 un = -(d1 + w2f), yv = d2 + ylf; \
            LAS float* Y = Yb + ((c) & 1) * 1024; \
            _Pragma("unroll") for (int i = 0; i < 4; ++i) Y[(4 * q + i) * 64 + 16 * vt + r] = yv[i]; \
            const bf16x8 bUV = cat8(pack4(un), OP.vm); \
            _Pragma("unroll") for (int kt = 0; kt < 4; ++kt) st[kt] = MF(__builtin_bit_cast(bf16x8, OP.bk[kt]), bUV, st[kt] * OP.gc[kt]); \
            { const int cl_ = (c) + 2 < T / 16 ? (c) + 2 : T / 16 - 1; rw_ops_load(OP, rw_bundle(P, seq, cl_), vt, r, q, lane); } \
            LDS_BARRIER(); } while (0)
#define RW_OSTEP(c, GP, BP) do { RW_SLABCHK(c); \
            const f32x4 gg = {bflo(GP.x), bfhi(GP.x), bflo(GP.y), bfhi(GP.y)}, bn = {bflo(BP.x), bfhi(BP.x), bflo(BP.y), bfhi(BP.y)}; \
            { const int cn_ = (c) + 1 < T / 16 ? (c) + 1 : T / 16 - 1; const unsigned char* bp = rw_bundle(P, seq, cn_); GP = *(const u32x2*)(bp + RWB_G + (ot * 64 + ov4) * 2); BP = *(const u32x2*)(bp + RWB_BON + (ot * 64 + ov4) * 2); } \
            u32x2* dst_ = ((c) > 0) ? (u32x2*)(mix + ((size_t)b * T + ((c) - 1) * 16 + ot) * D + 512 + hd * 64 + ov4) : dummy; \
            RW_OUT((c) - 1, gg, bn, dst_); \
            LDS_BARRIER(); \
            if (((c) & 63) == 2 && (c) > 2 && tid == 0) { const unsigned cv_ = (unsigned)((c) >> 6);        \
                asm volatile("global_store_dword %0, %1, off sc1" :: "v"(cons), "v"(cv_) : "memory"); } } while (0)
    if (wave >= 4) {
#pragma unroll 1
        for (int c2 = 0; c2 < T / 16; c2 += 2) { RW_REC(c2, opA); RW_REC(c2 + 1, opB); }
    } else {
#pragma unroll 1
        for (int c2 = 0; c2 < T / 16; c2 += 2) { RW_OSTEP(c2, gB, bB); RW_OSTEP(c2 + 1, gA, bA); }
        const f32x4 gg = {bflo(gB.x), bfhi(gB.x), bflo(gB.y), bfhi(gB.y)}, bn = {bflo(bB.x), bfhi(bB.x), bflo(bB.y), bfhi(bB.y)};
        RW_OUT(T / 16 - 1, gg, bn, (u32x2*)(mix + ((size_t)b * T + (T / 16 - 1) * 16 + ot) * D + 512 + hd * 64 + ov4));
    }
#undef RW_SLABCHK
#undef RW_REC
#undef RW_OSTEP
#undef RW_OUT
}

__device__ __forceinline__ int lds_add(LAS int* p, int v) { return __hip_atomic_fetch_add(p, v, __ATOMIC_RELAXED, __HIP_MEMORY_SCOPE_WORKGROUP); }
__device__ __forceinline__ void ph_fin(const Params& P, int l, int lane, int wave) {
    const bf16* mix = (const bf16*)(P.ws + WS_MIX); bf16* act = (bf16*)(P.ws + WS_ACT); const float* gain = P.in[I_MGAIN] + (size_t)l * D;
    const int gw = blockIdx.x * NWAVES + wave, NGW = gridDim.x * NWAVES;
    const f32x4* gp = (const f32x4*)(gain + lane * 16); const f32x4 g0 = gp[0], g1 = gp[1], g2 = gp[2], g3 = gp[3];
#pragma unroll 1
    for (int m0 = gw * 4; m0 < NTOK; m0 += NGW * 4) {
        u32x4 ra[4], rb[4];
#pragma unroll
        for (int k = 0; k < 4; ++k) { ra[k] = ldg16(mix + (size_t)(m0 + k) * D + lane * 16); rb[k] = ldg16(mix + (size_t)(m0 + k) * D + lane * 16 + 8); }
#pragma unroll
        for (int k = 0; k < 4; ++k) { float v[16]; { float a[8], b2[8]; unpack8(ra[k], a); unpack8(rb[k], b2);
#pragma unroll
                for (int i = 0; i < 8; ++i) { v[i] = a[i]; v[8 + i] = b2[i]; } }
            float s2 = 0.f;
#pragma unroll
            for (int i = 0; i < 16; ++i) s2 += v[i] * v[i];
            s2 = row16_sum(s2);
            const float rstd = 1.f / sqrtf(s2 * (1.f / 256.f) + 1e-6f); u32x4 w0, w1;
            w0.x = cvt2(v[0] * rstd * g0.x, v[1] * rstd * g0.y); w0.y = cvt2(v[2] * rstd * g0.z, v[3] * rstd * g0.w); w0.z = cvt2(v[4] * rstd * g1.x, v[5] * rstd * g1.y); w0.w = cvt2(v[6] * rstd * g1.z, v[7] * rstd * g1.w);
            w1.x = cvt2(v[8] * rstd * g2.x, v[9] * rstd * g2.y); w1.y = cvt2(v[10] * rstd * g2.z, v[11] * rstd * g2.w); w1.z = cvt2(v[12] * rstd * g3.x, v[13] * rstd * g3.y); w1.w = cvt2(v[14] * rstd * g3.z, v[15] * rstd * g3.w);
            *(u32x4*)(act + (size_t)(m0 + k) * D + lane * 16) = w0; *(u32x4*)(act + (size_t)(m0 + k) * D + lane * 16 + 8) = w1; }
    }
}
__device__ __forceinline__ void ph_route(const Params& P, int l, LAS unsigned char* lds, int tid, int lane, int wave) {
    LAS int* hist = (LAS int*)(lds + LDS_MISC + 256);
    unsigned char* wl = P.ws + WS_W + (size_t)l * WL_STRIDE;
    pg8::StaticOrder S; S.init(NTOK / 256, 1, gridDim.x, blockIdx.x);
    { pg8::Gemm g{(const bf16*)P.out, (const bf16*)(wl + WO_RT), NTOK, 256, D, nullptr, 0, HP}; pg8::EpiLogits E{(float*)(P.ws + WS_LG)};
      pg8::gemm_phase<pg8::EpiLogits, pg8::StaticOrder, true, true>(lds, g, S, E); }
    bf16* act = (bf16*)(P.ws + WS_ACT); int* route = (int*)(P.ws + WS_ROUTE); int* tcnt = (int*)(P.ws + WS_TCNT);
    const float* n2 = P.in[I_NORM2] + (size_t)l * D; const float* cb = P.in[I_MCB] + l * 4; const float* fbias = P.in[I_MFB] + l * 32;
    LAS float* rsl = (LAS float*)lds;
    f32x4 gn[4];
#pragma unroll
    for (int j = 0; j < 4; ++j) gn[j] = *((const f32x4*)n2 + lane + 64 * j);
    for (int ui = 0; ; ++ui) {
    pg8::Unit un; if (!S.next(ui, un)) break;
    const int tile = un.pm;
    if (tid < NEXP) hist[tid] = 0;
    { const int mb = tile * 256 + wave * 32; u32x2 va[4], vb[4];
#define RT_LOAD(V, mm) do { const u32x2* hr_ = (const u32x2*)((const bf16*)P.out + (size_t)(mm) * HP) + lane; _Pragma("unroll") for (int j = 0; j < 4; ++j) V[j] = hr_[64 * j]; } while (0)
#define RT_ROW(V, kk) do { f32x4 v[4]; float s_ = 0.f; \
        _Pragma("unroll") for (int j = 0; j < 4; ++j) { v[j] = (f32x4){bflo(V[j].x), bfhi(V[j].x), bflo(V[j].y), bfhi(V[j].y)}; s_ += (v[j].x * v[j].x + v[j].y * v[j].y) + (v[j].z * v[j].z + v[j].w * v[j].w); } \
        if ((kk) + 2 < 32) RT_LOAD(V, mb + (kk) + 2); \
        const float rstd = 1.f / sqrtf(wave_sum(s_) * (1.f / D) + 1e-6f); if (lane == 0) rsl[wave * 32 + (kk)] = rstd; \
        unsigned* o4 = (unsigned*)((unsigned char*)act + (size_t)(mb + (kk)) * D) + lane; \
        _Pragma("unroll") for (int j = 0; j < 4; ++j) { const f32x4 g = gn[j]; int w8 = 0; w8 = __builtin_amdgcn_cvt_pk_fp8_f32(pg8::sat8(v[j].x * rstd * g.x), pg8::sat8(v[j].y * rstd * g.y), w8, false); w8 = __builtin_amdgcn_cvt_pk_fp8_f32(pg8::sat8(v[j].z * rstd * g.z), pg8::sat8(v[j].w * rstd * g.w), w8, true); o4[64 * j] = (unsigned)w8; } } while (0)
      RT_LOAD(va, mb); RT_LOAD(vb, mb + 1);
#pragma unroll 1
      for (int k = 0; k < 32; k += 2) { RT_ROW(va, k); RT_ROW(vb, k + 1); }
#undef RT_LOAD
#undef RT_ROW
    }
    __syncthreads();
    if (tid < 256) { const int m = tile * 256 + tid; const float rstd = rsl[tid];
        const f32x4* lp = (const f32x4*)((const float*)(P.ws + WS_LG) + (size_t)m * 72); f32x4 q[18];
#pragma unroll
        for (int i = 0; i < 18; ++i) q[i] = lp[i];
        float L[36];
#pragma unroll
        for (int j = 0; j < 36; ++j) L[j] = (q[j >> 2][j & 3] + q[(36 + j) >> 2][(36 + j) & 3]) * rstd + (j < 4 ? cb[j] : fbias[j - 4]);
        const float c0 = L[0], c1 = L[1], c2 = L[2], c3 = L[3];
        int gs = 0; float cm = c0; if (c1 > cm) { cm = c1; gs = 1; } if (c2 > cm) { cm = c2; gs = 2; } if (c3 > cm) { cm = c3; gs = 3; }
        const float pg = 1.f / (expf(c0 - cm) + expf(c1 - cm) + expf(c2 - cm) + expf(c3 - cm));
        float fa[8];
#pragma unroll
        for (int i = 0; i < 8; ++i) fa[i] = (gs == 0) ? L[4 + i] : (gs == 1) ? L[12 + i] : (gs == 2) ? L[20 + i] : L[28 + i];
        int i0 = 0; float m0 = fa[0];
#pragma unroll
        for (int i = 1; i < 8; ++i) if (fa[i] > m0) { m0 = fa[i]; i0 = i; }
        int i1 = (i0 == 0) ? 1 : 0; float m1 = -3.0e38f;
#pragma unroll
        for (int i = 0; i < 8; ++i) if (i != i0 && fa[i] > m1) { m1 = fa[i]; i1 = i; }
        const float e1w = expf(m1 - m0), w0 = pg / (1.f + e1w), w1 = pg * e1w / (1.f + e1w);
        const int e0 = gs * 8 + i0, e1 = gs * 8 + i1;
        typedef int i32x4 __attribute__((ext_vector_type(4)));
        *(i32x4*)(route + (size_t)m * 8) = (i32x4){e0, e1, __builtin_bit_cast(int, w0), __builtin_bit_cast(int, w1)};
        lds_add(&hist[e0], 1); lds_add(&hist[e1], 1); }
    __syncthreads();
    if (tid < NEXP) { tcnt[tile * 32 + tid] = hist[tid]; atomicAdd((unsigned*)(P.ws + WS_CTL) + CW_CNT + l * 64 + tid, (unsigned)hist[tid]); }
    __syncthreads();
    }
}
__device__ __forceinline__ int build_tiles(const Params& P, int l, LAS unsigned char* ldsall, int tid) {
    LAS int* tile_e = (LAS int*)(ldsall + LDS_TILE_E); LAS int* misc = (LAS int*)(ldsall + LDS_MISC);
    LAS int* ntl = (LAS int*)(ldsall + LDS_MISC + 512);
    if (tid < NEXP) { const unsigned* cnt = (const unsigned*)(P.ws + WS_CTL) + CW_CNT + l * 64; const int c = (int)__hip_atomic_load(cnt + tid, __ATOMIC_RELAXED, __HIP_MEMORY_SCOPE_AGENT); ntl[tid] = (c + 255) >> 8; }
    __syncthreads();
    if (tid < NEXP) { int r = 0; for (int e = 0; e < tid; ++e) r += ntl[e];
        const int nt = ntl[tid]; r = r < MAXTILES ? r : MAXTILES; misc[1 + tid] = r * 256;
        for (int q = 0; q < nt && r + q < MAXTILES; ++q) tile_e[r + q] = tid;
        if (tid == NEXP - 1) misc[0] = (r + nt < MAXTILES) ? r + nt : MAXTILES; }
    __syncthreads();
    return misc[0];
}
__device__ __forceinline__ void ph_scatter(const Params& P, int l, LAS unsigned char* ldsall, int tid, int lane, int wave) {
    build_tiles(P, l, ldsall, tid);
    LAS int* misc = (LAS int*)(ldsall + LDS_MISC); LAS int* base = (LAS int*)ldsall; LAS int* EL = base + 32; LAS int* POS = EL + 512; LAS int* part = POS + 512;
    int* route = (int*)(P.ws + WS_ROUTE); const int* tcnt = (const int*)(P.ws + WS_TCNT); int* rowsrc = (int*)(P.ws + WS_TCNT + 65536);
    for (int tile = blockIdx.x; tile < NTOK / 256; tile += gridDim.x) {
        { const int e = tid & 31, q = tid >> 5; int c[16];
#pragma unroll
          for (int i = 0; i < 16; ++i) { const int t2 = q + 16 * i; c[i] = (t2 < tile) ? tcnt[t2 * 32 + e] : 0; }
          int s = 0;
#pragma unroll
          for (int i = 0; i < 16; ++i) s += c[i];
          part[q * 32 + e] = s; }
        int e0 = 0, e1 = 0; const size_t tok = (size_t)tile * 256 + tid;
        if (tid < 256) { e0 = route[tok * 8]; e1 = route[tok * 8 + 1]; EL[tid * 2] = e0; EL[tid * 2 + 1] = e1; }
        __syncthreads();
        if (tid < 32) { int s = misc[1 + tid]; for (int q = 0; q < 16; ++q) s += part[q * 32 + tid]; base[tid] = s; }
        __syncthreads();
        if (tid < 256) { int r0 = 0, r1 = 0;
            for (int i = 0; i < 2 * tid; ++i) { const int e = EL[i]; r0 += (e == e0); r1 += (e == e1); }
            const int p0 = base[e0] + r0, p1 = base[e1] + r1;
            route[tok * 8 + 4] = p0; route[tok * 8 + 5] = p1; rowsrc[p0] = (int)tok; rowsrc[p1] = (int)tok; }
        __syncthreads();
        __syncthreads();
    }
}
__device__ __forceinline__ void cb_load(const Params& P, const unsigned char* ys, int m, int p0, int p1, int lane, u32x2 (&h)[4], unsigned (&a)[4], unsigned (&b2)[4]) {
    const u32x2* hr = (const u32x2*)((const bf16*)P.out + (size_t)m * HP) + lane; const unsigned* y0 = (const unsigned*)(ys + (size_t)p0 * D) + lane; const unsigned* y1 = (const unsigned*)(ys + (size_t)p1 * D) + lane;
#pragma unroll
    for (int j = 0; j < 4; ++j) { h[j] = hr[64 * j]; a[j] = y0[64 * j]; b2[j] = y1[64 * j]; }
}
__device__ __forceinline__ void ph_combine(const Params& P, int l, int lane, int wave) {
    const unsigned char* ys = (const unsigned char*)(P.ws + WS_PROJ); bf16* act = (bf16*)(P.ws + WS_ACT); const int* route = (const int*)(P.ws + WS_ROUTE);
    const float* gain = (l + 1 < NL) ? P.in[I_NORM1] + (size_t)(l + 1) * D : P.in[I_FNW];
    f32x4 gn[4];
#pragma unroll
    for (int j = 0; j < 4; ++j) gn[j] = *((const f32x4*)gain + lane + 64 * j);
    for (int tile = blockIdx.x; tile < NTOK / 256; tile += gridDim.x) {
        const int mb = tile * 256 + wave * 32;
        const int* rp = route + (size_t)(mb + (lane & 31)) * 8; const int rw0 = rp[2], rw1 = rp[3], rp0 = rp[4], rp1 = rp[5];
        u32x2 nh[4]; unsigned na[4], nb[4];
        cb_load(P, ys, mb, __builtin_amdgcn_readlane(rp0, 0), __builtin_amdgcn_readlane(rp1, 0), lane, nh, na, nb);
#pragma unroll 1
        for (int k = 0; k < 32; ++k) {
            const int m = mb + k; f32x4 v[4]; unsigned a[4], b2[4];
#pragma unroll
            for (int j = 0; j < 4; ++j) { v[j] = (f32x4){bflo(nh[j].x), bfhi(nh[j].x), bflo(nh[j].y), bfhi(nh[j].y)}; a[j] = na[j]; b2[j] = nb[j]; }
            const float w0 = __builtin_bit_cast(float, __builtin_amdgcn_readlane(rw0, k)) * 0.0625f, w1 = __builtin_bit_cast(float, __builtin_amdgcn_readlane(rw1, k)) * 0.0625f;
            if (k + 1 < 32) cb_load(P, ys, m + 1, __builtin_amdgcn_readlane(rp0, k + 1), __builtin_amdgcn_readlane(rp1, k + 1), lane, nh, na, nb);
            float s2 = 0.f;
#pragma unroll
            for (int j = 0; j < 4; ++j) { const f32x2 a01 = __builtin_amdgcn_cvt_pk_f32_fp8((int)a[j], false), a23 = __builtin_amdgcn_cvt_pk_f32_fp8((int)a[j], true), b01 = __builtin_amdgcn_cvt_pk_f32_fp8((int)b2[j], false), b23 = __builtin_amdgcn_cvt_pk_f32_fp8((int)b2[j], true);
                v[j].x += w0 * a01[0] + w1 * b01[0]; v[j].y += w0 * a01[1] + w1 * b01[1]; v[j].z += w0 * a23[0] + w1 * b23[0]; v[j].w += w0 * a23[1] + w1 * b23[1];
                s2 += (v[j].x * v[j].x + v[j].y * v[j].y) + (v[j].z * v[j].z + v[j].w * v[j].w); }
            const float rstd = 1.f / sqrtf(wave_sum(s2) * (1.f / D) + 1e-6f);
            f32x4* hr = (f32x4*)(P.out + (size_t)m * D) + lane;
            if (l + 1 < NL) { u32x2* o8 = (u32x2*)(act + (size_t)m * D) + lane; u32x2* hb = (u32x2*)((bf16*)P.out + (size_t)m * HP) + lane;
#pragma unroll
                for (int j = 0; j < 4; ++j) { u32x2 hw; hw.x = cvt2(v[j].x, v[j].y); hw.y = cvt2(v[j].z, v[j].w); hb[64 * j] = hw; u32x2 w; w.x = cvt2(v[j].x * rstd * gn[j].x, v[j].y * rstd * gn[j].y); w.y = cvt2(v[j].z * rstd * gn[j].z, v[j].w * rstd * gn[j].w); o8[64 * j] = w; }
            } else {
#pragma unroll
                for (int j = 0; j < 4; ++j) { f32x4 o; o.x = v[j].x * rstd * gn[j].x; o.y = v[j].y * rstd * gn[j].y; o.z = v[j].z * rstd * gn[j].z; o.w = v[j].w * rstd * gn[j].w; hr[64 * j] = o; }
            }
        }
    }
}

#ifndef MK_ONE_LAUNCH
#define MK_ONE_LAUNCH 1
#endif
constexpr int PH_PER_LAYER = 10, N_PHASES = 1 + NL * PH_PER_LAYER;
#ifndef PH_MASK
#ifdef DBG_NOMOE
#define PH_MASK 0x61f
#else
#define PH_MASK 0x7ff
#endif
#endif
#define PHE(j) (((PH_MASK) >> (j)) & 1)
#ifndef DUP_MASK
#define DUP_MASK 0
#endif
#define NREP(j) ((((DUP_MASK) >> (j)) & 1) ? 2 : 1)
#if MK_ONE_LAUNCH
#define GRID_BAR() xcd_barrier(bar)
#else
#define GRID_BAR() do {} while (0)
#endif
#define IN(k) (lo <= (k) && (k) < hi)
#define SEAM(k) do { if (IN(k) && IN((k) + 1)) GRID_BAR(); } while (0)
#ifndef DUP_ROLE
#define DUP_ROLE 0
#endif
#ifndef DUP_N
#define DUP_N 1
#endif
#define MIXBODY() do { \
            const int u_ = blockIdx.x; \
            if (u_ < 32) rwkv_consumer(P, l, u_ >> 2, u_ & 3, lds, tid, lane, wave); \
            else if (u_ < 64) role_hgrn(P, l, (u_ - 32) >> 2, u_ & 3, lds, tid, lane, wave); \
            else if (u_ < 96) role_lru(P, l, (u_ - 64) >> 2, u_ & 3, lds, tid, lane, wave); \
            else { rwkv_producer(P, l, (u_ - 96) & 3, (u_ - 96) >> 2, 40, lds, tid, lane, wave);        \
                   if (u_ < 224) { __syncthreads(); role_s5(P, l, (u_ - 96) >> 4, (u_ - 96) & 15, lds, tid, lane, wave); } } \
} while (0)
template <int l> __device__ __forceinline__ void layer_phases(const Params& P, LAS unsigned char* lds, const XcdBarrier& bar, int tid, int lane, int wave, int lo, int hi) {
        const int pb = 1 + l * PH_PER_LAYER;
        const unsigned char* wl = P.ws + WS_W + (size_t)l * WL_STRIDE;
        if (PHE(0) && IN(pb + 0)) {
            pg8::Gemm g{(const bf16*)(P.ws + WS_ACT), (const bf16*)(wl + WO_IN), NTOK, DIN, D}; pg8::StaticOrder S; S.init(NTOK / 256, DIN / 256, gridDim.x, blockIdx.x);
            pg8::EpiBf16 E{(bf16*)(P.ws + WS_PROJ), DIN};
            pg8::gemm_phase<pg8::EpiBf16, pg8::StaticOrder, true, true>(lds, g, S, E);
        } SEAM(pb + 0);
        if (PHE(1) && IN(pb + 1)) {
            MIXBODY();
            if (NREP(1) == 2) { GRID_BAR(); MIXBODY(); }
        } SEAM(pb + 1);
        if (PHE(2) && IN(pb + 2)) {
            pg8::Gemm g{(const bf16*)(P.ws + WS_YG), (const bf16*)(wl + WO_GLU), NTOK, 512, 256}; pg8::StaticOrder S; S.init(NTOK / 256, 2, gridDim.x, blockIdx.x);
            pg8::EpiGated<1> E{(bf16*)(P.ws + WS_MIX) + 256, D};
            pg8::gemm_phase<pg8::EpiGated<1>, pg8::StaticOrder, true, true>(lds, g, S, E);
        } SEAM(pb + 2);
        if (PHE(3) && IN(pb + 3)) { ph_fin(P, l, lane, wave); } SEAM(pb + 3);
        if (PHE(4) && IN(pb + 4)) {
            pg8::Gemm g{(const bf16*)(P.ws + WS_ACT), (const bf16*)(wl + WO_OUT), NTOK, D, D}; pg8::StaticOrder S; S.init(NTOK / 256, D / 256, gridDim.x, blockIdx.x);
            if (l == 0) { pg8::EpiResB<true> E{(bf16*)P.out, (const void*)P.in[I_X], HP, D}; pg8::gemm_phase<pg8::EpiResB<true>, pg8::StaticOrder, true, true>(lds, g, S, E); }
            else { pg8::EpiResB<false> E{(bf16*)P.out, (const void*)P.out, HP, HP}; pg8::gemm_phase<pg8::EpiResB<false>, pg8::StaticOrder, true, true>(lds, g, S, E); }
        } SEAM(pb + 4);
        if (PHE(5) && IN(pb + 5)) { ph_route(P, l, lds, tid, lane, wave); } SEAM(pb + 5);
        if (PHE(6) && IN(pb + 6)) { ph_scatter(P, l, lds, tid, lane, wave); } SEAM(pb + 6);
        if (PHE(7) && IN(pb + 7)) {
            const int R = build_tiles(P, l, lds, tid);
            pg8::Gemm g{(const bf16*)(P.ws + WS_ACT), (const bf16*)(wl + WO_GU), SROWS, D, D / 2  , (const int*)(P.ws + WS_TCNT + 65536), NTOK}; pg8::StaticOrder S; S.init(R, 4, gridDim.x, blockIdx.x);
            S.tile_e = (const LAS int*)(lds + LDS_TILE_E); S.estride = (size_t)D * D;
            pg8::EpiGatedF8 E{(unsigned char*)(P.ws + WS_MIX), DEXP};
            pg8::gemm_phase<pg8::EpiGatedF8, pg8::StaticOrder, true, true, true, true>(lds, g, S, E);
        } SEAM(pb + 7);
        if (PHE(8) && IN(pb + 8)) {
            const int R = build_tiles(P, l, lds, tid);
            pg8::Gemm g{(const bf16*)(P.ws + WS_MIX), (const bf16*)(wl + WO_DN), SROWS, D, DEXP / 2  }; pg8::StaticOrder S; S.init(R, 4, gridDim.x, blockIdx.x);
            S.tile_e = (const LAS int*)(lds + LDS_TILE_E); S.estride = (size_t)D * DEXP;
            pg8::EpiF8 E{(unsigned char*)(P.ws + WS_PROJ), D, 16.f};
            pg8::gemm_phase<pg8::EpiF8, pg8::StaticOrder, true, true, false, true>(lds, g, S, E);
        } SEAM(pb + 8);
        if (PHE(9) && IN(pb + 9)) { ph_combine(P, l, lane, wave); } SEAM(pb + 9);
    }
__global__ void __launch_bounds__(NTHR, 2) fwd_kernel(Params P) {
    extern __shared__ __attribute__((aligned(16))) unsigned char lds_raw[];
    LAS unsigned char* lds = (LAS unsigned char*)lds_raw;
    const int tid = threadIdx.x, lane = tid & 63, wave = __builtin_amdgcn_readfirstlane(tid >> 6);
    if (tid < 16) ((LAS unsigned*)(lds + LDSCTL_OFF))[tid] = 0u;
    __syncthreads();
#if MK_ONE_LAUNCH
    XcdBarrier bar = xcd_barrier_post((unsigned*)(P.ws + WS_CTL) + CW_BAR, (volatile LAS unsigned*)(lds + LDSCTL_OFF));
#else
    XcdBarrier bar; bar.bar = nullptr; bar.x = 0; bar.st = nullptr;
#endif
    const int lo = P.ph_lo, hi = P.ph_hi;
    if (PHE(10) && IN(0)) { ph_prologue(P, lds, tid, lane, wave); } SEAM(0);
    layer_phases<0>(P, lds, bar, tid, lane, wave, lo, hi);
    layer_phases<1>(P, lds, bar, tid, lane, wave, lo, hi);
}
#undef IN
#undef SEAM

extern "C" void kernel_launch(void* const* d_in, const int* in_sizes, int n_in, void* d_out, int out_size, void* d_ws, size_t ws_size, hipStream_t stream) {
    static int grid = 0;
    if (grid == 0) {
        if (n_in != 46 || out_size != NTOK * D || ws_size < WS_END) { fprintf(stderr, "kernel_launch: unexpected sizes n_in %d out %d ws %zu\n", n_in, out_size, ws_size); grid = -1; return; }
        int dev = 0, cus = 0;
        if (hipGetDevice(&dev) != hipSuccess || hipDeviceGetAttribute(&cus, hipDeviceAttributeMultiprocessorCount, dev) != hipSuccess) { grid = -1; return; }
        if (hipFuncSetAttribute((const void*)fwd_kernel, hipFuncAttributeMaxDynamicSharedMemorySize, LDS_BYTES) != hipSuccess) { grid = -1; return; }
        int per_cu = 0;
        if (hipOccupancyMaxActiveBlocksPerMultiprocessor(&per_cu, (const void*)fwd_kernel, NTHR, LDS_BYTES) != hipSuccess || per_cu < 1) { fprintf(stderr, "kernel_launch: occupancy query says %d\n", per_cu); }
        (void)hipGetLastError();
        (void)cus; grid = 256;
    }
    if (grid < 0) return;
    if (hipMemsetAsync((char*)d_ws + WS_CTL, 0, CTL_ZERO_BYTES, stream) != hipSuccess) return;
    Params p; memset(&p, 0, sizeof(p));
    for (int i = 0; i < 46; ++i) p.in[i] = (const float*)d_in[i];
    p.out = (float*)d_out; p.ws = (unsigned char*)d_ws;
#if MK_ONE_LAUNCH
    p.ph_lo = 0; p.ph_hi = N_PHASES;
    hipLaunchKernelGGL(fwd_kernel, dim3(grid), dim3(NTHR), LDS_BYTES, stream, p);
#else
    for (int k = 0; k < N_PHASES; ++k) { p.ph_lo = k; p.ph_hi = k + 1; hipLaunchKernelGGL(fwd_kernel, dim3(grid), dim3(NTHR), LDS_BYTES, stream, p); }
#endif
}
```

```cpp
#include <hip/hip_runtime.h>
#include <cstdio>
#include <cstdint>
#include <cstring>

#define LAS __attribute__((address_space(3)))
#define GAS __attribute__((address_space(1)))

namespace pg8 {
#define PG8_LAS __attribute__((address_space(3)))
typedef unsigned short bf16_t;
typedef short bf16x8 __attribute__((ext_vector_type(8)));
typedef float f32x4 __attribute__((ext_vector_type(4)));
typedef unsigned u32x4 __attribute__((ext_vector_type(4)));
typedef int v8i __attribute__((ext_vector_type(8)));
constexpr int BM = 256, BK = 64, HALF = 128, HTB = HALF * BK * 2  , STAGE_BYTES = 8 * HTB, NXCD = 8, WGM = 8;

__host__ __device__ __forceinline__ int lds_byte(int r, int c) { const int st = (r >> 4) * 2 + (c >> 5), rr = r & 15, cc = c & 31, ob = rr * 64 + cc * 2; return st * 1024 + (ob ^ (((ob >> 9) & 1) << 5)); }
__host__ __device__ __forceinline__ void stage_rc(int b, int& R, int& C) { const int st = b / 1024, sb = b % 1024, swz = sb ^ (((sb >> 9) & 1) << 5); R = (st >> 1) * 16 + swz / 64; C = (st & 1) * 32 + (swz % 64) / 2; }
__host__ __device__ __forceinline__ int perm32(int rho) { const int n = rho >> 4, i = rho & 15; return 8 * (i >> 2) + 4 * n + (i & 3); }

struct Unit { int pm, pn; };
struct Gemm { const bf16_t* A; const bf16_t* Bt; int M, N, K; const int* rowsrc; int nsrc; int lda; };

struct StaticOrder {
    int nM, nN, nwg, G, c; const PG8_LAS int* tile_e; size_t estride;
    __device__ void init(int nM_, int nN_, int G_, int c_) { nM = nM_; nN = nN_; nwg = nM * nN; G = G_; c = c_; tile_e = nullptr; estride = 0; }
    __device__ bool next(int i, Unit& u) const {
        const long L = (long)i * G + c; if (L >= nwg) return false;
        int wgid = (int)L; { const int q = nwg / NXCD, r = nwg % NXCD, xcd = wgid % NXCD, off = wgid / NXCD; wgid = (xcd < r ? xcd * (q + 1) : r * (q + 1) + (xcd - r) * q) + off; }
        const int nig = WGM * nN, gid = wgid / nig, fm = gid * WGM, gsz = (nM - fm) < WGM ? (nM - fm) : WGM;
        u.pm = fm + ((wgid % nig) % gsz); u.pn = (wgid % nig) / gsz; return true;
    }
    __device__ __forceinline__ size_t boff(const Unit& u, size_t tstep) const { return (size_t)u.pn * tstep + (tile_e ? (size_t)tile_e[u.pm] * estride : (size_t)0); }
    __device__ __forceinline__ void a_ready(const Unit&) const {}
    __device__ __forceinline__ void done(const Unit&) const {}
};

__device__ __forceinline__ unsigned cvt_pk_bf16(float lo, float hi) { unsigned r; asm volatile("v_cvt_pk_bf16_f32 %0, %1, %2" : "=v"(r) : "v"(lo), "v"(hi)); return r; }

__device__ __forceinline__ float sat8(float x) { return __builtin_amdgcn_fmed3f(x, -448.f, 448.f); }
struct EpiBf16 {
    static constexpr bool PERM = true, AFTER_DRAIN = false;
    bf16_t* O; int ldc;
    __device__ __forceinline__ void operator()(const f32x4 (&acc)[2][2][4][2], const Unit& u, int wr, int wc, int fr, int fq) const {
        const int row0 = u.pm * BM + wr * 64 + fr, col0 = u.pn * BM + wc * 32 + 8 * fq;
#pragma unroll
        for (int ai = 0; ai < 2; ++ai)
#pragma unroll
            for (int m = 0; m < 4; ++m) { bf16_t* rowp = O + (size_t)(row0 + ai * HALF + m * 16) * ldc + col0;
#pragma unroll
                for (int bj = 0; bj < 2; ++bj) { const f32x4 v0 = acc[ai][bj][m][0], v1 = acc[ai][bj][m][1];
                    u32x4 w; w.x = cvt_pk_bf16(v0[0], v0[1]); w.y = cvt_pk_bf16(v0[2], v0[3]); w.z = cvt_pk_bf16(v1[0], v1[1]); w.w = cvt_pk_bf16(v1[2], v1[3]);
                    *(u32x4*)(rowp + bj * HALF) = w; } }
    }
};
struct EpiLogits {
    static constexpr bool PERM = true, AFTER_DRAIN = false;
    float* O;
    __device__ __forceinline__ void operator()(const f32x4 (&acc)[2][2][4][2], const Unit& u, int wr, int wc, int fr, int fq) const {
        const int row0 = u.pm * BM + wr * 64 + fr, col0 = wc * 32 + 8 * fq;
        if (col0 < 72) {
#pragma unroll
            for (int ai = 0; ai < 2; ++ai)
#pragma unroll
                for (int m = 0; m < 4; ++m) { float* rowp = O + (size_t)(row0 + ai * HALF + m * 16) * 72 + col0; *(f32x4*)rowp = acc[ai][0][m][0]; *(f32x4*)(rowp + 4) = acc[ai][0][m][1]; }
        }
    }
};
template <int MODE> struct EpiGated {
    static constexpr bool PERM = true, AFTER_DRAIN = false;
    bf16_t* O; int ldc;
    __device__ __forceinline__ void operator()(const f32x4 (&acc)[2][2][4][2], const Unit& u, int wr, int wc, int fr, int fq) const {
        const int row0 = u.pm * BM + wr * 64 + fr, col0 = u.pn * HALF + wc * 32 + 8 * fq;
#pragma unroll
        for (int ai = 0; ai < 2; ++ai)
#pragma unroll
            for (int m = 0; m < 4; ++m) { bf16_t* rowp = O + (size_t)(row0 + ai * HALF + m * 16) * ldc + col0;
                float o[8];
#pragma unroll
                for (int n = 0; n < 2; ++n)
#pragma unroll
                    for (int j = 0; j < 4; ++j) { const float a = acc[ai][0][m][n][j], b = acc[ai][1][m][n][j];
                        o[n * 4 + j] = (MODE == 0) ? (a / (1.f + __expf(-a))) * b : a / (1.f + __expf(-b)); }
                u32x4 w; w.x = cvt_pk_bf16(o[0], o[1]); w.y = cvt_pk_bf16(o[2], o[3]); w.z = cvt_pk_bf16(o[4], o[5]); w.w = cvt_pk_bf16(o[6], o[7]);
                *(u32x4*)rowp = w; }
    }
};
template <bool RF32> struct EpiResB {
    static constexpr bool PERM = true, AFTER_DRAIN = false;
    bf16_t* C; const void* R; int ldc, ldr;
    __device__ __forceinline__ void operator()(const f32x4 (&acc)[2][2][4][2], const Unit& u, int wr, int wc, int fr, int fq) const {
        const int row0 = u.pm * BM + wr * 64 + fr, col0 = u.pn * BM + wc * 32 + 8 * fq;
#pragma unroll
        for (int ai = 0; ai < 2; ++ai)
#pragma unroll
            for (int m = 0; m < 4; ++m) { const size_t row = (size_t)(row0 + ai * HALF + m * 16);
#pragma unroll
                for (int bj = 0; bj < 2; ++bj) { float r[8];
                    if constexpr (RF32) { const f32x4 a = *(const f32x4*)((const float*)R + row * ldr + col0 + bj * HALF), b = *(const f32x4*)((const float*)R + row * ldr + col0 + bj * HALF + 4);
                        r[0] = a[0]; r[1] = a[1]; r[2] = a[2]; r[3] = a[3]; r[4] = b[0]; r[5] = b[1]; r[6] = b[2]; r[7] = b[3]; }
                    else { const u32x4 w = *(const u32x4*)((const bf16_t*)R + row * ldr + col0 + bj * HALF);
                        r[0] = __builtin_bit_cast(float, w.x << 16); r[1] = __builtin_bit_cast(float, w.x & 0xffff0000u); r[2] = __builtin_bit_cast(float, w.y << 16); r[3] = __builtin_bit_cast(float, w.y & 0xffff0000u);
                        r[4] = __builtin_bit_cast(float, w.z << 16); r[5] = __builtin_bit_cast(float, w.z & 0xffff0000u); r[6] = __builtin_bit_cast(float, w.w << 16); r[7] = __builtin_bit_cast(float, w.w & 0xffff0000u); }
                    const f32x4 v0 = acc[ai][bj][m][0], v1 = acc[ai][bj][m][1];
                    u32x4 o; o.x = cvt_pk_bf16(v0[0] + r[0], v0[1] + r[1]); o.y = cvt_pk_bf16(v0[2] + r[2], v0[3] + r[3]); o.z = cvt_pk_bf16(v1[0] + r[4], v1[1] + r[5]); o.w = cvt_pk_bf16(v1[2] + r[6], v1[3] + r[7]);
                    *(u32x4*)(C + row * ldc + col0 + bj * HALF) = o; } }
    }
};
struct EpiGatedF8 {
    static constexpr bool PERM = true, AFTER_DRAIN = false;
    unsigned char* O; int ldc;
    __device__ __forceinline__ void operator()(const f32x4 (&acc)[2][2][4][2], const Unit& u, int wr, int wc, int fr, int fq) const {
        const int row0 = u.pm * BM + wr * 64 + fr, col0 = u.pn * HALF + wc * 32 + 8 * fq;
#pragma unroll
        for (int ai = 0; ai < 2; ++ai)
#pragma unroll
            for (int m = 0; m < 4; ++m) { unsigned char* rowp = O + (size_t)(row0 + ai * HALF + m * 16) * ldc + col0;
                float o[8];
#pragma unroll
                for (int n = 0; n < 2; ++n)
#pragma unroll
                    for (int j = 0; j < 4; ++j) { const float a = acc[ai][0][m][n][j], b = acc[ai][1][m][n][j]; o[n * 4 + j] = sat8((a / (1.f + __expf(-a))) * b); }
                int w0 = 0, w1 = 0;
                w0 = __builtin_amdgcn_cvt_pk_fp8_f32(o[0], o[1], w0, false); w0 = __builtin_amdgcn_cvt_pk_fp8_f32(o[2], o[3], w0, true);
                w1 = __builtin_amdgcn_cvt_pk_fp8_f32(o[4], o[5], w1, false); w1 = __builtin_amdgcn_cvt_pk_fp8_f32(o[6], o[7], w1, true);
                unsigned long long pk = (unsigned long long)(unsigned)w0 | ((unsigned long long)(unsigned)w1 << 32); *(unsigned long long*)rowp = pk; }
    }
};
struct EpiF8 {
    static constexpr bool PERM = true, AFTER_DRAIN = false;
    unsigned char* O; int ldc; float sc;
    __device__ __forceinline__ void operator()(const f32x4 (&acc)[2][2][4][2], const Unit& u, int wr, int wc, int fr, int fq) const {
        const int row0 = u.pm * BM + wr * 64 + fr, col0 = u.pn * BM + wc * 32 + 8 * fq;
#pragma unroll
        for (int ai = 0; ai < 2; ++ai)
#pragma unroll
            for (int m = 0; m < 4; ++m) { unsigned char* rowp = O + (size_t)(row0 + ai * HALF + m * 16) * ldc + col0;
#pragma unroll
                for (int bj = 0; bj < 2; ++bj) { const f32x4 v0 = acc[ai][bj][m][0] * sc, v1 = acc[ai][bj][m][1] * sc; int w0 = 0, w1 = 0;
                    w0 = __builtin_amdgcn_cvt_pk_fp8_f32(sat8(v0[0]), sat8(v0[1]), w0, false); w0 = __builtin_amdgcn_cvt_pk_fp8_f32(sat8(v0[2]), sat8(v0[3]), w0, true);
                    w1 = __builtin_amdgcn_cvt_pk_fp8_f32(sat8(v1[0]), sat8(v1[1]), w1, false); w1 = __builtin_amdgcn_cvt_pk_fp8_f32(sat8(v1[2]), sat8(v1[3]), w1, true);
                    *(unsigned long long*)(rowp + bj * HALF) = (unsigned long long)(unsigned)w0 | ((unsigned long long)(unsigned)w1 << 32); } }
    }
};
struct EpiResF32 {
    static constexpr bool PERM = false, AFTER_DRAIN = false;
    float* C; const float* R; int ldc;
    __device__ __forceinline__ void operator()(const f32x4 (&acc)[2][2][4][2], const Unit& u, int wr, int wc, int fr, int fq) const {
        const int row0 = u.pm * BM + wr * 64 + fr, col0 = u.pn * BM + wc * 32 + 4 * fq;
#pragma unroll
        for (int ai = 0; ai < 2; ++ai)
#pragma unroll
            for (int m = 0; m < 4; ++m) { const size_t ro = (size_t)(row0 + ai * HALF + m * 16) * ldc + col0;
#pragma unroll
                for (int bj = 0; bj < 2; ++bj)
#pragma unroll
                    for (int n = 0; n < 2; ++n) { const f32x4 r = *(const f32x4*)(R + ro + bj * HALF + n * 16); *(f32x4*)(C + ro + bj * HALF + n * 16) = acc[ai][bj][m][n] + r; } }
    }
};


template <class Epi, class Sched, bool ALIGN_EPI = false, bool SP2 = false, bool GATH = false, bool F8 = false>
__device__ __forceinline__ void gemm_phase(PG8_LAS unsigned char* lds, const Gemm g, const Sched& S, const Epi& E) {
    static_assert(!GATH || SP2, "the gathered-A variant exists for the SP2 loop only");
    const int tid = threadIdx.x, wid = __builtin_amdgcn_readfirstlane(tid >> 6), lane = tid & 63, wr = wid >> 2, wc = wid & 3, fr = lane & 15, fq = lane >> 4;
    const int K = g.K, nt = K / BK, ldA = g.lda ? g.lda : K;
    unsigned voffA[2], voffB[2];
#pragma unroll
    for (int i = 0; i < 2; ++i) { int R, C; stage_rc(tid * 16 + i * 8192, R, C); const int Rb = Epi::PERM ? ((R & ~31) + perm32(R & 31)) : R;
        voffA[i] = (unsigned)(R * ldA + C) * 2u; voffB[i] = (unsigned)(Rb * K + C) * 2u; }
    const size_t kstep = (size_t)(BK * 2);
    const size_t hstep = (size_t)HALF * K * 2;
    const size_t tstep = 2 * hstep;
    const size_t hstepA = (size_t)HALF * ldA * 2, tstepA = 2 * hstepA;
    const unsigned ldsw = (unsigned)wid * 1024u;
    const int aoff = lds_byte(wr * 64 + fr, fq * 8), boff = lds_byte(wc * 32 + fr, fq * 8);
#define PG8_SA(b, h) (((b) * 2 + (h)) * HTB)
#define PG8_SB(b, h) ((4 + (b) * 2 + (h)) * HTB)
#define PG8_STAGE(bufoff, gbase, voff) do { _Pragma("unroll") for (int _i = 0; _i < 2; ++_i) \
        __builtin_amdgcn_global_load_lds((const unsigned*)((const char*)(gbase) + (voff)[_i]), (PG8_LAS unsigned*)(lds + (bufoff) + ldsw + _i * 8192), 16, 0, 0); } while (0)
#define PG8_STAGE_G(bufoff, gbase, v0, v1) do { \
        __builtin_amdgcn_global_load_lds((const unsigned*)((const char*)(gbase) + (v0)), (PG8_LAS unsigned*)(lds + (bufoff) + ldsw), 16, 0, 0); \
        __builtin_amdgcn_global_load_lds((const unsigned*)((const char*)(gbase) + (v1)), (PG8_LAS unsigned*)(lds + (bufoff) + ldsw + 8192), 16, 0, 0); } while (0)
#define PG8_LDA(dst, b, h) do { if constexpr (F8) { _Pragma("unroll") for (int m = 0; m < 4; ++m) { const u32x4 lo_ = *(const PG8_LAS u32x4*)(lds + PG8_SA(b, h) + aoff + m * 2048), hi_ = *(const PG8_LAS u32x4*)(lds + PG8_SA(b, h) + aoff + 1024 + m * 2048); \
            dst##8[m] = (v8i){(int)lo_.x, (int)lo_.y, (int)lo_.z, (int)lo_.w, (int)hi_.x, (int)hi_.y, (int)hi_.z, (int)hi_.w}; } } \
        else { _Pragma("unroll") for (int m = 0; m < 4; ++m) _Pragma("unroll") for (int k = 0; k < 2; ++k) dst[m][k] = *(const PG8_LAS bf16x8*)(lds + PG8_SA(b, h) + aoff + m * 2048 + k * 1024); } } while (0)
#define PG8_LDB(dst, b, h) do { if constexpr (F8) { _Pragma("unroll") for (int n = 0; n < 2; ++n) { const u32x4 lo_ = *(const PG8_LAS u32x4*)(lds + PG8_SB(b, h) + boff + n * 2048), hi_ = *(const PG8_LAS u32x4*)(lds + PG8_SB(b, h) + boff + 1024 + n * 2048); \
            dst##8[n] = (v8i){(int)lo_.x, (int)lo_.y, (int)lo_.z, (int)lo_.w, (int)hi_.x, (int)hi_.y, (int)hi_.z, (int)hi_.w}; } } \
        else { _Pragma("unroll") for (int n = 0; n < 2; ++n) _Pragma("unroll") for (int k = 0; k < 2; ++k) dst[n][k] = *(const PG8_LAS bf16x8*)(lds + PG8_SB(b, h) + boff + n * 2048 + k * 1024); } } while (0)
#define PG8_MMA(ai, bj, At, Bt) do { __builtin_amdgcn_s_setprio(1); \
        if constexpr (F8) { _Pragma("unroll") for (int m = 0; m < 4; ++m) _Pragma("unroll") for (int n = 0; n < 2; ++n) \
            asm volatile("v_mfma_scale_f32_16x16x128_f8f6f4 %0, %1, %2, %0, %3, %4 op_sel_hi:[0,0,0]" : "+v"(acc[ai][bj][m][n]) : "v"(Bt##8[n]), "v"(At##8[m]), "v"(sc8_), "v"(sc8_)); } \
        else { _Pragma("unroll") for (int m = 0; m < 4; ++m) _Pragma("unroll") for (int n = 0; n < 2; ++n) _Pragma("unroll") for (int k = 0; k < 2; ++k) \
            acc[ai][bj][m][n] = __builtin_amdgcn_mfma_f32_16x16x32_bf16(Bt[n][k], At[m][k], acc[ai][bj][m][n], 0, 0, 0); } \
        __builtin_amdgcn_s_setprio(0); } while (0)
#define PG8_WAIT_V(n) asm volatile("s_waitcnt vmcnt(" #n ")" ::: "memory")
#define PG8_WAIT_L(n) asm volatile("s_waitcnt lgkmcnt(" #n ")" ::: "memory")
#define PG8_BAR __builtin_amdgcn_s_barrier()
#define PG8_SCHED __builtin_amdgcn_sched_barrier(0)
#define PG8_SCHED8 do { if constexpr (F8) __builtin_amdgcn_sched_barrier(0); } while (0)
    Unit cur, nxt; int ui = 0;
    if (!S.next(0, cur)) return;
    unsigned gc[2][2] = {{0u, 0u}, {0u, 0u}}, gn[2][2] = {{0u, 0u}, {0u, 0u}};
    int gR[2] = {0, 0}, gC[2] = {0, 0};
    if constexpr (GATH) {
#pragma unroll
        for (int i = 0; i < 2; ++i) stage_rc(tid * 16 + i * 8192, gR[i], gC[i]);
#pragma unroll
        for (int h = 0; h < 2; ++h)
#pragma unroll
            for (int i = 0; i < 2; ++i) { unsigned src = (unsigned)g.rowsrc[cur.pm * BM + h * HALF + gR[i]]; src = src < (unsigned)g.nsrc ? src : (unsigned)(g.nsrc - 1); gc[h][i] = (src * (unsigned)K + (unsigned)gC[i]) * 2u; }
    }
    f32x4 acc[2][2][4][2];
#pragma unroll
    for (int a = 0; a < 2; ++a)
#pragma unroll
        for (int b = 0; b < 2; ++b)
#pragma unroll
            for (int m = 0; m < 4; ++m)
#pragma unroll
                for (int n = 0; n < 2; ++n) acc[a][b][m][n] = (f32x4){0.f, 0.f, 0.f, 0.f};
    const int sc8_ = 0x7c7c7c7c;
    bf16x8 At[4][2], B0[2][2], B1[2][2]; v8i At8[4], B08[2], B18[2];
    const char* cA = GATH ? (const char*)g.A : (const char*)g.A + (size_t)cur.pm * tstepA; const char* cB = (const char*)g.Bt + S.boff(cur, tstep);
    S.a_ready(cur);
    if constexpr (SP2) {
        PG8_STAGE(PG8_SB(0, 0), cB, voffB); PG8_STAGE(PG8_SB(0, 1), cB + hstep, voffB);
        if constexpr (GATH) { PG8_STAGE_G(PG8_SA(0, 0), cA, gc[0][0], gc[0][1]); PG8_STAGE_G(PG8_SA(0, 1), cA, gc[1][0], gc[1][1]); } else { PG8_STAGE(PG8_SA(0, 0), cA, voffA); PG8_STAGE(PG8_SA(0, 1), cA + hstepA, voffA); }
        if (wr == 1) PG8_BAR;
        PG8_WAIT_V(2); PG8_BAR;
        PG8_STAGE(PG8_SB(1, 0), cB + kstep, voffB); if constexpr (GATH) PG8_STAGE_G(PG8_SA(1, 0), cA + kstep, gc[0][0], gc[0][1]); else PG8_STAGE(PG8_SA(1, 0), cA + kstep, voffA); PG8_STAGE(PG8_SB(1, 1), cB + hstep + kstep, voffB);
        PG8_WAIT_V(6); PG8_BAR;
    } else {
        PG8_STAGE(PG8_SB(0, 0), cB, voffB); PG8_STAGE(PG8_SA(0, 0), cA, voffA); PG8_STAGE(PG8_SB(0, 1), cB + hstep, voffB); PG8_STAGE(PG8_SA(0, 1), cA + hstepA, voffA);
        if (wr == 1) PG8_BAR;
        PG8_WAIT_V(4); PG8_BAR;
        PG8_STAGE(PG8_SB(1, 0), cB + kstep, voffB); PG8_STAGE(PG8_SA(1, 0), cA + kstep, voffA); PG8_STAGE(PG8_SB(1, 1), cB + hstep + kstep, voffB);
        PG8_WAIT_V(6); PG8_BAR;
    }
    for (;;) {
        const bool has_next = S.next(ui + 1, nxt);
        const char* nA = GATH ? cA : (has_next ? (const char*)g.A + (size_t)nxt.pm * tstepA : cA); const char* nB = has_next ? (const char*)g.Bt + S.boff(nxt, tstep) : cB;
        if constexpr (GATH) {
#pragma unroll
            for (int h = 0; h < 2; ++h)
#pragma unroll
                for (int i = 0; i < 2; ++i) { gn[h][i] = gc[h][i];
                    if (has_next) { unsigned src = (unsigned)g.rowsrc[nxt.pm * BM + h * HALF + gR[i]]; src = src < (unsigned)g.nsrc ? src : (unsigned)(g.nsrc - 1); gn[h][i] = (src * (unsigned)K + (unsigned)gC[i]) * 2u; } }
        }
#pragma nounroll
        for (int t = 0; t < nt; t += 2) {
            const bool last = (t == nt - 2);
            const char* a1 = cA + (size_t)(t + 1) * kstep;
            const char* a2 = last ? nA : cA + (size_t)(t + 2) * kstep; const char* b2 = last ? nB : cB + (size_t)(t + 2) * kstep;
            const char* a3 = a2 + kstep; const char* b3 = b2 + kstep;
            if (last && has_next) S.a_ready(nxt);
            if constexpr (SP2) {
            PG8_LDB(B0, 0, 0); PG8_LDB(B1, 0, 1); PG8_SCHED; PG8_LDA(At, 0, 0); if constexpr (GATH) PG8_STAGE_G(PG8_SA(1, 1), a1, gc[1][0], gc[1][1]); else PG8_STAGE(PG8_SA(1, 1), a1 + hstepA, voffA);
            PG8_WAIT_V(8); PG8_WAIT_L(0); PG8_BAR; PG8_SCHED8; PG8_MMA(0, 0, At, B0); PG8_MMA(0, 1, At, B1); PG8_SCHED8; PG8_BAR; PG8_SCHED;
            PG8_LDA(At, 0, 1); PG8_STAGE(PG8_SB(0, 0), b2, voffB); PG8_STAGE(PG8_SB(0, 1), b2 + hstep, voffB); if constexpr (GATH) PG8_STAGE_G(PG8_SA(0, 0), a2, last ? gn[0][0] : gc[0][0], last ? gn[0][1] : gc[0][1]); else PG8_STAGE(PG8_SA(0, 0), a2, voffA);
            PG8_WAIT_V(8); PG8_WAIT_L(0); PG8_BAR; PG8_SCHED8; PG8_MMA(1, 0, At, B0); PG8_MMA(1, 1, At, B1); PG8_SCHED8; PG8_BAR; PG8_SCHED;
            PG8_LDB(B0, 1, 0); PG8_LDB(B1, 1, 1); PG8_SCHED; PG8_LDA(At, 1, 0); if constexpr (GATH) PG8_STAGE_G(PG8_SA(0, 1), a2, last ? gn[1][0] : gc[1][0], last ? gn[1][1] : gc[1][1]); else PG8_STAGE(PG8_SA(0, 1), a2 + hstepA, voffA);
            PG8_WAIT_V(8); PG8_WAIT_L(0); PG8_BAR; PG8_SCHED8; PG8_MMA(0, 0, At, B0); PG8_MMA(0, 1, At, B1); PG8_SCHED8; PG8_BAR; PG8_SCHED;
            PG8_LDA(At, 1, 1); PG8_STAGE(PG8_SB(1, 0), b3, voffB); PG8_STAGE(PG8_SB(1, 1), b3 + hstep, voffB); if constexpr (GATH) PG8_STAGE_G(PG8_SA(1, 0), a3, last ? gn[0][0] : gc[0][0], last ? gn[0][1] : gc[0][1]); else PG8_STAGE(PG8_SA(1, 0), a3, voffA);
            PG8_WAIT_V(8); PG8_WAIT_L(0); PG8_BAR; PG8_SCHED8; PG8_MMA(1, 0, At, B0); PG8_MMA(1, 1, At, B1); PG8_SCHED8; PG8_BAR; PG8_SCHED;
            } else {
            PG8_LDB(B0, 0, 0); PG8_SCHED; PG8_LDA(At, 0, 0); PG8_STAGE(PG8_SA(1, 1), a1 + hstepA, voffA);
            PG8_WAIT_L(8); PG8_BAR; PG8_WAIT_L(0); PG8_MMA(0, 0, At, B0); PG8_BAR; PG8_SCHED;
            PG8_LDB(B1, 0, 1); PG8_STAGE(PG8_SB(0, 0), b2, voffB);
            PG8_BAR; PG8_WAIT_L(0); PG8_MMA(0, 1, At, B1); PG8_BAR;
            PG8_LDA(At, 0, 1); PG8_STAGE(PG8_SA(0, 0), a2, voffA);
            PG8_BAR; PG8_WAIT_L(0); PG8_MMA(1, 0, At, B0); PG8_BAR; PG8_SCHED;
            PG8_STAGE(PG8_SB(0, 1), b2 + hstep, voffB);
            PG8_WAIT_V(6); PG8_BAR; PG8_MMA(1, 1, At, B1); PG8_BAR;
            PG8_LDB(B0, 1, 0); PG8_SCHED; PG8_LDA(At, 1, 0); PG8_STAGE(PG8_SA(0, 1), a2 + hstepA, voffA);
            PG8_WAIT_L(8); PG8_BAR; PG8_WAIT_L(0); PG8_MMA(0, 0, At, B0); PG8_BAR; PG8_SCHED;
            PG8_LDB(B1, 1, 1); PG8_STAGE(PG8_SB(1, 0), b3, voffB);
            PG8_BAR; PG8_WAIT_L(0); PG8_MMA(0, 1, At, B1); PG8_BAR;
            PG8_LDA(At, 1, 1); PG8_STAGE(PG8_SA(1, 0), a3, voffA);
            PG8_BAR; PG8_WAIT_L(0); PG8_MMA(1, 0, At, B0); PG8_BAR; PG8_SCHED;
            PG8_STAGE(PG8_SB(1, 1), b3 + hstep, voffB);
            PG8_WAIT_V(6); PG8_BAR; PG8_MMA(1, 1, At, B1); PG8_BAR;
            }
        }
        if constexpr (F8) asm volatile("s_nop 15\n\ts_nop 15" ::: "memory");
        if constexpr (ALIGN_EPI) { if (wr == 0) PG8_BAR; }
        if constexpr (!Epi::AFTER_DRAIN) { E(acc, cur, wr, wc, fr, fq); S.done(cur); }
        if (!has_next) break;
#pragma unroll
        for (int a = 0; a < 2; ++a)
#pragma unroll
            for (int b = 0; b < 2; ++b)
#pragma unroll
                for (int m = 0; m < 4; ++m)
#pragma unroll
                    for (int n = 0; n < 2; ++n) acc[a][b][m][n] = (f32x4){0.f, 0.f, 0.f, 0.f};
        cur = nxt; cA = nA; cB = nB; ++ui;
        if constexpr (GATH) {
#pragma unroll
            for (int h = 0; h < 2; ++h)
#pragma unroll
                for (int i = 0; i < 2; ++i) gc[h][i] = gn[h][i]; }
        if constexpr (ALIGN_EPI) { if (wr == 1) PG8_BAR; }
    }
    PG8_WAIT_V(0);
    if constexpr (!ALIGN_EPI) { if (wr == 0) PG8_BAR; }
    PG8_BAR;
    if constexpr (Epi::AFTER_DRAIN) { E.fused(acc, cur, wr, wc, fr, fq, lds, wid, lane); S.done(cur); }
#undef PG8_SA
#undef PG8_SB
#undef PG8_STAGE
#undef PG8_STAGE_G
#undef PG8_LDA
#undef PG8_LDB
#undef PG8_MMA
#undef PG8_WAIT_V
#undef PG8_WAIT_L
#undef PG8_BAR
#undef PG8_SCHED
#undef PG8_SCHED8
}
}


constexpr int NB = 8, T = 8192, D = 1024, NTOK = NB * T, DIN = 2816, NL = 2, GW = 256;
constexpr int NWAVES = 8, NTHR = 512;
constexpr int HP = 2048;
constexpr int NEXP = 32, DEXP = 512;
constexpr int MAXTILES = (2 * NTOK) / 256 + NEXP;
constexpr int SROWS = MAXTILES * 256;
constexpr int C_HQ = 0, C_HF = 256, C_HI = 512, C_HG = 768, C_SU = 1024, C_RW = 1280, C_LG = 2304, C_LX = 2560;

constexpr size_t MiB = 1u << 20;
constexpr size_t WS_CTL = 0, CTL_ZERO_BYTES = 1 * MiB;
constexpr size_t WL_STRIDE = 105 * MiB;
constexpr size_t WO_IN = 0, WO_OUT = 6 * MiB, WO_GLU = 8 * MiB, WO_GU = 9 * MiB, WO_DN = 73 * MiB, WO_RT = 8 * MiB + 512 * 1024;
constexpr size_t WS_W = 1 * MiB;
constexpr size_t S5_STRIDE = 9 * MiB;
constexpr size_t S5O_F3 = 0, S5O_F1 = 4 * MiB, S5O_A16 = 8 * MiB;
constexpr size_t WS_S5 = 211 * MiB;
constexpr size_t WS_ACT = 229 * MiB;
constexpr size_t WS_PROJ = 357 * MiB;
constexpr size_t WS_MIX = 709 * MiB;
constexpr size_t WS_YG = WS_MIX + 128 * MiB;
constexpr size_t WS_VF = 869 * MiB;
constexpr size_t WS_HU = 901 * MiB;
constexpr size_t WS_XS = 933 * MiB;
constexpr size_t WS_ROUTE = 965 * MiB;
constexpr size_t WS_TCNT = 967 * MiB;
constexpr size_t WS_LG = 968 * MiB;
constexpr size_t WS_END = 986 * MiB;
static_assert(WS_PROJ + (size_t)NTOK * DIN * 2 <= WS_MIX && WS_PROJ + (size_t)SROWS * D * 2 <= WS_MIX, "proj region");
static_assert(WS_MIX + (size_t)SROWS * DEXP * 2 <= WS_VF, "mix region");
constexpr int CW_BAR = 4096;
constexpr int CW_CNT = 8192;
constexpr int CW_CUR = 8192 + 256;

constexpr int RING_BYTES = 131072;
constexpr int LDSCTL_OFF = RING_BYTES;
constexpr int LDS_TILE_E = LDSCTL_OFF + 64;
constexpr int LDS_MISC = LDS_TILE_E + MAXTILES * 4;
constexpr int LDS_BYTES = 147456;
static_assert(LDS_MISC + 1024 <= LDS_BYTES, "LDS map");

typedef unsigned short bf16;
typedef float f32x4 __attribute__((ext_vector_type(4)));
typedef float f32x2 __attribute__((ext_vector_type(2)));
typedef unsigned u32x4 __attribute__((ext_vector_type(4)));
typedef unsigned u32x2 __attribute__((ext_vector_type(2)));
typedef short bf16x8 __attribute__((ext_vector_type(8)));

typedef __bf16 hwbf2 __attribute__((ext_vector_type(2)));
__device__ __forceinline__ unsigned cvt2(float lo, float hi) { const f32x2 v = {lo, hi}; return __builtin_bit_cast(unsigned, __builtin_convertvector(v, hwbf2)); }
__device__ __forceinline__ unsigned pk2(float lo, float hi) { return cvt2(lo, hi); }
__device__ __forceinline__ unsigned f2bf(float f) { return cvt2(f, 0.f) & 0xffffu; }
__device__ __forceinline__ float bf2f(unsigned b) { return __builtin_bit_cast(float, b << 16); }
__device__ __forceinline__ float bflo(unsigned w) { return __builtin_bit_cast(float, w << 16); }
__device__ __forceinline__ float bfhi(unsigned w) { return __builtin_bit_cast(float, w & 0xffff0000u); }
__device__ __forceinline__ void unpack8(const u32x4 w, float (&o)[8]) { o[0] = bflo(w.x); o[1] = bfhi(w.x); o[2] = bflo(w.y); o[3] = bfhi(w.y); o[4] = bflo(w.z); o[5] = bfhi(w.z); o[6] = bflo(w.w); o[7] = bfhi(w.w); }
__device__ __forceinline__ float frcp(float x) { return __builtin_amdgcn_rcpf(x); }
__device__ __forceinline__ float sigmoidf_(float x) { return frcp(1.f + __expf(-x)); }
__device__ __forceinline__ float siluf_(float x) { return x * frcp(1.f + __expf(-x)); }
__device__ __forceinline__ float softplusf_(float x) { return x > 15.f ? x : __logf(1.f + __expf(x)); }
__device__ __forceinline__ float gelu_tanh(float x) { const float u = 0.7978845608028654f * (x + 0.044715f * x * x * x); return x * frcp(1.f + __expf(-2.f * u)); }
#define DPPF(v, ctrl) __builtin_bit_cast(float, __builtin_amdgcn_update_dpp(0, __builtin_bit_cast(int, (v)), (ctrl), 0xf, 0xf, true))
__device__ __forceinline__ float row16_sum(float v) {
    v += DPPF(v, 0xB1);
    v += DPPF(v, 0x4E);
    v += DPPF(v, 0x141);
    v += DPPF(v, 0x140);
    return v;
}
__device__ __forceinline__ float wave_sum(float v) {
    v = row16_sum(v);
    return (__builtin_bit_cast(float, __builtin_amdgcn_readlane(__builtin_bit_cast(int, v), 0)) + __builtin_bit_cast(float, __builtin_amdgcn_readlane(__builtin_bit_cast(int, v), 16)))
         + (__builtin_bit_cast(float, __builtin_amdgcn_readlane(__builtin_bit_cast(int, v), 32)) + __builtin_bit_cast(float, __builtin_amdgcn_readlane(__builtin_bit_cast(int, v), 48)));
}
__device__ __forceinline__ float half_sum(float v, int lane) {
    v = row16_sum(v);
    const float a = __builtin_bit_cast(float, __builtin_amdgcn_readlane(__builtin_bit_cast(int, v), 0)) + __builtin_bit_cast(float, __builtin_amdgcn_readlane(__builtin_bit_cast(int, v), 16));
    const float b = __builtin_bit_cast(float, __builtin_amdgcn_readlane(__builtin_bit_cast(int, v), 32)) + __builtin_bit_cast(float, __builtin_amdgcn_readlane(__builtin_bit_cast(int, v), 48));
    return (lane & 32) ? b : a;
}
#define PIN1(a) asm volatile("" : "+v"(a))
#define PIN2(v) asm volatile("" : "+v"((v).x), "+v"((v).y))
#define PIN4(v) asm volatile("" : "+v"((v).x), "+v"((v).y), "+v"((v).z), "+v"((v).w))
#define LDS_WAIT() asm volatile("s_waitcnt lgkmcnt(0)" ::: "memory")
#define LDS_BARRIER() do { asm volatile("s_waitcnt lgkmcnt(0)" ::: "memory"); __builtin_amdgcn_s_barrier(); asm volatile("" ::: "memory"); } while (0)


#define XB_TMO      128
#define XB_XCNT(j)  (256  + 64 * (j))
#define XB_XSUB(j)  (1280 + 64 * (j))
#define XB_XGEN(j)  (2304 + 64 * (j))
#define XB_TOP      3328
#define XB_TOPGEN   3392
#define XCD_BAR_WORDS 3456
#define XB_SPIN_CAP (1u << 18)

__device__ __forceinline__ unsigned xb_ld(unsigned* p)              { return __hip_atomic_load(p, __ATOMIC_RELAXED, __HIP_MEMORY_SCOPE_AGENT); }
__device__ __forceinline__ unsigned xb_add(unsigned* p, unsigned v) { return __hip_atomic_fetch_add(p, v, __ATOMIC_RELAXED, __HIP_MEMORY_SCOPE_AGENT); }
__device__ __forceinline__ unsigned xb_xcc_id() { return (unsigned)__builtin_amdgcn_s_getreg((3 << 11) | 20) & 0xFu; }
#define XB_SPIN(cond, bar) do { unsigned _sp = 0; while (cond) { __builtin_amdgcn_s_sleep(1); \
    if ((++_sp & 255u) == 0u) { if (xb_ld(&(bar)[XB_TMO])) break; if (_sp > XB_SPIN_CAP) { atomicAdd(&(bar)[XB_TMO], 1u); break; } } } } while (0)

struct XcdBarrier {
    unsigned* bar; unsigned x;
    volatile LAS unsigned* st;
};

__device__ __forceinline__ XcdBarrier xcd_barrier_post(unsigned* bar, volatile LAS unsigned* st) {
    XcdBarrier b; b.bar = bar; b.x = xb_xcc_id(); b.st = st;
    if (threadIdx.x == 0) (void)xb_add(&bar[XB_XCNT(b.x)], 1u);
    return b;
}
__device__ __forceinline__ void xcd_barrier_complete(unsigned* bar, unsigned x, unsigned& nloc, unsigned& nx) {
    const unsigned G = gridDim.x * gridDim.y * gridDim.z;
    unsigned sum, cnt, mine, sp = 0u;
    for (;;) {
        sum = 0u; cnt = 0u; mine = 0u;
#pragma unroll
        for (unsigned j = 0; j < 16; ++j) { const unsigned c = xb_ld(&bar[XB_XCNT(j)]); sum += c; cnt += (c > 0u) ? 1u : 0u; mine = (j == x) ? c : mine; }
        if (sum == G) break;
        __builtin_amdgcn_s_sleep(1);
        if ((++sp & 255u) == 0u) { if (xb_ld(&bar[XB_TMO])) break; if (sp > XB_SPIN_CAP) { atomicAdd(&bar[XB_TMO], 1u); break; } }
    }
    nloc = mine > 0u ? mine : 1u; nx = cnt > 0u ? cnt : 1u;
}

__device__ __forceinline__ void xcd_barrier(const XcdBarrier& b) {
    asm volatile("s_waitcnt vmcnt(0)" ::: "memory");
    __syncthreads();
    if (threadIdx.x == 0) {
        unsigned* bar = b.bar;
        __builtin_amdgcn_s_waitcnt(0);
        unsigned nloc = b.st[0], nx = b.st[1];
        if (nloc == 0u) { xcd_barrier_complete(bar, b.x, nloc, nx); b.st[0] = nloc; b.st[1] = nx; }
        const unsigned old = xb_add(&bar[XB_XSUB(b.x)], 1u);
        const unsigned gen = old / nloc;
        if (old + 1u == (gen + 1u) * nloc) {
            __builtin_amdgcn_fence(__ATOMIC_RELEASE, "agent");
            asm volatile("s_waitcnt vmcnt(0)" ::: "memory");
            const unsigned og = xb_add(&bar[XB_TOP], 1u);
            const unsigned tg = og / nx;
            if (og + 1u == (tg + 1u) * nx) xb_add(&bar[XB_TOPGEN], 1u);
            else XB_SPIN(xb_ld(&bar[XB_TOPGEN]) == tg, bar);
            __builtin_amdgcn_fence(__ATOMIC_ACQUIRE, "agent");
            xb_add(&bar[XB_XGEN(b.x)], 1u);
            asm volatile("s_waitcnt vmcnt(0)" ::: "memory");
        } else {
            XB_SPIN(xb_ld(&bar[XB_XGEN(b.x)]) == gen, bar);
            __builtin_amdgcn_fence(__ATOMIC_ACQUIRE, "agent");
            asm volatile("s_waitcnt vmcnt(0)" ::: "memory");
        }
    }
    __syncthreads();
}


struct Params { const float* in[46]; float* out; unsigned char* ws; int ph_lo, ph_hi; };
enum { I_X = 0, I_NORM1, I_WIN, I_HLB, I_HNW, I_S5LR, I_S5LI, I_S5DT, I_S5BR, I_S5BI, I_S5CR, I_S5CI, I_S5D, I_S5GLU, I_RMU, I_RW0, I_RW2, I_RA0, I_RA2, I_RG2,
       I_RKK, I_RKA, I_RRK, I_RV0, I_RV1, I_RV2, I_RLNW, I_RLNB, I_LCW, I_LCB, I_LWA, I_LBA, I_LWX, I_LBX, I_LLAM, I_MGAIN, I_WOUT, I_NORM2, I_MCW, I_MCB, I_MFW, I_MFB,
       I_MWG, I_MWU, I_MWD, I_FNW };

__device__ __forceinline__ void transpose_item(const float* W, int ldw, int k0, int n0, bf16* dst, int K, LAS float* scr, int lane) {
#pragma unroll 8
    for (int i = 0; i < 32; ++i) { const int kk = 2 * i + (lane >> 5); scr[kk * 33 + (lane & 31)] = W[(size_t)(k0 + kk) * ldw + n0 + (lane & 31)]; }
    LDS_WAIT(); asm volatile("" ::: "memory");
    const int c = lane & 7;
#pragma unroll
    for (int j = 0; j < 4; ++j) { const int n = (lane >> 3) + 8 * j; const LAS float* s = scr + (8 * c) * 33 + n;
        u32x4 o; o.x = pk2(s[0 * 33], s[1 * 33]); o.y = pk2(s[2 * 33], s[3 * 33]); o.z = pk2(s[4 * 33], s[5 * 33]); o.w = pk2(s[6 * 33], s[7 * 33]);
        *(u32x4*)(dst + (size_t)n * K + k0 + 8 * c) = o; }
    LDS_WAIT(); asm volatile("" ::: "memory");
}
__device__ __forceinline__ void transpose_item_f8(const float* W, int ldw, int k0, int n0, unsigned char* dst, int Kb, float sc, LAS float* scr, int lane) {
#pragma unroll 8
    for (int i = 0; i < 32; ++i) { const int kk = 2 * i + (lane >> 5); scr[kk * 33 + (lane & 31)] = W[(size_t)(k0 + kk) * ldw + n0 + (lane & 31)]; }
    LDS_WAIT(); asm volatile("" ::: "memory");
    const int c = lane & 7;
#pragma unroll
    for (int j = 0; j < 4; ++j) { const int n = (lane >> 3) + 8 * j; const LAS float* p = scr + (8 * c) * 33 + n; int w0 = 0, w1 = 0;
        w0 = __builtin_amdgcn_cvt_pk_fp8_f32(p[0 * 33] * sc, p[1 * 33] * sc, w0, false); w0 = __builtin_amdgcn_cvt_pk_fp8_f32(p[2 * 33] * sc, p[3 * 33] * sc, w0, true);
        w1 = __builtin_amdgcn_cvt_pk_fp8_f32(p[4 * 33] * sc, p[5 * 33] * sc, w1, false); w1 = __builtin_amdgcn_cvt_pk_fp8_f32(p[6 * 33] * sc, p[7 * 33] * sc, w1, true);
        *(unsigned long long*)(dst + (size_t)n * Kb + k0 + 8 * c) = (unsigned long long)(unsigned)w0 | ((unsigned long long)(unsigned)w1 << 32); }
    LDS_WAIT(); asm volatile("" ::: "memory");
}
constexpr int IT_IN = 16 * 88, IT_OUT = 16 * 32, IT_GLU = 4 * 16, IT_EXP = 32 * 256, IT_LAYER = IT_IN + IT_OUT + IT_GLU + 3 * IT_EXP;
__device__ __forceinline__ void prologue_item(const Params& P, int it, LAS float* scr, int lane) {
    const int l = it / IT_LAYER; int r = it % IT_LAYER;
    bf16* wl = (bf16*)(P.ws + WS_W + (size_t)l * WL_STRIDE);
    if (r < IT_IN) { const int kb = r / 88, nb = r % 88; transpose_item(P.in[I_WIN] + (size_t)l * D * DIN, DIN, 64 * kb, 32 * nb, (bf16*)((unsigned char*)wl + WO_IN) + (size_t)(32 * nb) * D, D, scr, lane); return; } r -= IT_IN;
    if (r < IT_OUT) { const int kb = r / 32, nb = r % 32; transpose_item(P.in[I_WOUT] + (size_t)l * D * D, D, 64 * kb, 32 * nb, (bf16*)((unsigned char*)wl + WO_OUT) + (size_t)(32 * nb) * D, D, scr, lane); return; } r -= IT_OUT;
    if (r < IT_GLU) { const int kb = r / 16, nb = r % 16, n0 = 32 * nb, nn = n0 & 255, drow = (nn >> 7) * 256 + (nn & 127) + ((n0 >> 8) ? 128 : 0);
        transpose_item(P.in[I_S5GLU] + (size_t)l * 256 * 512, 512, 64 * kb, n0, (bf16*)((unsigned char*)wl + WO_GLU) + (size_t)drow * 256, 256, scr, lane); return; } r -= IT_GLU;
    if (r < 2 * IT_EXP) { const int up = r / IT_EXP; r %= IT_EXP; const int e = r >> 8, q = r & 255, kb = q >> 4, nb = q & 15, n0 = 32 * nb, drow = (n0 >> 7) * 256 + (n0 & 127) + (up ? 128 : 0);
        transpose_item_f8(P.in[up ? I_MWU : I_MWG] + (size_t)(l * NEXP + e) * D * DEXP, DEXP, 64 * kb, n0, (unsigned char*)wl + WO_GU + (size_t)e * D * D + (size_t)drow * D, D, 64.f, scr, lane); return; } r -= 2 * IT_EXP;
    { const int e = r >> 8, q = r & 255, kb = q >> 5, nb = q & 31;
      transpose_item_f8(P.in[I_MWD] + (size_t)(l * NEXP + e) * DEXP * D, D, 64 * kb, 32 * nb, (unsigned char*)wl + WO_DN + (size_t)e * D * DEXP + (size_t)(32 * nb) * DEXP, DEXP, 64.f, scr, lane); }
}
__device__ __forceinline__ void rms_store_bf16(const f32x4 (&v)[4], const float* gain, bf16* orow, int lane) {
    float s = 0.f;
#pragma unroll
    for (int j = 0; j < 4; ++j) s += (v[j].x * v[j].x + v[j].y * v[j].y) + (v[j].z * v[j].z + v[j].w * v[j].w);
    const float rstd = 1.f / sqrtf(wave_sum(s) * (1.f / D) + 1e-6f);
    u32x2* o8 = (u32x2*)orow + lane;
#pragma unroll
    for (int j = 0; j < 4; ++j) { const f32x4 g = *((const f32x4*)gain + lane + 64 * j); u32x2 w; w.x = pk2(v[j].x * rstd * g.x, v[j].y * rstd * g.y); w.y = pk2(v[j].z * rstd * g.z, v[j].w * rstd * g.w); o8[64 * j] = w; }
}
__device__ __forceinline__ void s5_pow(float lr, float li, double dt, int j, float& ar, float& ai) {
    const double m = exp((double)lr * dt * (double)j); double ang = (double)li * dt * (double)j; ang -= 6.283185307179586 * rint(ang * 0.15915494309189535);
    ar = (float)(m * cos(ang)); ai = (float)(m * sin(ang));
}
__device__ __forceinline__ void s5_consts_unit(const Params& P, int l, int g, LAS unsigned char* lds, int tid) {
    LAS float* PW = (LAS float*)lds;
    LAS float* BBr = PW + 64 * 17 * 2;
    LAS float* BBi = BBr + 1024;
    LAS float* Cr = BBi + 1024;
    LAS float* Ci = Cr + 1024;
    LAS float* KT = Ci + 1024;
    const int lg = l * 16 + g;
    const double dt = exp((double)P.in[I_S5DT][lg]);
    const float* lrp = P.in[I_S5LR] + (size_t)lg * 64; const float* lip = P.in[I_S5LI] + (size_t)lg * 64;
    for (int idx = tid; idx < 64 * 17; idx += NTHR) { const int p = idx / 17, j = idx % 17; float ar, ai; s5_pow(lrp[p], lip[p], dt, j, ar, ai); PW[idx * 2] = ar; PW[idx * 2 + 1] = ai; }
    for (int idx = tid; idx < 1024; idx += NTHR) { const int p = idx >> 4, c = idx & 15; const float lr = lrp[p], li = lip[p]; float ar, ai; s5_pow(lr, li, dt, 1, ar, ai);
        const float den = lr * lr + li * li, kr = ((ar - 1.f) * lr + ai * li) / den, ki = (ai * lr - (ar - 1.f) * li) / den;
        const float br = P.in[I_S5BR][((size_t)lg * 64 + p) * 16 + c], bi = P.in[I_S5BI][((size_t)lg * 64 + p) * 16 + c];
        BBr[idx] = kr * br - ki * bi; BBi[idx] = kr * bi + ki * br;
        Cr[idx] = P.in[I_S5CR][(size_t)lg * 1024 + idx]; Ci[idx] = P.in[I_S5CI][(size_t)lg * 1024 + idx]; }
    __syncthreads();
    for (int idx = tid; idx < 4096; idx += NTHR) { const int j = idx >> 8, c = (idx >> 4) & 15, cp = idx & 15; float acc = 0.f;
        for (int p = 0; p < 64; ++p) { const float ar = PW[(p * 17 + j) * 2], ai = PW[(p * 17 + j) * 2 + 1], br = BBr[p * 16 + cp], bi = BBi[p * 16 + cp], cr = Cr[c * 64 + p], ci = Ci[c * 64 + p];
            const float zr = ar * br - ai * bi, zi = ar * bi + ai * br; acc += cr * zr - ci * zi; }
        KT[idx] = acc; }
    __syncthreads();
    unsigned char* sb = P.ws + WS_S5 + (size_t)l * S5_STRIDE;
    bf16* F3 = (bf16*)(sb + S5O_F3) + (size_t)g * 98304; bf16* F1 = (bf16*)(sb + S5O_F1) + (size_t)g * 32768; float* A16 = (float*)(sb + S5O_A16) + (size_t)g * 128;
    for (int idx = tid; idx < 98304; idx += NTHR) { const int j = idx & 7, ln = (idx >> 3) & 63, fk = idx >> 9, ks = fk % 12, rt = fk / 12; const int row = 16 * rt + (ln & 15), k = 32 * ks + 8 * (ln >> 4) + j, t = row >> 4, c = row & 15; float val;
        if (k < 256) { const int s2 = k >> 4, cp = k & 15; val = (s2 <= t) ? KT[((t - s2) * 16 + c) * 16 + cp] : 0.f; }
        else { const int n = k - 256, p = n & 63; const float ar = PW[(p * 17 + t + 1) * 2], ai = PW[(p * 17 + t + 1) * 2 + 1], cr = Cr[c * 64 + p], ci = Ci[c * 64 + p]; val = (n < 64) ? (cr * ar - ci * ai) : -(cr * ai + ci * ar); }
        F3[idx] = (bf16)f2bf(val); }
    for (int idx = tid; idx < 32768; idx += NTHR) { const int j = idx & 7, ln = (idx >> 3) & 63, fk = idx >> 9, ks = fk & 7, rt = fk >> 3; const int n = 16 * rt + (ln & 15), k = 32 * ks + 8 * (ln >> 4) + j, p = n & 63, s2 = k >> 4, cp = k & 15;
        const float ar = PW[(p * 17 + 15 - s2) * 2], ai = PW[(p * 17 + 15 - s2) * 2 + 1], br = BBr[p * 16 + cp], bi = BBi[p * 16 + cp];
        F1[idx] = (bf16)f2bf((n < 64) ? (ar * br - ai * bi) : (ar * bi + ai * br)); }
    if (tid < 64) { A16[tid * 2] = PW[(tid * 17 + 16) * 2]; A16[tid * 2 + 1] = PW[(tid * 17 + 16) * 2 + 1]; }
    __syncthreads();
}
__device__ __forceinline__ void ph_prologue(const Params& P, LAS unsigned char* lds, int tid, int lane, int wave) {
    for (int u = blockIdx.x; u < NL * 16; u += gridDim.x) s5_consts_unit(P, u >> 4, u & 15, lds, tid);
    LAS float* scr = (LAS float*)(lds + wave * 16384);
    const int gw = blockIdx.x * NWAVES + wave, NGW = gridDim.x * NWAVES;
    for (int it = gw; it < NL * IT_LAYER; it += NGW) prologue_item(P, it, scr, lane);
    for (int idx = blockIdx.x * NTHR + tid; idx < NL * 256 * 1024; idx += gridDim.x * NTHR) { const int l = idx >> 18, n = (idx >> 10) & 255, k = idx & 1023; float val = 0.f;
        if (n < 72) { const int j = n % 36; const float w = (j < 4) ? P.in[I_MCW][((size_t)l * D + k) * 4 + j] : P.in[I_MFW][(((size_t)l * 4 + ((j - 4) >> 3)) * D + k) * 8 + ((j - 4) & 7)]; val = w * P.in[I_NORM2][(size_t)l * D + k]; }
        const unsigned hi = f2bf(val); const float rem = val - __builtin_bit_cast(float, hi << 16);
        ((bf16*)(P.ws + WS_W + (size_t)l * WL_STRIDE + WO_RT))[(size_t)n * D + k] = (bf16)((n >= 36) ? f2bf(rem) : hi); }
    bf16* act = (bf16*)(P.ws + WS_ACT);
    for (int m = gw; m < NTOK; m += NGW) {
        const f32x4* xr = (const f32x4*)(P.in[I_X] + (size_t)m * D) + lane; f32x4 v[4];
#pragma unroll
        for (int j = 0; j < 4; ++j) v[j] = xr[64 * j];
        rms_store_bf16(v, P.in[I_NORM1], act + (size_t)m * D, lane);
    }
}


__device__ __forceinline__ u32x4 ldg16(const bf16* p) { return *(const u32x4*)p; }

#define MF(a, b, c) __builtin_amdgcn_mfma_f32_16x16x32_bf16((a), (b), (c), 0, 0, 0)
__device__ __forceinline__ u32x2 pack4(const f32x4 d) { u32x2 w; w.x = cvt2(d[0], d[1]); w.y = cvt2(d[2], d[3]); return w; }
__device__ __forceinline__ bf16x8 cat8(const u32x2 lo, const u32x2 hi) { u32x4 w; w.x = lo.x; w.y = lo.y; w.z = hi.x; w.w = hi.y; return __builtin_bit_cast(bf16x8, w); }
__device__ __forceinline__ bf16x8 pack_lo(const f32x4 d) { return cat8(pack4(d), (u32x2){0u, 0u}); }
__device__ __forceinline__ bf16x8 pack2(const f32x4 a, const f32x4 b) { return cat8(pack4(a), pack4(b)); }

__device__ __forceinline__ void role_hgrn(const Params& P, int l, int b, int hd, LAS unsigned char* lds, int tid, int lane, int wave) {
    LAS float* LF = (LAS float*)lds; LAS float* Oa = LF + 1024; LAS float* GamC = Oa + 1024;
    LAS bf16* Qh = (LAS bf16*)(GamC + 64); LAS bf16* Kt = Qh + 16 * 72; LAS bf16* KbarT = Kt + 16 * 72; LAS bf16* VmTb = KbarT + 64 * 24;
    const bf16* proj = (const bf16*)(P.ws + WS_PROJ); bf16* mix = (bf16*)(P.ws + WS_MIX);
    const int tl = tid & 255, tt = tl >> 4, j4 = (tl & 15) * 4, r = lane & 15, q = lane >> 4;
    const int tA = (wave < 4) ? (lane & 15) : tt, jA = (wave < 4) ? 16 * wave + 4 * (lane >> 4) : j4;
    f32x4 lb = {0.f, 0.f, 0.f, 0.f};
    if (l > 0) {
#pragma unroll
        for (int i = 0; i < 4; ++i) { const int c = hd * 64 + jA + i; lb[i] = 1.f / (1.f + expf(P.in[I_HLB][c] - P.in[I_HLB][256 + c])); } }
    const f32x4 nw = *(const f32x4*)(P.in[I_HNW] + l * 256 + hd * 64 + j4);
    f32x4 st[4];
#pragma unroll
    for (int i = 0; i < 4; ++i) st[i] = (f32x4){0.f, 0.f, 0.f, 0.f};
    const bf16* pr0 = proj + ((size_t)b * T + tA) * DIN + hd * 64 + jA;
    u32x2 n0, n1; f32x4 qv = lb, kkv = lb, civ = lb, cmv = lb, sgc = lb, sgn = lb;
    if (wave < 4) { n0 = *(const u32x2*)(pr0 + C_HQ); n1 = *(const u32x2*)(pr0 + C_HF); } else { n0 = *(const u32x2*)(pr0 + C_HI); n1 = *(const u32x2*)(pr0 + C_HG); }
#define HG_STAGE_A(c) do { u32x2 rq = n0, rf = n1; PIN2(rq); PIN2(rf); \
        { const int cn_ = (c) + 1 < T / 16 ? (c) + 1 : T / 16 - 1; const bf16* pn = pr0 + (size_t)cn_ * 16 * DIN; n0 = *(const u32x2*)(pn + C_HQ); n1 = *(const u32x2*)(pn + C_HF); } \
        const f32x4 fx = {bflo(rf.x), bfhi(rf.x), bflo(rf.y), bfhi(rf.y)}, qx = {bflo(rq.x), bfhi(rq.x), bflo(rq.y), bfhi(rq.y)}; \
        f32x4 lfv; \
        _Pragma("unroll") for (int i = 0; i < 4; ++i) { const float e = __expf(fminf(-fx[i], 80.f)), ri_ = frcp(1.f + e); const float f = lb[i] + (1.f - lb[i]) * ri_; kkv[i] = (1.f - lb[i]) * e * ri_; lfv[i] = __logf(f); qv[i] = siluf_(qx[i]); } \
          \
        _Pragma("unroll") for (int i = 0; i < 4; ++i) { float p_ = lfv[i], s_ = lfv[i]; \
            p_ += DPPF(p_, 0x111); p_ += DPPF(p_, 0x112); p_ += DPPF(p_, 0x114); p_ += DPPF(p_, 0x118); \
            s_ += DPPF(s_, 0x101); s_ += DPPF(s_, 0x102); s_ += DPPF(s_, 0x104); s_ += DPPF(s_, 0x108); \
            civ[i] = p_; cmv[i] = s_ - lfv[i]; } } while (0)
#define HG_STAGE_V(c) do { u32x2 ri = n0, rg = n1; PIN2(ri); PIN2(rg); \
        { const int cn_ = (c) + 1 < T / 16 ? (c) + 1 : T / 16 - 1; const bf16* pn = pr0 + (size_t)cn_ * 16 * DIN; n0 = *(const u32x2*)(pn + C_HI); n1 = *(const u32x2*)(pn + C_HG); } \
        const f32x4 ix = {bflo(ri.x), bfhi(ri.x), bflo(ri.y), bfhi(ri.y)}, gx = {bflo(rg.x), bfhi(rg.x), bflo(rg.y), bfhi(rg.y)}; f32x4 vv; LAS bf16* VmT_ = VmTb + ((c) & 1) * 1536; \
        _Pragma("unroll") for (int i = 0; i < 4; ++i) { vv[i] = siluf_(ix[i]); sgn[i] = siluf_(gx[i]); } \
        { const u32x2 vp = pack4(vv); VmT_[(j4 + 0) * 24 + tt] = (bf16)(vp.x & 0xffffu); VmT_[(j4 + 1) * 24 + tt] = (bf16)(vp.x >> 16); VmT_[(j4 + 2) * 24 + tt] = (bf16)(vp.y & 0xffffu); VmT_[(j4 + 3) * 24 + tt] = (bf16)(vp.y >> 16); } } while (0)
#define HG_STAGE_B(c) do { f32x4 qh, kt, kb; \
        _Pragma("unroll") for (int i = 0; i < 4; ++i) { qh[i] = qv[i] * __expf(civ[i]); kt[i] = kkv[i] * __expf(fminf(-civ[i], 80.f)); kb[i] = kkv[i] * __expf(cmv[i]); } \
        *(LAS u32x2*)(Qh + tA * 72 + jA) = pack4(qh); *(LAS u32x2*)(Kt + tA * 72 + jA) = pack4(kt); \
        { const u32x2 kbp = pack4(kb); KbarT[(jA + 0) * 24 + tA] = (bf16)(kbp.x & 0xffffu); KbarT[(jA + 1) * 24 + tA] = (bf16)(kbp.x >> 16); KbarT[(jA + 2) * 24 + tA] = (bf16)(kbp.y & 0xffffu); KbarT[(jA + 3) * 24 + tA] = (bf16)(kbp.y >> 16); } \
        if (tA == 15) { f32x4 gc; _Pragma("unroll") for (int i = 0; i < 4; ++i) gc[i] = __expf(civ[i]); *(LAS f32x4*)(GamC + jA) = gc; } } while (0)
    if (wave < 4) HG_STAGE_A(0); else { HG_STAGE_V(0); sgc = sgn; }
    __syncthreads();
    if (wave < 4) HG_STAGE_B(0);
    __syncthreads();
    if (wave < 4) {
#pragma unroll 1
        for (int c = 0; c < T / 16; ++c) { const int cn = c + 1 < T / 16 ? c + 1 : T / 16 - 1;
            HG_STAGE_A(cn); LDS_BARRIER(); HG_STAGE_B(cn); LDS_BARRIER(); }
    } else {
#pragma unroll 1
        for (int c = 0; c < T / 16; ++c) { const int cn = c + 1 < T / 16 ? c + 1 : T / 16 - 1;
            { const int vt = wave - 4; const f32x4 z4 = {0.f, 0.f, 0.f, 0.f}; f32x4 AT = z4, o = z4; const LAS bf16* VmT_ = VmTb + (c & 1) * 1536;
#pragma unroll
              for (int ks = 0; ks < 2; ++ks) AT = MF(*(const LAS bf16x8*)(Kt + r * 72 + ks * 32 + q * 8), *(const LAS bf16x8*)(Qh + r * 72 + ks * 32 + q * 8), AT);
#pragma unroll
              for (int i = 0; i < 4; ++i) AT[i] = (4 * q + i <= r) ? AT[i] : 0.f;
              const u32x2 vmB = *(const LAS u32x2*)(VmT_ + (16 * vt + r) * 24 + 4 * q); const bf16x8 bV = cat8(vmB, (u32x2){0u, 0u});
#pragma unroll
              for (int ks = 0; ks < 2; ++ks) o = MF(cat8(*(const LAS u32x2*)(Qh + r * 72 + 32 * ks + 4 * q), *(const LAS u32x2*)(Qh + r * 72 + 32 * ks + 16 + 4 * q)), pack2(st[2 * ks], st[2 * ks + 1]), o);
              o = MF(pack_lo(AT), bV, o);
#pragma unroll
              for (int i = 0; i < 4; ++i) Oa[(4 * q + i) * 64 + 16 * vt + r] = o[i];
#pragma unroll
              for (int kt = 0; kt < 4; ++kt) { const f32x4 g4 = *(const LAS f32x4*)(GamC + 16 * kt + 4 * q);
                  st[kt] = MF(cat8(*(const LAS u32x2*)(KbarT + (16 * kt + r) * 24 + 4 * q), (u32x2){0u, 0u}), bV, st[kt] * g4); } }
            LDS_BARRIER();
            { const f32x4 o4 = *(const LAS f32x4*)(Oa + tt * 64 + j4);
              const float ss = row16_sum((o4[0] * o4[0] + o4[1] * o4[1]) + (o4[2] * o4[2] + o4[3] * o4[3])); const float rs = __builtin_amdgcn_rsqf(ss * (1.f / 64.f) + 1e-6f);
              *(u32x2*)(mix + ((size_t)b * T + c * 16 + tt) * D + hd * 64 + j4) = pack4(o4 * rs * nw * sgc);
              HG_STAGE_V(cn); sgc = sgn; }
            LDS_BARRIER(); }
    }
#undef HG_STAGE_A
#undef HG_STAGE_V
#undef HG_STAGE_B
}

__device__ __forceinline__ f32x4 mma_tile(const LAS bf16* A, int lda, const LAS bf16* Bt, int ldb, int K, int lane) {
    f32x4 acc = {0.f, 0.f, 0.f, 0.f}; const int r = lane & 15, q = lane >> 4;
    for (int k0 = 0; k0 < K; k0 += 32) { const bf16x8 a = *(const LAS bf16x8*)(A + r * lda + k0 + q * 8); const bf16x8 b = *(const LAS bf16x8*)(Bt + r * ldb + k0 + q * 8);
        acc = __builtin_amdgcn_mfma_f32_16x16x32_bf16(a, b, acc, 0, 0, 0); }
    return acc;
}
__device__ __forceinline__ void lds_load_wT(const float* W, int ldw, int n0, int N, int K, LAS bf16* Wt, int ldt, int tid) {
#pragma unroll 2
    for (int idx = tid; idx < K * N; idx += NTHR) { const int k = idx / N, n = idx % N; Wt[n * ldt + k] = (bf16)f2bf(W[(size_t)k * ldw + n0 + n]); }
}

__device__ __forceinline__ void role_lru(const Params& P, int l, int b, int hd, LAS unsigned char* lds, int tid, int lane, int wave) {
    LAS float* XR = (LAS float*)lds; LAS float* LG = XR + 67 * 64; LAS float* XC = LG + 4096; LAS float* RL = XC + 4096; LAS float* GL = RL + 4096;
    LAS bf16* XCb = (LAS bf16*)(GL + 4096); LAS bf16* WaT = XCb + 64 * 72; LAS bf16* WxT = WaT + 64 * 72; LAS float* CWL = (LAS float*)(WxT + 64 * 72);
    const bf16* proj = (const bf16*)(P.ws + WS_PROJ); bf16* mix = (bf16*)(P.ws + WS_MIX);
    const int tt = tid >> 3, c8 = (tid & 7) * 8;
    lds_load_wT(P.in[I_LWA] + (size_t)(l * 4 + hd) * 4096, 64, 0, 64, 64, WaT, 72, tid);
    lds_load_wT(P.in[I_LWX] + (size_t)(l * 4 + hd) * 4096, 64, 0, 64, 64, WxT, 72, tid);
    if (tid < 320) { const int jj = tid >> 6, c = tid & 63; CWL[tid] = (jj < 4) ? P.in[I_LCW][(size_t)l * 4 * 256 + jj * 256 + hd * 64 + c] : P.in[I_LCB][l * 256 + hd * 64 + c]; }
    if (tid < 24) {
#pragma unroll
        for (int i = 0; i < 8; ++i) XR[(tid >> 3) * 64 + c8 + i] = 0.f; }
    float pba[2], pbx[2], pspl[2];
#pragma unroll
    for (int h2 = 0; h2 < 2; ++h2) { const int j = ((wave >> 2) * 2 + h2) * 16 + (lane & 15), c = l * 256 + hd * 64 + j; pba[h2] = P.in[I_LBA][c]; pbx[h2] = P.in[I_LBX][c]; pspl[h2] = log1pf(expf(-P.in[I_LLAM][c])); }
    float hstate = 0.f;
    const bf16* px = proj + ((size_t)b * T + tt) * DIN + C_LX + hd * 64 + c8; const bf16* pgp = proj + ((size_t)b * T + tt) * DIN + C_LG + hd * 64 + c8;
    u32x4 nx = ldg16(px), ngt = ldg16(pgp);
    __syncthreads();
#pragma unroll 1
    for (int blk = 0; blk < T / 64; ++blk) {
        const int t0 = blk * 64;
        {   float x[8], g[8]; unpack8(nx, x); unpack8(ngt, g);
            if (blk + 1 < T / 64) { nx = ldg16(px + (size_t)(t0 + 64) * DIN); ngt = ldg16(pgp + (size_t)(t0 + 64) * DIN); }
#pragma unroll
            for (int i = 0; i < 8; ++i) { XR[(tt + 3) * 64 + c8 + i] = x[i]; LG[tt * 64 + c8 + i] = g[i]; }
        }
        LDS_BARRIER();
        {   float xc[8];
#pragma unroll
            for (int i = 0; i < 8; ++i) { const int c = c8 + i; float a = CWL[256 + c];
#pragma unroll
                for (int jj = 0; jj < 4; ++jj) a += CWL[jj * 64 + c] * XR[(tt + jj) * 64 + c];
                XC[tt * 64 + c] = a; xc[i] = a; }
            u32x4 w; w.x = cvt2(xc[0], xc[1]); w.y = cvt2(xc[2], xc[3]); w.z = cvt2(xc[4], xc[5]); w.w = cvt2(xc[6], xc[7]); *(LAS u32x4*)(XCb + tt * 72 + c8) = w; }
        LDS_BARRIER();
        {   const int tt4 = wave & 3, r = lane & 15, q = lane >> 4;
#pragma unroll
            for (int h2 = 0; h2 < 2; ++h2) { const int nt = (wave >> 2) * 2 + h2, j = nt * 16 + r;
                const f32x4 ar = mma_tile(XCb + tt4 * 16 * 72, 72, WaT + nt * 16 * 72, 72, 64, lane), ag = mma_tile(XCb + tt4 * 16 * 72, 72, WxT + nt * 16 * 72, 72, 64, lane);
#pragma unroll
                for (int i = 0; i < 4; ++i) { const int t = tt4 * 16 + q * 4 + i; const float rr = sigmoidf_(ar[i] + pba[h2]), gi = sigmoidf_(ag[i] + pbx[h2]); const float la = -8.f * rr * pspl[h2];
                    const float e2 = __expf(2.f * la); RL[t * 64 + j] = __expf(la); GL[t * 64 + j] = sqrtf(1.f - e2) * gi * XC[t * 64 + j]; } }
            if (tid < 24) {
#pragma unroll
                for (int i = 0; i < 8; ++i) XR[(tid >> 3) * 64 + c8 + i] = XR[(64 + (tid >> 3)) * 64 + c8 + i]; }
        }
        LDS_BARRIER();
        if (tid < 64) {
#pragma unroll 8
            for (int t = 0; t < 64; ++t) { hstate = RL[t * 64 + tid] * hstate + GL[t * 64 + tid]; XC[t * 64 + tid] = hstate; } }
        LDS_BARRIER();
        {   u32x4 w; float o[8];
#pragma unroll
            for (int i = 0; i < 8; ++i) o[i] = gelu_tanh(LG[tt * 64 + c8 + i]) * XC[tt * 64 + c8 + i];
            w.x = cvt2(o[0], o[1]); w.y = cvt2(o[2], o[3]); w.z = cvt2(o[4], o[5]); w.w = cvt2(o[6], o[7]);
            *(u32x4*)(mix + ((size_t)b * T + t0 + tt) * D + 768 + hd * 64 + c8) = w; }
        LDS_BARRIER();
    }
}

__device__ __forceinline__ void s5_stage_u(const bf16* proj, int b, int g, int t0, LAS unsigned char* UL, int tid) {
#pragma unroll
    for (int rep = 0; rep < 4; ++rep) { const int tk = rep * 256 + (tid >> 1), half = tid & 1; const u32x4 v = ldg16(proj + ((size_t)b * T + t0 + tk) * DIN + C_SU + g * 16 + half * 8);
        const int cl = tk >> 4, s = tk & 15; *(LAS u32x4*)(UL + (cl >> 4) * 8192 + ((s * 16 + (cl & 15)) * 32 + half * 16)) = v; }
}
__device__ __forceinline__ void role_s5(const Params& P, int l, int b, int g, LAS unsigned char* lds, int tid, int lane, int wave) {
    LAS unsigned char* UL = lds; LAS unsigned char* XL = lds + 32768; LAS float* ES = (LAS float*)(lds + 49152);
    const bf16* proj = (const bf16*)(P.ws + WS_PROJ); bf16* yg = (bf16*)(P.ws + WS_YG);
    const unsigned char* sb = P.ws + WS_S5 + (size_t)l * S5_STRIDE;
    const bf16* F3 = (const bf16*)(sb + S5O_F3) + (size_t)g * 98304; const bf16* F1 = (const bf16*)(sb + S5O_F1) + (size_t)g * 32768; const float* A16 = (const float*)(sb + S5O_A16) + (size_t)g * 128;
    float* Hu = (float*)(P.ws + WS_HU) + (size_t)(b * 16 + g) * 512 * 128; float* Xs = (float*)(P.ws + WS_XS) + (size_t)(b * 16 + g) * 512 * 128;
    const int c16 = lane & 15, q = lane >> 4;
    {
        bf16x8 af[8];
#pragma unroll
        for (int ks = 0; ks < 8; ++ks) af[ks] = *(const bf16x8*)(F1 + ((size_t)(wave * 8 + ks) * 64 + lane) * 8);
#pragma unroll 1
        for (int it = 0; it < 8; ++it) {
            s5_stage_u(proj, b, g, it * 1024, UL, tid);
            __syncthreads();
#pragma unroll 1
            for (int ct = 0; ct < 4; ++ct) { f32x4 acc = {0.f, 0.f, 0.f, 0.f};
#pragma unroll
                for (int ks = 0; ks < 8; ++ks) { const bf16x8 bv = *(const LAS bf16x8*)(UL + ct * 8192 + (((2 * ks + (q >> 1)) * 16 + c16) * 32 + (q & 1) * 16)); acc = __builtin_amdgcn_mfma_f32_16x16x32_bf16(af[ks], bv, acc, 0, 0, 0); }
                *(f32x4*)(Hu + (size_t)(it * 64 + ct * 16 + c16) * 128 + 16 * wave + 4 * q) = acc; }
            __syncthreads();
        }
    }
    __threadfence(); __syncthreads();
    {
        const float ar = A16[lane * 2], ai = A16[lane * 2 + 1]; const float* hb = Hu + (size_t)(wave * 64) * 128; float xr = 0.f, xi = 0.f;
#pragma unroll 8
        for (int j = 0; j < 64; ++j) { const float hr = hb[j * 128 + lane], hi = hb[j * 128 + 64 + lane]; const float nr = ar * xr - ai * xi + hr, ni = ar * xi + ai * xr + hi; xr = nr; xi = ni; }
        ES[wave * 128 + lane] = xr; ES[wave * 128 + 64 + lane] = xi;
        __syncthreads();
        float pr = ar, pi = ai;
#pragma unroll
        for (int i = 0; i < 6; ++i) { const float nr = pr * pr - pi * pi, ni = 2.f * pr * pi; pr = nr; pi = ni; }
        float cr = 0.f, ci = 0.f;
        for (int w2 = 0; w2 < wave; ++w2) { const float er = ES[w2 * 128 + lane], ei = ES[w2 * 128 + 64 + lane]; const float nr = pr * cr - pi * ci + er, ni = pr * ci + pi * cr + ei; cr = nr; ci = ni; }
        xr = cr; xi = ci; float* xb = Xs + (size_t)(wave * 64) * 128;
#pragma unroll 8
        for (int j = 0; j < 64; ++j) { const float hr = hb[j * 128 + lane], hi = hb[j * 128 + 64 + lane]; xb[j * 128 + lane] = xr; xb[j * 128 + 64 + lane] = xi; const float nr = ar * xr - ai * xi + hr, ni = ar * xi + ai * xr + hi; xr = nr; xi = ni; }
    }
    __threadfence(); __syncthreads();
    {
        bf16x8 af[2][12];
#pragma unroll
        for (int r2 = 0; r2 < 2; ++r2)
#pragma unroll
            for (int ks = 0; ks < 12; ++ks) af[r2][ks] = *(const bf16x8*)(F3 + ((size_t)((2 * wave + r2) * 12 + ks) * 64 + lane) * 8);
        float dsk[4];
#pragma unroll
        for (int i = 0; i < 4; ++i) dsk[i] = P.in[I_S5D][l * 256 + g * 16 + 4 * q + i];
#pragma unroll 1
        for (int it = 0; it < 8; ++it) {
            s5_stage_u(proj, b, g, it * 1024, UL, tid);
#pragma unroll
            for (int rep = 0; rep < 4; ++rep) { const int cl = rep * 16 + (tid >> 5), n4 = (tid & 31) * 4; const f32x4 x = *(const f32x4*)(Xs + (size_t)(it * 64 + cl) * 128 + n4);
                u32x2 w; w.x = pk2(x.x, x.y); w.y = pk2(x.z, x.w);
                *(LAS u32x2*)(XL + (cl >> 4) * 4096 + ((((n4 >> 5) * 4 + ((n4 >> 3) & 3)) * 16 + (cl & 15)) * 16 + (n4 & 7) * 2)) = w; }
            __syncthreads();
#pragma unroll 1
            for (int ct = 0; ct < 4; ++ct) { f32x4 acc0 = {0.f, 0.f, 0.f, 0.f}, acc1 = {0.f, 0.f, 0.f, 0.f};
#pragma unroll
                for (int ks = 0; ks < 8; ++ks) { const bf16x8 bv = *(const LAS bf16x8*)(UL + ct * 8192 + (((2 * ks + (q >> 1)) * 16 + c16) * 32 + (q & 1) * 16));
                    acc0 = __builtin_amdgcn_mfma_f32_16x16x32_bf16(af[0][ks], bv, acc0, 0, 0, 0); acc1 = __builtin_amdgcn_mfma_f32_16x16x32_bf16(af[1][ks], bv, acc1, 0, 0, 0); }
#pragma unroll
                for (int ks = 0; ks < 4; ++ks) { const bf16x8 bv = *(const LAS bf16x8*)(XL + ct * 4096 + ((ks * 4 + q) * 16 + c16) * 16);
                    acc0 = __builtin_amdgcn_mfma_f32_16x16x32_bf16(af[0][8 + ks], bv, acc0, 0, 0, 0); acc1 = __builtin_amdgcn_mfma_f32_16x16x32_bf16(af[1][8 + ks], bv, acc1, 0, 0, 0); }
#pragma unroll
                for (int r2 = 0; r2 < 2; ++r2) { const int t = 2 * wave + r2; const f32x4 acc = r2 ? acc1 : acc0;
                    const u32x2 uw = *(const LAS u32x2*)(UL + ct * 8192 + ((t * 16 + c16) * 32 + (4 * q) * 2));
                    const float y0 = gelu_tanh(acc[0] + dsk[0] * bflo(uw.x)), y1 = gelu_tanh(acc[1] + dsk[1] * bfhi(uw.x)), y2 = gelu_tanh(acc[2] + dsk[2] * bflo(uw.y)), y3 = gelu_tanh(acc[3] + dsk[3] * bfhi(uw.y));
                    u32x2 o; o.x = pk2(y0, y1); o.y = pk2(y2, y3);
                    *(u32x2*)(yg + ((size_t)b * T + it * 1024 + (ct * 16 + c16) * 16 + t) * 256 + g * 16 + 4 * q) = o; } }
            __syncthreads();
        }
    }
}

__device__ __forceinline__ void rw_load8(const bf16* cur, const bf16* prev, const float* mu, float (&o)[8]) {
    float p[8], q[8]; unpack8(ldg16(cur), p);
    if (prev) unpack8(ldg16(prev), q); else {
#pragma unroll
        for (int i = 0; i < 8; ++i) q[i] = 0.f; }
    const f32x4 m0 = *(const f32x4*)mu, m1 = *(const f32x4*)(mu + 4);
#pragma unroll
    for (int i = 0; i < 4; ++i) { o[i] = p[i] + m0[i] * (q[i] - p[i]); o[4 + i] = p[4 + i] + m1[i] * (q[4 + i] - p[4 + i]); }
}
__device__ __forceinline__ void rw_mix8(const u32x4 c, const u32x4 pv, const LAS float* mu, float (&o)[8]) {
    float p[8], q[8]; unpack8(c, p); unpack8(pv, q);
    const f32x4 m0 = *(const LAS f32x4*)mu, m1 = *(const LAS f32x4*)(mu + 4);
#pragma unroll
    for (int i = 0; i < 4; ++i) { o[i] = p[i] + m0[i] * (q[i] - p[i]); o[4 + i] = p[4 + i] + m1[i] * (q[4 + i] - p[4 + i]); }
}
__device__ __forceinline__ void st8f(LAS float* d, const float (&o)[8]) { *(LAS f32x4*)d = (f32x4){o[0], o[1], o[2], o[3]}; *(LAS f32x4*)(d + 4) = (f32x4){o[4], o[5], o[6], o[7]}; }
__device__ __forceinline__ void st8b(LAS bf16* d, const float (&o)[8]) { u32x4 w; w.x = cvt2(o[0], o[1]); w.y = cvt2(o[2], o[3]); w.z = cvt2(o[4], o[5]); w.w = cvt2(o[6], o[7]); *(LAS u32x4*)d = w; }
constexpr int RW_SLAB = 64, RW_NSLAB = 8, RW_RING = 3, RW_RUN = 8;
constexpr size_t RWB_STRIDE = 18944;
constexpr int RWB_WQ = 0, RWB_BB = 4096, RWB_KB = 6144, RWB_VM = 8192, RWB_GC = 10240, RWB_W2 = 10496, RWB_YL = 12544, RWB_G = 14592, RWB_BON = 16640;
constexpr int CW_TMO = 64, CW_RWP = 16384, CW_RWC = 32768;
static_assert((size_t)32 * RW_RING * RW_SLAB * RWB_STRIDE <= (size_t)128 * MiB, "bundle ring fits the ACT buffer");
__device__ __forceinline__ unsigned char* rw_bundle(const Params& P, int seq, int chunk) { return P.ws + WS_ACT + (size_t)((seq * RW_RING + ((chunk >> 6) % RW_RING)) * RW_SLAB + (chunk & 63)) * RWB_STRIDE; }
#define RLX_AGENT __ATOMIC_RELAXED, __HIP_MEMORY_SCOPE_AGENT
__device__ __forceinline__ void st_wt8(void* p, u32x2 v) { __hip_atomic_store((unsigned long long*)p, (unsigned long long)v.x | ((unsigned long long)v.y << 32), RLX_AGENT); }
__device__ __forceinline__ void wait_ge(unsigned* word, unsigned want, unsigned* tmo) {
    unsigned spins = 0;
    while ((unsigned)__builtin_amdgcn_readfirstlane(__hip_atomic_load(word, RLX_AGENT)) < want) {
        __builtin_amdgcn_s_sleep(2);
        if (++spins > (1u << 20)) { __hip_atomic_store(tmo, 1u, RLX_AGENT); break; }
        if ((spins & 1023u) == 0u && __builtin_amdgcn_readfirstlane(__hip_atomic_load(tmo, RLX_AGENT))) break;
    }
}
__device__ __forceinline__ void rwkv_producer(const Params& P, int l, int hd, int gp, int NPG, LAS unsigned char* lds, int tid, int lane, int wave) {
    unsigned* ctl = (unsigned*)(P.ws + WS_CTL);
    LAS bf16* W2T = (LAS bf16*)lds;
    LAS bf16* A2T = W2T + 64 * 72;
    LAS bf16* G2T = A2T + 64 * 72;
    LAS bf16* V1T = G2T + 64 * 136;
    LAS bf16* V2T = V1T + 32 * 264;
    LAS bf16* TWD = V2T + 64 * 40;
    LAS bf16* ADb = TWD + 16 * 72;
    LAS bf16* SGD = ADb + 16 * 72;
    LAS bf16* VALb = SGD + 16 * 136;
    LAS bf16* VHb = VALb + 16 * 264;
    LAS float* R = (LAS float*)(VHb + 16 * 40); LAS float* K = R + 1024; LAS float* V = K + 1024; LAS float* WL = V + 1024; LAS float* KK = WL + 1024; LAS float* Bb = KK + 1024;
    LAS float* G = Bb + 1024; LAS float* Y = G + 1024; LAS float* RK = Y + 1024  ; LAS float* AL = RK + 16; LAS float* VG = AL + 1024;
    LAS bf16* KKh = TWD; LAS bf16* Rh = KKh + 16 * 72; LAS bf16* Bt = Rh + 16 * 72; LAS bf16* Kt = Bt + 16 * 72; LAS bf16* BbarT = Kt + 16 * 72; LAS bf16* KbarT = BbarT + 64 * 24;
    LAS bf16* VmT = (LAS bf16*)AL; LAS bf16* KKhT = VmT + 64 * 24; LAS bf16* RhT = KKhT + 64 * 24; LAS float* GamC = (LAS float*)(RhT + 64 * 24); LAS bf16* WQ = (LAS bf16*)(GamC + 64); LAS float* MU = (LAS float*)(WQ + 32 * 72); LAS float* PT = MU + 1024;
    const bf16* proj = (const bf16*)(P.ws + WS_PROJ); bf16* mix = (bf16*)(P.ws + WS_MIX); bf16* vf = (bf16*)(P.ws + WS_VF);
    const float* mu_base = P.in[I_RMU] + (size_t)l * 1024;
    lds_load_wT(P.in[I_RW2] + (size_t)l * 64 * 256, 256, hd * 64, 64, 64, W2T, 72, tid);
    lds_load_wT(P.in[I_RA2] + (size_t)l * 64 * 256, 256, hd * 64, 64, 64, A2T, 72, tid);
    lds_load_wT(P.in[I_RG2] + (size_t)l * 128 * 256, 256, hd * 64, 64, 128, G2T, 136, tid);
    if (l > 0) { lds_load_wT(P.in[I_RV1], 32, 0, 32, 256, V1T, 264, tid); lds_load_wT(P.in[I_RV2], 256, hd * 64, 64, 32, V2T, 40, tid); }
    const int tt0 = tid >> 5, l320 = tid & 31;
    for (int i = tid; i < 1024; i += NTHR) MU[i] = mu_base[i];
    if (tid < 64) { const int c = l * 256 + hd * 64 + tid; PT[tid] = P.in[I_RW0][c]; PT[64 + tid] = P.in[I_RA0][c]; PT[128 + tid] = P.in[I_RKK][c]; PT[192 + tid] = P.in[I_RKA][c]; PT[256 + tid] = P.in[I_RRK][c];
        PT[320 + tid] = (l > 0) ? P.in[I_RV0][hd * 64 + tid] : 0.f; PT[384 + tid] = P.in[I_RLNW][c]; PT[448 + tid] = P.in[I_RLNB][c]; }
    const int segA = l320 >> 3, chA = l320 & 7, colA = (segA == 0 ? hd * 64 : segA == 1 ? 256 + hd * 64 : segA == 2 ? 768 : 832) + chA * 8, colB = 896 + (l320 & 15) * 8;
    const bool hasB = l320 < 16, hasC = (l > 0) || (l320 >= 16 && l320 < 24); const int colC = (l > 0) ? 512 + l320 * 8 : 512 + hd * 64 + (l320 & 7) * 8;
    const u32x4 zero4 = {0u, 0u, 0u, 0u};
    __syncthreads();
    const int nun = (NPG == 40) ? (gp < 32 ? 12 : gp < 40 ? 13 : 3) : 0;
#pragma unroll 1
    for (int k = 0; ; ++k) { int u;
        if (NPG == 40) { if (k >= nun) break; u = (gp >= 40) ? 488 + 8 * k + (gp - 40) : (k < 12 ? gp + 40 * k : 480 + (gp - 32)); }
        else { u = gp + k * NPG; if (u >= 512) break; }
    const int slab = u >> 6, b = (u >> 3) & 7, run = u & 7, seq = b * 4 + hd, cfirst = slab * RW_SLAB + run * RW_RUN;
    if (slab >= RW_RING) { if (wave == 0) wait_ge(ctl + CW_RWC + l * 1024 + seq * 16, (unsigned)(slab - RW_RING + 1), ctl + CW_TMO); __syncthreads(); }
    const bf16* rowp = proj + ((size_t)b * T + tt0) * DIN + C_RW; const bf16* vfp = vf + ((size_t)b * T + tt0) * 256 + hd * 64 + l320 * 2;
    u32x4 nAc, nAp, nBc = zero4, nBp = zero4, nCc = zero4, nCp = zero4; unsigned nvf = 0u;
    {   const bf16* rn = rowp + (size_t)(cfirst * 16) * DIN; const bool hp = (cfirst * 16 + tt0) > 0;
        nAc = ldg16(rn + colA); nAp = hp ? ldg16(rn - DIN + colA) : zero4;
        if (hasB) { nBc = ldg16(rn + colB); nBp = hp ? ldg16(rn - DIN + colB) : zero4; }
        if (hasC) { nCc = ldg16(rn + colC); nCp = hp ? ldg16(rn - DIN + colC) : zero4; }
        if (l > 0) nvf = *(const unsigned*)(vfp + (size_t)(cfirst * 16) * 256); }
#pragma unroll 1
    for (int blk = cfirst; blk < cfirst + RW_RUN; ++blk) {
        const int t0 = blk * 16; int tidl = tid; asm volatile("" : "+v"(tidl));
        const int tt = tidl >> 5, l32 = tidl & 31, lane = tidl & 63;
        const u32x4 rAc = nAc, rAp = nAp, rBc = nBc, rBp = nBp, rCc = nCc, rCp = nCp; const unsigned rvf = nvf;
        if (blk + 1 < cfirst + RW_RUN) { const bf16* rn = rowp + (size_t)(t0 + 16) * DIN;
            nAc = ldg16(rn + colA); nAp = ldg16(rn - DIN + colA);
            if (hasB) { nBc = ldg16(rn + colB); nBp = ldg16(rn - DIN + colB); }
            if (hasC) { nCc = ldg16(rn + colC); nCp = ldg16(rn - DIN + colC); }
            if (l > 0) nvf = *(const unsigned*)(vfp + (size_t)(t0 + 16) * 256); }
        unsigned char* bp = rw_bundle(P, seq, blk);
        {   float o[8];
            rw_mix8(rAc, rAp, MU + colA, o);
            if (segA == 0) st8f(R + tt * 64 + chA * 8, o); else if (segA == 1) st8f(K + tt * 64 + chA * 8, o);
            else if (segA == 2) {
#pragma unroll
                for (int i = 0; i < 8; ++i) { const float e = __expf(2.f * o[i]); o[i] = 1.f - 2.f * frcp(e + 1.f); }
                st8b(TWD + tt * 72 + chA * 8, o); }
            else st8b(ADb + tt * 72 + chA * 8, o);
            if (hasB) { rw_mix8(rBc, rBp, MU + colB, o);
#pragma unroll
                for (int i = 0; i < 8; ++i) o[i] = sigmoidf_(o[i]);
                st8b(SGD + tt * 136 + (l32 & 15) * 8, o); }
            if (hasC) { rw_mix8(rCc, rCp, MU + colC, o);
                if (l == 0) st8f(V + tt * 64 + (l32 & 7) * 8, o);
                else { st8b(VALb + tt * 264 + l32 * 8, o); if ((l32 >> 3) == hd) st8f(V + tt * 64 + (l32 & 7) * 8, o); } }
        }
        LDS_BARRIER();
        {   const int r = lane & 15, q = lane >> 4;
            if (wave < 4) { const f32x4 cw_ = mma_tile(TWD, 72, W2T + wave * 16 * 72, 72, 64, lane), ca = mma_tile(ADb, 72, A2T + wave * 16 * 72, 72, 64, lane);
#pragma unroll
                for (int i = 0; i < 4; ++i) { WL[(q * 4 + i) * 64 + wave * 16 + r] = cw_[i]; AL[(q * 4 + i) * 64 + wave * 16 + r] = ca[i]; }
                if (l > 0 && wave < 2) { const f32x4 ch_ = mma_tile(VALb, 264, V1T + wave * 16 * 264, 264, 256, lane);
#pragma unroll
                    for (int i = 0; i < 4; ++i) VHb[(q * 4 + i) * 40 + wave * 16 + r] = (bf16)f2bf(ch_[i]); } }
            else { const int nt = wave - 4; const f32x4 cg = mma_tile(SGD, 136, G2T + nt * 16 * 136, 136, 128, lane);
#pragma unroll
                for (int i = 0; i < 4; ++i) G[(q * 4 + i) * 64 + nt * 16 + r] = cg[i]; }
        }
        LDS_BARRIER();
        if (l > 0) {
            if (wave < 4) { const int r = lane & 15, q = lane >> 4; const f32x4 cv = mma_tile(VHb, 40, V2T + wave * 16 * 40, 40, 32, lane);
#pragma unroll
                for (int i = 0; i < 4; ++i) VG[(q * 4 + i) * 64 + wave * 16 + r] = cv[i]; }
            LDS_BARRIER();
        }
        {   const int j2 = l32 * 2; float ssq = 0.f, rk = 0.f; float kkv[2], av[2], vv2[2];
            const size_t tok = (size_t)b * T + t0 + tt;
#pragma unroll
            for (int i = 0; i < 2; ++i) { const int j = j2 + i, x = tt * 64 + j;
                const float wl = -softplusf_(-(PT[j] + WL[x])) - 0.5f; WL[x] = -__expf(wl);
                const float a = sigmoidf_(PT[64 + j] + AL[x]); av[i] = a;
                const float kr = K[x]; kkv[i] = kr * PT[128 + j]; ssq += kkv[i] * kkv[i];
                const float km = kr * (1.f + (a - 1.f) * PT[192 + j]); K[x] = km;
                float v = V[x];
                if (l > 0) { const float vfv = i ? bfhi(rvf) : bflo(rvf); v = v + (vfv - v) * sigmoidf_(PT[320 + j] + VG[x]); V[x] = v; }
                vv2[i] = v;
                rk += R[x] * km * PT[256 + j]; }
            if (l == 0) *(unsigned*)(vf + tok * 256 + hd * 64 + j2) = cvt2(vv2[0], vv2[1]);
            ssq = half_sum(ssq, lane); rk = half_sum(rk, lane);
            const float inv = frcp(fmaxf(sqrtf(ssq), 1e-12f));
#pragma unroll
            for (int i = 0; i < 2; ++i) { const int x = tt * 64 + j2 + i; const float kn = kkv[i] * inv; KK[x] = kn; Bb[x] = kn * av[i]; }
            if (l32 == 0) RK[tt] = rk;
        }
        LDS_BARRIER();
        {   const int j2 = l32 * 2; float ce0 = 0.f, ce1 = 0.f, ct0 = 0.f, ct1 = 0.f;
#pragma unroll
            for (int s2 = 0; s2 < 16; ++s2) { const f32x2 w2 = *(const LAS f32x2*)(WL + s2 * 64 + j2); if (s2 < tt) { ce0 += w2.x; ce1 += w2.y; } ct0 += w2.x; ct1 += w2.y; }
            const f32x2 wme = *(const LAS f32x2*)(WL + tt * 64 + j2); const float ci0 = ce0 + wme.x, ci1 = ce1 + wme.y;
            const float ex0 = __expf(ce0), ex1 = __expf(ce1), in0 = __expf(ci0), in1 = __expf(ci1), ng0 = __expf(-ci0), ng1 = __expf(-ci1), br0 = __expf(ct0 - ci0), br1 = __expf(ct1 - ci1);
            const int x = tt * 64 + j2; const f32x2 kk2 = *(const LAS f32x2*)(KK + x), r2 = *(const LAS f32x2*)(R + x), b2 = *(const LAS f32x2*)(Bb + x), k2 = *(const LAS f32x2*)(K + x), v2_ = *(const LAS f32x2*)(V + x);
            const unsigned kkh = cvt2(kk2.x * ex0, kk2.y * ex1), rh = cvt2(r2.x * in0, r2.y * in1);
            *(LAS unsigned*)(KKh + tt * 72 + j2) = kkh; *(LAS unsigned*)(Rh + tt * 72 + j2) = rh;
            *(LAS unsigned*)(Bt + tt * 72 + j2) = cvt2(b2.x * ng0, b2.y * ng1); *(LAS unsigned*)(Kt + tt * 72 + j2) = cvt2(k2.x * ng0, k2.y * ng1);
            KKhT[j2 * 24 + tt] = (bf16)(kkh & 0xffffu); KKhT[(j2 + 1) * 24 + tt] = (bf16)(kkh >> 16); RhT[j2 * 24 + tt] = (bf16)(rh & 0xffffu); RhT[(j2 + 1) * 24 + tt] = (bf16)(rh >> 16);
            { const unsigned bb = cvt2(b2.x * br0, b2.y * br1), kb = cvt2(k2.x * br0, k2.y * br1); BbarT[j2 * 24 + tt] = (bf16)(bb & 0xffffu); BbarT[(j2 + 1) * 24 + tt] = (bf16)(bb >> 16); KbarT[j2 * 24 + tt] = (bf16)(kb & 0xffffu); KbarT[(j2 + 1) * 24 + tt] = (bf16)(kb >> 16); }
            { const unsigned vv = cvt2(v2_.x, v2_.y); VmT[j2 * 24 + tt] = (bf16)(vv & 0xffffu); VmT[(j2 + 1) * 24 + tt] = (bf16)(vv >> 16); }
            if (tt == 0) { GamC[j2] = __expf(ct0); GamC[j2 + 1] = __expf(ct1); }
        }
        LDS_BARRIER();
        u32x2 vmB = {0u, 0u};
        {   const int r = lane & 15, q = lane >> 4; const f32x4 z4 = {0.f, 0.f, 0.f, 0.f};
            f32x4 NT = z4, Nn = z4, ArbT = z4;
#pragma unroll
            for (int ks = 0; ks < 2; ++ks) { const bf16x8 fb = *(const LAS bf16x8*)(Bt + r * 72 + ks * 32 + q * 8), fk = *(const LAS bf16x8*)(KKh + r * 72 + ks * 32 + q * 8), fr = *(const LAS bf16x8*)(Rh + r * 72 + ks * 32 + q * 8);
                NT = MF(fb, fk, NT); Nn = MF(fk, fb, Nn); ArbT = MF(fb, fr, ArbT); }
#pragma unroll
            for (int i = 0; i < 4; ++i) { const int rr = 4 * q + i; NT[i] = (rr < r) ? NT[i] : 0.f; Nn[i] = (r < rr) ? Nn[i] : 0.f; ArbT[i] = (rr <= r) ? ArbT[i] : 0.f; }
            const f32x4 N2 = MF(pack_lo(NT), pack_lo(Nn), z4), N2T = MF(pack_lo(Nn), pack_lo(NT), z4);
            const f32x4 N4 = MF(pack_lo(N2T), pack_lo(N2), z4), N4T = MF(pack_lo(N2), pack_lo(N2T), z4);
            const f32x4 N8T = MF(pack_lo(N4), pack_lo(N4T), z4);
            const bf16x8 aN8 = pack_lo(N8T), aN4 = pack_lo(N4T), aN2 = pack_lo(N2T), aN1 = pack_lo(-NT);
            if (wave < 4) {
                const int kt = wave; const u32x2 zb = *(const LAS u32x2*)(KKhT + (16 * kt + r) * 24 + 4 * q);
                f32x4 z = {bflo(zb.x), bfhi(zb.x), bflo(zb.y), bfhi(zb.y)};
                z = MF(aN8, pack_lo(z), z); z = MF(aN4, pack_lo(z), z); z = MF(aN2, pack_lo(z), z); z = MF(aN1, pack_lo(z), z);
                const u32x2 rb = *(const LAS u32x2*)(RhT + (16 * kt + r) * 24 + 4 * q); const f32x4 rc = {bflo(rb.x), bfhi(rb.x), bflo(rb.y), bfhi(rb.y)};
                const f32x4 qe = MF(pack_lo(-ArbT), pack_lo(z), rc);
#pragma unroll
                for (int i = 0; i < 4; ++i) { WQ[(4 * q + i) * 72 + 16 * kt + r] = (bf16)f2bf(z[i]); WQ[(16 + 4 * q + i) * 72 + 16 * kt + r] = (bf16)f2bf(qe[i]); }
            } else {
                const int vt = wave - 4; f32x4 AakT = z4, ArkT = z4;
#pragma unroll
                for (int ks = 0; ks < 2; ++ks) { const bf16x8 fkt = *(const LAS bf16x8*)(Kt + r * 72 + ks * 32 + q * 8), fk = *(const LAS bf16x8*)(KKh + r * 72 + ks * 32 + q * 8), fr = *(const LAS bf16x8*)(Rh + r * 72 + ks * 32 + q * 8);
                    AakT = MF(fkt, fk, AakT); ArkT = MF(fkt, fr, ArkT); }
#pragma unroll
                for (int i = 0; i < 4; ++i) { const int rr = 4 * q + i; AakT[i] = (rr < r) ? AakT[i] : 0.f; ArkT[i] = (rr <= r) ? ArkT[i] : 0.f; }
                vmB = *(const LAS u32x2*)(VmT + (16 * vt + r) * 24 + 4 * q);
                f32x4 z = MF(pack_lo(AakT), cat8(vmB, (u32x2){0u, 0u}), z4);
                z = MF(aN8, pack_lo(z), z); z = MF(aN4, pack_lo(z), z); z = MF(aN2, pack_lo(z), z); z = MF(aN1, pack_lo(z), z);
                const f32x4 yl_ = MF(pack2(ArkT, -ArbT), cat8(vmB, pack4(z)), z4);
                st_wt8(bp + RWB_W2 + (vt * 64 + lane) * 8, pack4(z)); st_wt8(bp + RWB_YL + (vt * 64 + lane) * 8, pack4(yl_));
            }
        }
        LDS_BARRIER();
        {
            { const int row = tidl >> 4, pc = tidl & 15, rr = row & 15, half = row >> 4, ks = pc >> 3, hi = (pc >> 2) & 1, qq = pc & 3;
              st_wt8(bp + RWB_WQ + (((2 * ks + half) * 64 + qq * 16 + rr) * 2 + hi) * 8, *(const LAS u32x2*)(WQ + row * 72 + pc * 4)); }
            for (int idx = tidl; idx < 768; idx += NTHR) { const int arr = idx >> 8, pi = idx & 255, row = pi >> 2, pc = pi & 3; const LAS bf16* src = (arr == 0 ? BbarT : arr == 1 ? KbarT : VmT) + row * 24 + pc * 4;
                const int ln = pc * 16 + (row & 15), t4 = row >> 4;
                st_wt8(bp + (arr < 2 ? RWB_BB + ((t4 * 64 + ln) * 2 + arr) * 8 : RWB_VM + (t4 * 64 + ln) * 8), *(const LAS u32x2*)src); }
            if (tidl < 32) st_wt8(bp + RWB_GC + tidl * 8, *(const LAS u32x2*)(GamC + tidl * 2));
            if (tidl < 256) { const int t = tidl >> 4, v4 = (tidl & 15) * 4; const f32x4 g4 = *(const LAS f32x4*)(G + t * 64 + v4); const f32x4 v4f = *(const LAS f32x4*)(V + t * 64 + v4); const float rkt = RK[t];
                st_wt8(bp + RWB_G + (t * 64 + v4) * 2, pack4(g4)); st_wt8(bp + RWB_BON + (t * 64 + v4) * 2, pack4(v4f * rkt)); }
        }
        LDS_BARRIER();
    }
    asm volatile("s_waitcnt vmcnt(0)" ::: "memory");
    __syncthreads();
    if (tid == 0) __hip_atomic_fetch_add(ctl + CW_RWP + l * 4096 + (seq * 8 + slab) * 16, 1u, RLX_AGENT);
    }
}
struct RwOps { u32x4 w[4]; u32x4 bk[4]; u32x2 vm, w2, yl; f32x4 gc[4]; };
__device__ __forceinline__ void rw_ops_load(RwOps& o, const unsigned char* bp, int vt, int r, int q, int lane) {
#pragma unroll
    for (int f = 0; f < 4; ++f) { o.w[f] = *(const u32x4*)(bp + RWB_WQ + (f * 64 + lane) * 16); o.bk[f] = *(const u32x4*)(bp + RWB_BB + (f * 64 + lane) * 16); o.gc[f] = *(const f32x4*)(bp + RWB_GC + (16 * f + 4 * q) * 4); }
    o.vm = *(const u32x2*)(bp + RWB_VM + (vt * 64 + lane) * 8); o.w2 = *(const u32x2*)(bp + RWB_W2 + (vt * 64 + lane) * 8); o.yl = *(const u32x2*)(bp + RWB_YL + (vt * 64 + lane) * 8);
}
__device__ __forceinline__ void rw_ops_load_lds(RwOps& o, const LAS unsigned char* sp, int vt, int q, int lane) {
#pragma unroll
    for (int f = 0; f < 4; ++f) { o.w[f] = *(const LAS u32x4*)(sp + RWB_WQ + (f * 64 + lane) * 16); o.bk[f] = *(const LAS u32x4*)(sp + RWB_BB + (f * 64 + lane) * 16); o.gc[f] = *(const LAS f32x4*)(sp + RWB_GC + (16 * f + 4 * q) * 4); }
    o.vm = *(const LAS u32x2*)(sp + RWB_VM + (vt * 64 + lane) * 8); o.w2 = *(const LAS u32x2*)(sp + RWB_W2 + (vt * 64 + lane) * 8); o.yl = *(const LAS u32x2*)(sp + RWB_YL + (vt * 64 + lane) * 8);
}
constexpr int RWL_N = 6, RWL_D = 6, RWL_SLOT = 20480;
static_assert(8192 + RWL_N * RWL_SLOT <= 131072, "consumer LDS ring");
__device__ __forceinline__ void rwkv_consumer(const Params& P, int l, int b, int hd, LAS unsigned char* lds, int tid, int lane, int wave) {
    LAS float* Yb = (LAS float*)lds;
    LAS unsigned char* ring = lds + 8192;
    unsigned* ctl = (unsigned*)(P.ws + WS_CTL); const int seq = b * 4 + hd;
    unsigned* prod = ctl + CW_RWP + l * 4096 + seq * 8 * 16; unsigned* cons = ctl + CW_RWC + l * 1024 + seq * 16; unsigned* tmo = ctl + CW_TMO;
    bf16* mix = (bf16*)(P.ws + WS_MIX);
    const int r = lane & 15, q = lane >> 4, vt = wave & 3;
    f32x4 st[4];
#pragma unroll
    for (int i = 0; i < 4; ++i) st[i] = (f32x4){0.f, 0.f, 0.f, 0.f};
    const int ot = (tid >> 4) & 15, ov4 = (tid & 15) * 4;
    f32x4 lnw = *(const f32x4*)(P.in[I_RLNW] + l * 256 + hd * 64 + ov4), lnb = *(const f32x4*)(P.in[I_RLNB] + l * 256 + hd * 64 + ov4);
    if (wave == 0) { wait_ge(prod, (unsigned)RW_RUN, tmo); __builtin_amdgcn_fence(__ATOMIC_ACQUIRE, "agent"); asm volatile("s_waitcnt vmcnt(0)" ::: "memory"); }
    __syncthreads();
    RwOps opA, opB; u32x2 gA = {0u, 0u}, bA = gA, gB = gA, bB = gA;
#define RW_DMA(X, SL) do { const unsigned char* bp_ = rw_bundle(P, seq, (X)); LAS unsigned char* sl_ = ring + (SL) * RWL_SLOT; \
        _Pragma("unroll") for (int rd = 0; rd < 5; ++rd) __builtin_amdgcn_global_load_lds((const unsigned*)(bp_ + (size_t)(rd * 256 + wave * 64 + lane) * 16), (LAS unsigned*)(sl_ + (rd * 256 + wave * 64) * 16), 16, 0, 0); } while (0)
    if (wave < 4) {
#pragma unroll
        for (int x = 0; x < RWL_D; ++x) RW_DMA(x, x); }
    asm volatile("s_waitcnt vmcnt(0)" ::: "memory");
    __syncthreads();
    if (wave >= 4) { rw_ops_load_lds(opA, ring, vt, q, lane); rw_ops_load_lds(opB, ring + RWL_SLOT, vt, q, lane); }
    else { gA = *(const LAS u32x2*)(ring + RWB_G + (ot * 64 + ov4) * 2); bA = *(const LAS u32x2*)(ring + RWB_BON + (ot * 64 + ov4) * 2); PIN4(lnw); PIN4(lnb); }
    u32x2* const dummy = (u32x2*)(P.ws + WS_LG) + tid;
#define RW_OUT(cp, GG, BN, DST) do { \
        const f32x4 y = *(const LAS f32x4*)(Yb + ((cp) & 1) * 1024 + ot * 64 + ov4); \
        const float mean = row16_sum((y[0] + y[1]) + (y[2] + y[3])) * (1.f / 64.f); const f32x4 d = y - mean; \
        const float var = row16_sum((d[0] * d[0] + d[1] * d[1]) + (d[2] * d[2] + d[3] * d[3])) * (1.f / 64.f); const float rs = __builtin_amdgcn_rsqf(var + 64e-5f); \
        const f32x4 o = (d * rs * lnw + lnb + (BN)) * (GG); \
        *(DST) = pack4(o); } while (0)
#define RW_SLABCHK(c) do { if ((((c) + RWL_D) & 63) == 0 && (c) + RWL_D < T / 16) { \
            if (wave == 0) { wait_ge(prod + (((c) + RWL_D) >> 6) * 16, (unsigned)RW_RUN, tmo); __builtin_amdgcn_fence(__ATOMIC_ACQUIRE, "agent"); asm volatile("s_waitcnt vmcnt(0)" ::: "memory"); } \
            __syncthreads(); } } while (0)
#define RW_REC(c, OP) do { RW_SLABCHK(c); \
            f32x4 d1 = {0.f, 0.f, 0.f, 0.f}, d2 = {0.f, 0.f, 0.f, 0.f}; \
            _Pragma("unroll") for (int ks = 0; ks < 2; ++ks) { const bf16x8 bS = pack2(st[2 * ks], st[2 * ks + 1]); d1 = MF(__builtin_bit_cast(bf16x8, OP.w[2 * ks]), bS, d1); d2 = MF(__builtin_bit_cast(bf16x8, OP.w[2 * ks + 1]), bS, d2); } \
            const f32x4 w2f = {bflo(OP.w2.x), bfhi(OP.w2.x), bflo(OP.w2.y), bfhi(OP.w2.y)}, ylf = {bflo(OP.yl.x), bfhi(OP.yl.x), bflo(OP.yl.y), bfhi(OP.yl.y)}; \
            const f32x4 un = -(d1 + w2f), yv = d2 + ylf; \
            LAS float* Y = Yb + ((c) & 1) * 1024; \
            _Pragma("unroll") for (int i = 0; i < 4; ++i) Y[(4 * q + i) * 64 + 16 * vt + r] = yv[i]; \
            const bf16x8 bUV = cat8(pack4(un), OP.vm); \
            _Pragma("unroll") for (int kt = 0; kt < 4; ++kt) st[kt] = MF(__builtin_bit_cast(bf16x8, OP.bk[kt]), bUV, st[kt] * OP.gc[kt]); \
            { const int cl_ = (c) + 2 < T / 16 ? (c) + 2 : T / 16 - 1; rw_ops_load_lds(OP, ring + (cl_ % RWL_N) * RWL_SLOT, vt, q, lane); } \
            LDS_BARRIER(); } while (0)
#define RW_OSTEP(c, GP, BP) do { RW_SLABCHK(c); \
            const f32x4 gg = {bflo(GP.x), bfhi(GP.x), bflo(GP.y), bfhi(GP.y)}, bn = {bflo(BP.x), bfhi(BP.x), bflo(BP.y), bfhi(BP.y)}; \
            { const int cn_ = (c) + 1 < T / 16 ? (c) + 1 : T / 16 - 1; const LAS unsigned char* sp_ = ring + (cn_ % RWL_N) * RWL_SLOT; GP = *(const LAS u32x2*)(sp_ + RWB_G + (ot * 64 + ov4) * 2); BP = *(const LAS u32x2*)(sp_ + RWB_BON + (ot * 64 + ov4) * 2); } \
            u32x2* dst_ = ((c) > 0) ? (u32x2*)(mix + ((size_t)b * T + ((c) - 1) * 16 + ot) * D + 512 + hd * 64 + ov4) : dummy; \
            RW_OUT((c) - 1, gg, bn, dst_); \
              \
            { const int cd_ = (c) + RWL_D < T / 16 ? (c) + RWL_D : T / 16 - 1; RW_DMA(cd_, ((c) + RWL_D) % RWL_N); asm volatile("s_waitcnt vmcnt(18)" ::: "memory"); } \
            LDS_BARRIER(); \
            if (((c) & 63) == 2 && (c) > 2 && tid == 0) { const unsigned cv_ = (unsigned)((c) >> 6);        \
                asm volatile("global_store_dword %0, %1, off sc1" :: "v"(cons), "v"(cv_) : "memory"); } } while (0)
    if (wave >= 4) {
#pragma unroll 1
        for (int c2 = 0; c2 < T / 16; c2 += 2) { RW_REC(c2, opA); RW_REC(c2 + 1, opB); }
    } else {
#pragma unroll 1
        for (int c2 = 0; c2 < T / 16; c2 += 2) { RW_OSTEP(c2, gB, bB); RW_OSTEP(c2 + 1, gA, bA); }
        const f32x4 gg = {bflo(gB.x), bfhi(gB.x), bflo(gB.y), bfhi(gB.y)}, bn = {bflo(bB.x), bfhi(bB.x), bflo(bB.y), bfhi(bB.y)};
        RW_OUT(T / 16 - 1, gg, bn, (u32x2*)(mix + ((size_t)b * T + (T / 16 - 1) * 16 + ot) * D + 512 + hd * 64 + ov4));
    }
#undef RW_SLABCHK
#undef RW_REC
#undef RW_OSTEP
#undef RW_OUT
#undef RW_DMA
    asm volatile("s_waitcnt vmcnt(0)" ::: "memory");
    __syncthreads();
}

__device__ __forceinline__ int lds_add(LAS int* p, int v) { return __hip_atomic_fetch_add(p, v, __ATOMIC_RELAXED, __HIP_MEMORY_SCOPE_WORKGROUP); }
__device__ __forceinline__ void ph_fin(const Params& P, int l, int lane, int wave) {
    const bf16* mix = (const bf16*)(P.ws + WS_MIX); bf16* act = (bf16*)(P.ws + WS_ACT); const float* gain = P.in[I_MGAIN] + (size_t)l * D;
    const int gw = blockIdx.x * NWAVES + wave, NGW = gridDim.x * NWAVES;
    const f32x4* gp = (const f32x4*)(gain + lane * 16); const f32x4 g0 = gp[0], g1 = gp[1], g2 = gp[2], g3 = gp[3];
#pragma unroll 1
    for (int m0 = gw * 4; m0 < NTOK; m0 += NGW * 4) {
        u32x4 ra[4], rb[4];
#pragma unroll
        for (int k = 0; k < 4; ++k) { ra[k] = ldg16(mix + (size_t)(m0 + k) * D + lane * 16); rb[k] = ldg16(mix + (size_t)(m0 + k) * D + lane * 16 + 8); }
#pragma unroll
        for (int k = 0; k < 4; ++k) { float v[16]; { float a[8], b2[8]; unpack8(ra[k], a); unpack8(rb[k], b2);
#pragma unroll
                for (int i = 0; i < 8; ++i) { v[i] = a[i]; v[8 + i] = b2[i]; } }
            float s2 = 0.f;
#pragma unroll
            for (int i = 0; i < 16; ++i) s2 += v[i] * v[i];
            s2 = row16_sum(s2);
            const float rstd = 1.f / sqrtf(s2 * (1.f / 256.f) + 1e-6f); u32x4 w0, w1;
            w0.x = cvt2(v[0] * rstd * g0.x, v[1] * rstd * g0.y); w0.y = cvt2(v[2] * rstd * g0.z, v[3] * rstd * g0.w); w0.z = cvt2(v[4] * rstd * g1.x, v[5] * rstd * g1.y); w0.w = cvt2(v[6] * rstd * g1.z, v[7] * rstd * g1.w);
            w1.x = cvt2(v[8] * rstd * g2.x, v[9] * rstd * g2.y); w1.y = cvt2(v[10] * rstd * g2.z, v[11] * rstd * g2.w); w1.z = cvt2(v[12] * rstd * g3.x, v[13] * rstd * g3.y); w1.w = cvt2(v[14] * rstd * g3.z, v[15] * rstd * g3.w);
            *(u32x4*)(act + (size_t)(m0 + k) * D + lane * 16) = w0; *(u32x4*)(act + (size_t)(m0 + k) * D + lane * 16 + 8) = w1; }
    }
}
__device__ __forceinline__ void ph_route(const Params& P, int l, LAS unsigned char* lds, int tid, int lane, int wave) {
    LAS int* hist = (LAS int*)(lds + LDS_MISC + 256);
    unsigned char* wl = P.ws + WS_W + (size_t)l * WL_STRIDE;
    pg8::StaticOrder S; S.init(NTOK / 256, 1, gridDim.x, blockIdx.x);
    { pg8::Gemm g{(const bf16*)P.out, (const bf16*)(wl + WO_RT), NTOK, 256, D, nullptr, 0, HP}; pg8::EpiLogits E{(float*)(P.ws + WS_LG)};
      pg8::gemm_phase<pg8::EpiLogits, pg8::StaticOrder, true, true>(lds, g, S, E); }
    bf16* act = (bf16*)(P.ws + WS_ACT); int* route = (int*)(P.ws + WS_ROUTE); int* tcnt = (int*)(P.ws + WS_TCNT);
    const float* n2 = P.in[I_NORM2] + (size_t)l * D; const float* cb = P.in[I_MCB] + l * 4; const float* fbias = P.in[I_MFB] + l * 32;
    LAS float* rsl = (LAS float*)lds;
    f32x4 gn[4];
#pragma unroll
    for (int j = 0; j < 4; ++j) gn[j] = *((const f32x4*)n2 + lane + 64 * j);
    for (int ui = 0; ; ++ui) {
    pg8::Unit un; if (!S.next(ui, un)) break;
    const int tile = un.pm;
    if (tid < NEXP) hist[tid] = 0;
    { const int mb = tile * 256 + wave * 32; u32x2 va[4], vb[4];
#define RT_LOAD(V, mm) do { const u32x2* hr_ = (const u32x2*)((const bf16*)P.out + (size_t)(mm) * HP) + lane; _Pragma("unroll") for (int j = 0; j < 4; ++j) V[j] = hr_[64 * j]; } while (0)
#define RT_ROW(V, kk) do { f32x4 v[4]; float s_ = 0.f; \
        _Pragma("unroll") for (int j = 0; j < 4; ++j) { v[j] = (f32x4){bflo(V[j].x), bfhi(V[j].x), bflo(V[j].y), bfhi(V[j].y)}; s_ += (v[j].x * v[j].x + v[j].y * v[j].y) + (v[j].z * v[j].z + v[j].w * v[j].w); } \
        if ((kk) + 2 < 32) RT_LOAD(V, mb + (kk) + 2); \
        const float rstd = 1.f / sqrtf(wave_sum(s_) * (1.f / D) + 1e-6f); if (lane == 0) rsl[wave * 32 + (kk)] = rstd; \
        unsigned* o4 = (unsigned*)((unsigned char*)act + (size_t)(mb + (kk)) * D) + lane; \
        _Pragma("unroll") for (int j = 0; j < 4; ++j) { const f32x4 g = gn[j]; int w8 = 0; w8 = __builtin_amdgcn_cvt_pk_fp8_f32(pg8::sat8(v[j].x * rstd * g.x), pg8::sat8(v[j].y * rstd * g.y), w8, false); w8 = __builtin_amdgcn_cvt_pk_fp8_f32(pg8::sat8(v[j].z * rstd * g.z), pg8::sat8(v[j].w * rstd * g.w), w8, true); o4[64 * j] = (unsigned)w8; } } while (0)
      RT_LOAD(va, mb); RT_LOAD(vb, mb + 1);
#pragma unroll 1
      for (int k = 0; k < 32; k += 2) { RT_ROW(va, k); RT_ROW(vb, k + 1); }
#undef RT_LOAD
#undef RT_ROW
    }
    __syncthreads();
    if (tid < 256) { const int m = tile * 256 + tid; const float rstd = rsl[tid];
        const f32x4* lp = (const f32x4*)((const float*)(P.ws + WS_LG) + (size_t)m * 72); f32x4 q[18];
#pragma unroll
        for (int i = 0; i < 18; ++i) q[i] = lp[i];
        float L[36];
#pragma unroll
        for (int j = 0; j < 36; ++j) L[j] = (q[j >> 2][j & 3] + q[(36 + j) >> 2][(36 + j) & 3]) * rstd + (j < 4 ? cb[j] : fbias[j - 4]);
        const float c0 = L[0], c1 = L[1], c2 = L[2], c3 = L[3];
        int gs = 0; float cm = c0; if (c1 > cm) { cm = c1; gs = 1; } if (c2 > cm) { cm = c2; gs = 2; } if (c3 > cm) { cm = c3; gs = 3; }
        const float pg = 1.f / (expf(c0 - cm) + expf(c1 - cm) + expf(c2 - cm) + expf(c3 - cm));
        float fa[8];
#pragma unroll
        for (int i = 0; i < 8; ++i) fa[i] = (gs == 0) ? L[4 + i] : (gs == 1) ? L[12 + i] : (gs == 2) ? L[20 + i] : L[28 + i];
        int i0 = 0; float m0 = fa[0];
#pragma unroll
        for (int i = 1; i < 8; ++i) if (fa[i] > m0) { m0 = fa[i]; i0 = i; }
        int i1 = (i0 == 0) ? 1 : 0; float m1 = -3.0e38f;
#pragma unroll
        for (int i = 0; i < 8; ++i) if (i != i0 && fa[i] > m1) { m1 = fa[i]; i1 = i; }
        const float e1w = expf(m1 - m0), w0 = pg / (1.f + e1w), w1 = pg * e1w / (1.f + e1w);
        const int e0 = gs * 8 + i0, e1 = gs * 8 + i1;
        typedef int i32x4 __attribute__((ext_vector_type(4)));
        *(i32x4*)(route + (size_t)m * 8) = (i32x4){e0, e1, __builtin_bit_cast(int, w0), __builtin_bit_cast(int, w1)};
        lds_add(&hist[e0], 1); lds_add(&hist[e1], 1); }
    __syncthreads();
    if (tid < NEXP) { tcnt[tile * 32 + tid] = hist[tid]; atomicAdd((unsigned*)(P.ws + WS_CTL) + CW_CNT + l * 64 + tid, (unsigned)hist[tid]); }
    __syncthreads();
    }
}
__device__ __forceinline__ int build_tiles(const Params& P, int l, LAS unsigned char* ldsall, int tid) {
    LAS int* tile_e = (LAS int*)(ldsall + LDS_TILE_E); LAS int* misc = (LAS int*)(ldsall + LDS_MISC);
    LAS int* ntl = (LAS int*)(ldsall + LDS_MISC + 512);
    if (tid < NEXP) { const unsigned* cnt = (const unsigned*)(P.ws + WS_CTL) + CW_CNT + l * 64; const int c = (int)__hip_atomic_load(cnt + tid, __ATOMIC_RELAXED, __HIP_MEMORY_SCOPE_AGENT); ntl[tid] = (c + 255) >> 8; }
    __syncthreads();
    if (tid < NEXP) { int r = 0; for (int e = 0; e < tid; ++e) r += ntl[e];
        const int nt = ntl[tid]; r = r < MAXTILES ? r : MAXTILES; misc[1 + tid] = r * 256;
        for (int q = 0; q < nt && r + q < MAXTILES; ++q) tile_e[r + q] = tid;
        if (tid == NEXP - 1) misc[0] = (r + nt < MAXTILES) ? r + nt : MAXTILES; }
    __syncthreads();
    return misc[0];
}
__device__ __forceinline__ void ph_scatter(const Params& P, int l, LAS unsigned char* ldsall, int tid, int lane, int wave) {
    build_tiles(P, l, ldsall, tid);
    LAS int* misc = (LAS int*)(ldsall + LDS_MISC); LAS int* base = (LAS int*)ldsall; LAS int* EL = base + 32; LAS int* POS = EL + 512; LAS int* part = POS + 512;
    int* route = (int*)(P.ws + WS_ROUTE); const int* tcnt = (const int*)(P.ws + WS_TCNT); int* rowsrc = (int*)(P.ws + WS_TCNT + 65536);
    for (int tile = blockIdx.x; tile < NTOK / 256; tile += gridDim.x) {
        { const int e = tid & 31, q = tid >> 5; int c[16];
#pragma unroll
          for (int i = 0; i < 16; ++i) { const int t2 = q + 16 * i; c[i] = (t2 < tile) ? tcnt[t2 * 32 + e] : 0; }
          int s = 0;
#pragma unroll
          for (int i = 0; i < 16; ++i) s += c[i];
          part[q * 32 + e] = s; }
        int e0 = 0, e1 = 0; const size_t tok = (size_t)tile * 256 + tid;
        if (tid < 256) { e0 = route[tok * 8]; e1 = route[tok * 8 + 1]; EL[tid * 2] = e0; EL[tid * 2 + 1] = e1; }
        __syncthreads();
        if (tid < 32) { int s = misc[1 + tid]; for (int q = 0; q < 16; ++q) s += part[q * 32 + tid]; base[tid] = s; }
        __syncthreads();
        if (tid < 256) { int r0 = 0, r1 = 0;
            for (int i = 0; i < 2 * tid; ++i) { const int e = EL[i]; r0 += (e == e0); r1 += (e == e1); }
            const int p0 = base[e0] + r0, p1 = base[e1] + r1;
            route[tok * 8 + 4] = p0; route[tok * 8 + 5] = p1; rowsrc[p0] = (int)tok; rowsrc[p1] = (int)tok; }
        __syncthreads();
        __syncthreads();
    }
}
__device__ __forceinline__ void cb_load(const Params& P, const unsigned char* ys, int m, int p0, int p1, int lane, u32x2 (&h)[4], unsigned (&a)[4], unsigned (&b2)[4]) {
    const u32x2* hr = (const u32x2*)((const bf16*)P.out + (size_t)m * HP) + lane; const unsigned* y0 = (const unsigned*)(ys + (size_t)p0 * D) + lane; const unsigned* y1 = (const unsigned*)(ys + (size_t)p1 * D) + lane;
#pragma unroll
    for (int j = 0; j < 4; ++j) { h[j] = hr[64 * j]; a[j] = y0[64 * j]; b2[j] = y1[64 * j]; }
}
__device__ __forceinline__ void ph_combine(const Params& P, int l, int lane, int wave) {
    const unsigned char* ys = (const unsigned char*)(P.ws + WS_PROJ); bf16* act = (bf16*)(P.ws + WS_ACT); const int* route = (const int*)(P.ws + WS_ROUTE);
    const float* gain = (l + 1 < NL) ? P.in[I_NORM1] + (size_t)(l + 1) * D : P.in[I_FNW];
    f32x4 gn[4];
#pragma unroll
    for (int j = 0; j < 4; ++j) gn[j] = *((const f32x4*)gain + lane + 64 * j);
    for (int tile = blockIdx.x; tile < NTOK / 256; tile += gridDim.x) {
        const int mb = tile * 256 + wave * 32;
        const int* rp = route + (size_t)(mb + (lane & 31)) * 8; const int rw0 = rp[2], rw1 = rp[3], rp0 = rp[4], rp1 = rp[5];
        u32x2 nh[4]; unsigned na[4], nb[4];
        cb_load(P, ys, mb, __builtin_amdgcn_readlane(rp0, 0), __builtin_amdgcn_readlane(rp1, 0), lane, nh, na, nb);
#pragma unroll 1
        for (int k = 0; k < 32; ++k) {
            const int m = mb + k; f32x4 v[4]; unsigned a[4], b2[4];
#pragma unroll
            for (int j = 0; j < 4; ++j) { v[j] = (f32x4){bflo(nh[j].x), bfhi(nh[j].x), bflo(nh[j].y), bfhi(nh[j].y)}; a[j] = na[j]; b2[j] = nb[j]; }
            const float w0 = __builtin_bit_cast(float, __builtin_amdgcn_readlane(rw0, k)) * 0.0625f, w1 = __builtin_bit_cast(float, __builtin_amdgcn_readlane(rw1, k)) * 0.0625f;
            if (k + 1 < 32) cb_load(P, ys, m + 1, __builtin_amdgcn_readlane(rp0, k + 1), __builtin_amdgcn_readlane(rp1, k + 1), lane, nh, na, nb);
            float s2 = 0.f;
#pragma unroll
            for (int j = 0; j < 4; ++j) { const f32x2 a01 = __builtin_amdgcn_cvt_pk_f32_fp8((int)a[j], false), a23 = __builtin_amdgcn_cvt_pk_f32_fp8((int)a[j], true), b01 = __builtin_amdgcn_cvt_pk_f32_fp8((int)b2[j], false), b23 = __builtin_amdgcn_cvt_pk_f32_fp8((int)b2[j], true);
                v[j].x += w0 * a01[0] + w1 * b01[0]; v[j].y += w0 * a01[1] + w1 * b01[1]; v[j].z += w0 * a23[0] + w1 * b23[0]; v[j].w += w0 * a23[1] + w1 * b23[1];
                s2 += (v[j].x * v[j].x + v[j].y * v[j].y) + (v[j].z * v[j].z + v[j].w * v[j].w); }
            const float rstd = 1.f / sqrtf(wave_sum(s2) * (1.f / D) + 1e-6f);
            f32x4* hr = (f32x4*)(P.out + (size_t)m * D) + lane;
            if (l + 1 < NL) { u32x2* o8 = (u32x2*)(act + (size_t)m * D) + lane; u32x2* hb = (u32x2*)((bf16*)P.out + (size_t)m * HP) + lane;
#pragma unroll
                for (int j = 0; j < 4; ++j) { u32x2 hw; hw.x = cvt2(v[j].x, v[j].y); hw.y = cvt2(v[j].z, v[j].w); hb[64 * j] = hw; u32x2 w; w.x = cvt2(v[j].x * rstd * gn[j].x, v[j].y * rstd * gn[j].y); w.y = cvt2(v[j].z * rstd * gn[j].z, v[j].w * rstd * gn[j].w); o8[64 * j] = w; }
            } else {
#pragma unroll
                for (int j = 0; j < 4; ++j) { f32x4 o; o.x = v[j].x * rstd * gn[j].x; o.y = v[j].y * rstd * gn[j].y; o.z = v[j].z * rstd * gn[j].z; o.w = v[j].w * rstd * gn[j].w; hr[64 * j] = o; }
            }
        }
    }
}

#ifndef MK_ONE_LAUNCH
#define MK_ONE_LAUNCH 1
#endif
constexpr int PH_PER_LAYER = 10, N_PHASES = 1 + NL * PH_PER_LAYER;
#ifndef PH_MASK
#ifdef DBG_NOMOE
#define PH_MASK 0x61f
#else
#define PH_MASK 0x7ff
#endif
#endif
#define PHE(j) (((PH_MASK) >> (j)) & 1)
#ifndef DUP_MASK
#define DUP_MASK 0
#endif
#define NREP(j) ((((DUP_MASK) >> (j)) & 1) ? 2 : 1)
#if MK_ONE_LAUNCH
#define GRID_BAR() xcd_barrier(bar)
#else
#define GRID_BAR() do {} while (0)
#endif
#define IN(k) (lo <= (k) && (k) < hi)
#define SEAM(k) do { if (IN(k) && IN((k) + 1)) GRID_BAR(); } while (0)
#ifndef DUP_ROLE
#define DUP_ROLE 0
#endif
#ifndef DUP_N
#define DUP_N 1
#endif
#define MIXBODY() do { \
            const int u_ = blockIdx.x; \
            if (u_ < 32) rwkv_consumer(P, l, u_ >> 2, u_ & 3, lds, tid, lane, wave); \
            else if (u_ < 64) role_hgrn(P, l, (u_ - 32) >> 2, u_ & 3, lds, tid, lane, wave); \
            else if (u_ < 96) { role_lru(P, l, (u_ - 64) >> 2, u_ & 3, lds, tid, lane, wave); __syncthreads(); rwkv_producer(P, l, u_ & 3, 40 + ((u_ - 64) >> 2), 40, lds, tid, lane, wave); } \
            else { rwkv_producer(P, l, (u_ - 96) & 3, (u_ - 96) >> 2, 40, lds, tid, lane, wave);        \
                   if (u_ < 224) { __syncthreads(); role_s5(P, l, (u_ - 96) >> 4, (u_ - 96) & 15, lds, tid, lane, wave); } } \
} while (0)
template <int l> __device__ __forceinline__ void layer_phases(const Params& P, LAS unsigned char* lds, const XcdBarrier& bar, int tid, int lane, int wave, int lo, int hi) {
        const int pb = 1 + l * PH_PER_LAYER;
        const unsigned char* wl = P.ws + WS_W + (size_t)l * WL_STRIDE;
        if (PHE(0) && IN(pb + 0)) {
            pg8::Gemm g{(const bf16*)(P.ws + WS_ACT), (const bf16*)(wl + WO_IN), NTOK, DIN, D}; pg8::StaticOrder S; S.init(NTOK / 256, DIN / 256, gridDim.x, blockIdx.x);
            pg8::EpiBf16 E{(bf16*)(P.ws + WS_PROJ), DIN};
            pg8::gemm_phase<pg8::EpiBf16, pg8::StaticOrder, true, true>(lds, g, S, E);
        } SEAM(pb + 0);
        if (PHE(1) && IN(pb + 1)) {
            MIXBODY();
            if (NREP(1) == 2) { GRID_BAR(); MIXBODY(); }
        } SEAM(pb + 1);
        if (PHE(2) && IN(pb + 2)) {
            pg8::Gemm g{(const bf16*)(P.ws + WS_YG), (const bf16*)(wl + WO_GLU), NTOK, 512, 256}; pg8::StaticOrder S; S.init(NTOK / 256, 2, gridDim.x, blockIdx.x);
            pg8::EpiGated<1> E{(bf16*)(P.ws + WS_MIX) + 256, D};
            pg8::gemm_phase<pg8::EpiGated<1>, pg8::StaticOrder, true, true>(lds, g, S, E);
        } SEAM(pb + 2);
        if (PHE(3) && IN(pb + 3)) { ph_fin(P, l, lane, wave); } SEAM(pb + 3);
        if (PHE(4) && IN(pb + 4)) {
            pg8::Gemm g{(const bf16*)(P.ws + WS_ACT), (const bf16*)(wl + WO_OUT), NTOK, D, D}; pg8::StaticOrder S; S.init(NTOK / 256, D / 256, gridDim.x, blockIdx.x);
            if (l == 0) { pg8::EpiResB<true> E{(bf16*)P.out, (const void*)P.in[I_X], HP, D}; pg8::gemm_phase<pg8::EpiResB<true>, pg8::StaticOrder, true, true>(lds, g, S, E); }
            else { pg8::EpiResB<false> E{(bf16*)P.out, (const void*)P.out, HP, HP}; pg8::gemm_phase<pg8::EpiResB<false>, pg8::StaticOrder, true, true>(lds, g, S, E); }
        } SEAM(pb + 4);
        if (PHE(5) && IN(pb + 5)) { ph_route(P, l, lds, tid, lane, wave); } SEAM(pb + 5);
        if (PHE(6) && IN(pb + 6)) { ph_scatter(P, l, lds, tid, lane, wave); } SEAM(pb + 6);
        if (PHE(7) && IN(pb + 7)) {
            const int R = build_tiles(P, l, lds, tid);
            pg8::Gemm g{(const bf16*)(P.ws + WS_ACT), (const bf16*)(wl + WO_GU), SROWS, D, D / 2  , (const int*)(P.ws + WS_TCNT + 65536), NTOK}; pg8::StaticOrder S; S.init(R, 4, gridDim.x, blockIdx.x);
            S.tile_e = (const LAS int*)(lds + LDS_TILE_E); S.estride = (size_t)D * D;
            pg8::EpiGatedF8 E{(unsigned char*)(P.ws + WS_MIX), DEXP};
            pg8::gemm_phase<pg8::EpiGatedF8, pg8::StaticOrder, true, true, true, true>(lds, g, S, E);
        } SEAM(pb + 7);
        if (PHE(8) && IN(pb + 8)) {
            const int R = build_tiles(P, l, lds, tid);
            pg8::Gemm g{(const bf16*)(P.ws + WS_MIX), (const bf16*)(wl + WO_DN), SROWS, D, DEXP / 2  }; pg8::StaticOrder S; S.init(R, 4, gridDim.x, blockIdx.x);
            S.tile_e = (const LAS int*)(lds + LDS_TILE_E); S.estride = (size_t)D * DEXP;
            pg8::EpiF8 E{(unsigned char*)(P.ws + WS_PROJ), D, 16.f};
            pg8::gemm_phase<pg8::EpiF8, pg8::StaticOrder, true, true, false, true>(lds, g, S, E);
        } SEAM(pb + 8);
        if (PHE(9) && IN(pb + 9)) { ph_combine(P, l, lane, wave); } SEAM(pb + 9);
    }
__global__ void __launch_bounds__(NTHR, 2) fwd_kernel(Params P) {
    extern __shared__ __attribute__((aligned(16))) unsigned char lds_raw[];
    LAS unsigned char* lds = (LAS unsigned char*)lds_raw;
    const int tid = threadIdx.x, lane = tid & 63, wave = __builtin_amdgcn_readfirstlane(tid >> 6);
    if (tid < 16) ((LAS unsigned*)(lds + LDSCTL_OFF))[tid] = 0u;
    __syncthreads();
#if MK_ONE_LAUNCH
    XcdBarrier bar = xcd_barrier_post((unsigned*)(P.ws + WS_CTL) + CW_BAR, (volatile LAS unsigned*)(lds + LDSCTL_OFF));
#else
    XcdBarrier bar; bar.bar = nullptr; bar.x = 0; bar.st = nullptr;
#endif
    const int lo = P.ph_lo, hi = P.ph_hi;
    if (PHE(10) && IN(0)) { ph_prologue(P, lds, tid, lane, wave); } SEAM(0);
    layer_phases<0>(P, lds, bar, tid, lane, wave, lo, hi);
    layer_phases<1>(P, lds, bar, tid, lane, wave, lo, hi);
}
#undef IN
#undef SEAM

extern "C" void kernel_launch(void* const* d_in, const int* in_sizes, int n_in, void* d_out, int out_size, void* d_ws, size_t ws_size, hipStream_t stream) {
    static int grid = 0;
    if (grid == 0) {
        if (n_in != 46 || out_size != NTOK * D || ws_size < WS_END) { fprintf(stderr, "kernel_launch: unexpected sizes n_in %d out %d ws %zu\n", n_in, out_size, ws_size); grid = -1; return; }
        int dev = 0, cus = 0;
        if (hipGetDevice(&dev) != hipSuccess || hipDeviceGetAttribute(&cus, hipDeviceAttributeMultiprocessorCount, dev) != hipSuccess) { grid = -1; return; }
        if (hipFuncSetAttribute((const void*)fwd_kernel, hipFuncAttributeMaxDynamicSharedMemorySize, LDS_BYTES) != hipSuccess) { grid = -1; return; }
        int per_cu = 0;
        if (hipOccupancyMaxActiveBlocksPerMultiprocessor(&per_cu, (const void*)fwd_kernel, NTHR, LDS_BYTES) != hipSuccess || per_cu < 1) { fprintf(stderr, "kernel_launch: occupancy query says %d\n", per_cu); }
        (void)hipGetLastError();
        (void)cus; grid = 256;
    }
    if (grid < 0) return;
    if (hipMemsetAsync((char*)d_ws + WS_CTL, 0, CTL_ZERO_BYTES, stream) != hipSuccess) return;
    Params p; memset(&p, 0, sizeof(p));
    for (int i = 0; i < 46; ++i) p.in[i] = (const float*)d_in[i];
    p.out = (float*)d_out; p.ws = (unsigned char*)d_ws;
#if MK_ONE_LAUNCH
    p.ph_lo = 0; p.ph_hi = N_PHASES;
    hipLaunchKernelGGL(fwd_kernel, dim3(grid), dim3(NTHR), LDS_BYTES, stream, p);
#else
    for (int k = 0; k < N_PHASES; ++k) { p.ph_lo = k; p.ph_hi = k + 1; hipLaunchKernelGGL(fwd_kernel, dim3(grid), dim3(NTHR), LDS_BYTES, stream, p); }
#endif
}
```

```cpp
#include <hip/hip_runtime.h>
#include <cstdio>
#include <cstdint>
#include <cstring>

#define LAS __attribute__((address_space(3)))
#define GAS __attribute__((address_space(1)))

namespace pg8 {
#define PG8_LAS __attribute__((address_space(3)))
typedef unsigned short bf16_t;
typedef short bf16x8 __attribute__((ext_vector_type(8)));
typedef float f32x4 __attribute__((ext_vector_type(4)));
typedef unsigned u32x4 __attribute__((ext_vector_type(4)));
typedef int v8i __attribute__((ext_vector_type(8)));
constexpr int BM = 256, BK = 64, HALF = 128, HTB = HALF * BK * 2  , STAGE_BYTES = 8 * HTB, NXCD = 8, WGM = 8;

__host__ __device__ __forceinline__ int lds_byte(int r, int c) { const int st = (r >> 4) * 2 + (c >> 5), rr = r & 15, cc = c & 31, ob = rr * 64 + cc * 2; return st * 1024 + (ob ^ (((ob >> 9) & 1) << 5)); }
__host__ __device__ __forceinline__ void stage_rc(int b, int& R, int& C) { const int st = b / 1024, sb = b % 1024, swz = sb ^ (((sb >> 9) & 1) << 5); R = (st >> 1) * 16 + swz / 64; C = (st & 1) * 32 + (swz % 64) / 2; }
__host__ __device__ __forceinline__ int perm32(int rho) { const int n = rho >> 4, i = rho & 15; return 8 * (i >> 2) + 4 * n + (i & 3); }

struct Unit { int pm, pn; };
struct Gemm { const bf16_t* A; const bf16_t* Bt; int M, N, K; const int* rowsrc; int nsrc; int lda; };

struct StaticOrder {
    int nM, nN, nwg, G, c; const PG8_LAS int* tile_e; size_t estride;
    __device__ void init(int nM_, int nN_, int G_, int c_) { nM = nM_; nN = nN_; nwg = nM * nN; G = G_; c = c_; tile_e = nullptr; estride = 0; }
    __device__ bool next(int i, Unit& u) const {
        const long L = (long)i * G + c; if (L >= nwg) return false;
        int wgid = (int)L; { const int q = nwg / NXCD, r = nwg % NXCD, xcd = wgid % NXCD, off = wgid / NXCD; wgid = (xcd < r ? xcd * (q + 1) : r * (q + 1) + (xcd - r) * q) + off; }
        const int nig = WGM * nN, gid = wgid / nig, fm = gid * WGM, gsz = (nM - fm) < WGM ? (nM - fm) : WGM;
        u.pm = fm + ((wgid % nig) % gsz); u.pn = (wgid % nig) / gsz; return true;
    }
    __device__ __forceinline__ size_t boff(const Unit& u, size_t tstep) const { return (size_t)u.pn * tstep + (tile_e ? (size_t)tile_e[u.pm] * estride : (size_t)0); }
    __device__ __forceinline__ void a_ready(const Unit&) const {}
    __device__ __forceinline__ void done(const Unit&) const {}
};

__device__ __forceinline__ unsigned cvt_pk_bf16(float lo, float hi) { unsigned r; asm volatile("v_cvt_pk_bf16_f32 %0, %1, %2" : "=v"(r) : "v"(lo), "v"(hi)); return r; }

__device__ __forceinline__ float sat8(float x) { return __builtin_amdgcn_fmed3f(x, -448.f, 448.f); }
struct EpiBf16 {
    static constexpr bool PERM = true, AFTER_DRAIN = false;
    bf16_t* O; int ldc;
    __device__ __forceinline__ void operator()(const f32x4 (&acc)[2][2][4][2], const Unit& u, int wr, int wc, int fr, int fq) const {
        const int row0 = u.pm * BM + wr * 64 + fr, col0 = u.pn * BM + wc * 32 + 8 * fq;
#pragma unroll
        for (int ai = 0; ai < 2; ++ai)
#pragma unroll
            for (int m = 0; m < 4; ++m) { bf16_t* rowp = O + (size_t)(row0 + ai * HALF + m * 16) * ldc + col0;
#pragma unroll
                for (int bj = 0; bj < 2; ++bj) { const f32x4 v0 = acc[ai][bj][m][0], v1 = acc[ai][bj][m][1];
                    u32x4 w; w.x = cvt_pk_bf16(v0[0], v0[1]); w.y = cvt_pk_bf16(v0[2], v0[3]); w.z = cvt_pk_bf16(v1[0], v1[1]); w.w = cvt_pk_bf16(v1[2], v1[3]);
                    *(u32x4*)(rowp + bj * HALF) = w; } }
    }
};
struct EpiLogits {
    static constexpr bool PERM = true, AFTER_DRAIN = false;
    float* O;
    __device__ __forceinline__ void operator()(const f32x4 (&acc)[2][2][4][2], const Unit& u, int wr, int wc, int fr, int fq) const {
        const int row0 = u.pm * BM + wr * 64 + fr, col0 = wc * 32 + 8 * fq;
        if (col0 < 72) {
#pragma unroll
            for (int ai = 0; ai < 2; ++ai)
#pragma unroll
                for (int m = 0; m < 4; ++m) { float* rowp = O + (size_t)(row0 + ai * HALF + m * 16) * 72 + col0; *(f32x4*)rowp = acc[ai][0][m][0]; *(f32x4*)(rowp + 4) = acc[ai][0][m][1]; }
        }
    }
};
template <int MODE> struct EpiGated {
    static constexpr bool PERM = true, AFTER_DRAIN = false;
    bf16_t* O; int ldc;
    __device__ __forceinline__ void operator()(const f32x4 (&acc)[2][2][4][2], const Unit& u, int wr, int wc, int fr, int fq) const {
        const int row0 = u.pm * BM + wr * 64 + fr, col0 = u.pn * HALF + wc * 32 + 8 * fq;
#pragma unroll
        for (int ai = 0; ai < 2; ++ai)
#pragma unroll
            for (int m = 0; m < 4; ++m) { bf16_t* rowp = O + (size_t)(row0 + ai * HALF + m * 16) * ldc + col0;
                float o[8];
#pragma unroll
                for (int n = 0; n < 2; ++n)
#pragma unroll
                    for (int j = 0; j < 4; ++j) { const float a = acc[ai][0][m][n][j], b = acc[ai][1][m][n][j];
                        o[n * 4 + j] = (MODE == 0) ? (a / (1.f + __expf(-a))) * b : a / (1.f + __expf(-b)); }
                u32x4 w; w.x = cvt_pk_bf16(o[0], o[1]); w.y = cvt_pk_bf16(o[2], o[3]); w.z = cvt_pk_bf16(o[4], o[5]); w.w = cvt_pk_bf16(o[6], o[7]);
                *(u32x4*)rowp = w; }
    }
};
template <bool RF32> struct EpiResB {
    static constexpr bool PERM = true, AFTER_DRAIN = false;
    bf16_t* C; const void* R; int ldc, ldr;
    __device__ __forceinline__ void operator()(const f32x4 (&acc)[2][2][4][2], const Unit& u, int wr, int wc, int fr, int fq) const {
        const int row0 = u.pm * BM + wr * 64 + fr, col0 = u.pn * BM + wc * 32 + 8 * fq;
#pragma unroll
        for (int ai = 0; ai < 2; ++ai)
#pragma unroll
            for (int m = 0; m < 4; ++m) { const size_t row = (size_t)(row0 + ai * HALF + m * 16);
#pragma unroll
                for (int bj = 0; bj < 2; ++bj) { float r[8];
                    if constexpr (RF32) { const f32x4 a = *(const f32x4*)((const float*)R + row * ldr + col0 + bj * HALF), b = *(const f32x4*)((const float*)R + row * ldr + col0 + bj * HALF + 4);
                        r[0] = a[0]; r[1] = a[1]; r[2] = a[2]; r[3] = a[3]; r[4] = b[0]; r[5] = b[1]; r[6] = b[2]; r[7] = b[3]; }
                    else { const u32x4 w = *(const u32x4*)((const bf16_t*)R + row * ldr + col0 + bj * HALF);
                        r[0] = __builtin_bit_cast(float, w.x << 16); r[1] = __builtin_bit_cast(float, w.x & 0xffff0000u); r[2] = __builtin_bit_cast(float, w.y << 16); r[3] = __builtin_bit_cast(float, w.y & 0xffff0000u);
                        r[4] = __builtin_bit_cast(float, w.z << 16); r[5] = __builtin_bit_cast(float, w.z & 0xffff0000u); r[6] = __builtin_bit_cast(float, w.w << 16); r[7] = __builtin_bit_cast(float, w.w & 0xffff0000u); }
                    const f32x4 v0 = acc[ai][bj][m][0], v1 = acc[ai][bj][m][1];
                    u32x4 o; o.x = cvt_pk_bf16(v0[0] + r[0], v0[1] + r[1]); o.y = cvt_pk_bf16(v0[2] + r[2], v0[3] + r[3]); o.z = cvt_pk_bf16(v1[0] + r[4], v1[1] + r[5]); o.w = cvt_pk_bf16(v1[2] + r[6], v1[3] + r[7]);
                    *(u32x4*)(C + row * ldc + col0 + bj * HALF) = o; } }
    }
};
struct EpiGatedF8 {
    static constexpr bool PERM = true, AFTER_DRAIN = false;
    unsigned char* O; int ldc;
    __device__ __forceinline__ void operator()(const f32x4 (&acc)[2][2][4][2], const Unit& u, int wr, int wc, int fr, int fq) const {
        const int row0 = u.pm * BM + wr * 64 + fr, col0 = u.pn * HALF + wc * 32 + 8 * fq;
#pragma unroll
        for (int ai = 0; ai < 2; ++ai)
#pragma unroll
            for (int m = 0; m < 4; ++m) { unsigned char* rowp = O + (size_t)(row0 + ai * HALF + m * 16) * ldc + col0;
                float o[8];
#pragma unroll
                for (int n = 0; n < 2; ++n)
#pragma unroll
                    for (int j = 0; j < 4; ++j) { const float a = acc[ai][0][m][n][j], b = acc[ai][1][m][n][j]; o[n * 4 + j] = sat8((a / (1.f + __expf(-a))) * b); }
                int w0 = 0, w1 = 0;
                w0 = __builtin_amdgcn_cvt_pk_fp8_f32(o[0], o[1], w0, false); w0 = __builtin_amdgcn_cvt_pk_fp8_f32(o[2], o[3], w0, true);
                w1 = __builtin_amdgcn_cvt_pk_fp8_f32(o[4], o[5], w1, false); w1 = __builtin_amdgcn_cvt_pk_fp8_f32(o[6], o[7], w1, true);
                unsigned long long pk = (unsigned long long)(unsigned)w0 | ((unsigned long long)(unsigned)w1 << 32); *(unsigned long long*)rowp = pk; }
    }
};
struct EpiF8 {
    static constexpr bool PERM = true, AFTER_DRAIN = false;
    unsigned char* O; int ldc; float sc;
    __device__ __forceinline__ void operator()(const f32x4 (&acc)[2][2][4][2], const Unit& u, int wr, int wc, int fr, int fq) const {
        const int row0 = u.pm * BM + wr * 64 + fr, col0 = u.pn * BM + wc * 32 + 8 * fq;
#pragma unroll
        for (int ai = 0; ai < 2; ++ai)
#pragma unroll
            for (int m = 0; m < 4; ++m) { unsigned char* rowp = O + (size_t)(row0 + ai * HALF + m * 16) * ldc + col0;
#pragma unroll
                for (int bj = 0; bj < 2; ++bj) { const f32x4 v0 = acc[ai][bj][m][0] * sc, v1 = acc[ai][bj][m][1] * sc; int w0 = 0, w1 = 0;
                    w0 = __builtin_amdgcn_cvt_pk_fp8_f32(sat8(v0[0]), sat8(v0[1]), w0, false); w0 = __builtin_amdgcn_cvt_pk_fp8_f32(sat8(v0[2]), sat8(v0[3]), w0, true);
                    w1 = __builtin_amdgcn_cvt_pk_fp8_f32(sat8(v1[0]), sat8(v1[1]), w1, false); w1 = __builtin_amdgcn_cvt_pk_fp8_f32(sat8(v1[2]), sat8(v1[3]), w1, true);
                    *(unsigned long long*)(rowp + bj * HALF) = (unsigned long long)(unsigned)w0 | ((unsigned long long)(unsigned)w1 << 32); } }
    }
};
struct EpiResF32 {
    static constexpr bool PERM = false, AFTER_DRAIN = false;
    float* C; const float* R; int ldc;
    __device__ __forceinline__ void operator()(const f32x4 (&acc)[2][2][4][2], const Unit& u, int wr, int wc, int fr, int fq) const {
        const int row0 = u.pm * BM + wr * 64 + fr, col0 = u.pn * BM + wc * 32 + 4 * fq;
#pragma unroll
        for (int ai = 0; ai < 2; ++ai)
#pragma unroll
            for (int m = 0; m < 4; ++m) { const size_t ro = (size_t)(row0 + ai * HALF + m * 16) * ldc + col0;
#pragma unroll
                for (int bj = 0; bj < 2; ++bj)
#pragma unroll
                    for (int n = 0; n < 2; ++n) { const f32x4 r = *(const f32x4*)(R + ro + bj * HALF + n * 16); *(f32x4*)(C + ro + bj * HALF + n * 16) = acc[ai][bj][m][n] + r; } }
    }
};


template <class Epi, class Sched, bool ALIGN_EPI = false, bool SP2 = false, bool GATH = false, bool F8 = false>
__device__ __forceinline__ void gemm_phase(PG8_LAS unsigned char* lds, const Gemm g, const Sched& S, const Epi& E) {
    static_assert(!GATH || SP2, "the gathered-A variant exists for the SP2 loop only");
    const int tid = threadIdx.x, wid = __builtin_amdgcn_readfirstlane(tid >> 6), lane = tid & 63, wr = wid >> 2, wc = wid & 3, fr = lane & 15, fq = lane >> 4;
    const int K = g.K, nt = K / BK, ldA = g.lda ? g.lda : K;
    unsigned voffA[2], voffB[2];
#pragma unroll
    for (int i = 0; i < 2; ++i) { int R, C; stage_rc(tid * 16 + i * 8192, R, C); const int Rb = Epi::PERM ? ((R & ~31) + perm32(R & 31)) : R;
        voffA[i] = (unsigned)(R * ldA + C) * 2u; voffB[i] = (unsigned)(Rb * K + C) * 2u; }
    const size_t kstep = (size_t)(BK * 2);
    const size_t hstep = (size_t)HALF * K * 2;
    const size_t tstep = 2 * hstep;
    const size_t hstepA = (size_t)HALF * ldA * 2, tstepA = 2 * hstepA;
    const unsigned ldsw = (unsigned)wid * 1024u;
    const int aoff = lds_byte(wr * 64 + fr, fq * 8), boff = lds_byte(wc * 32 + fr, fq * 8);
#define PG8_SA(b, h) (((b) * 2 + (h)) * HTB)
#define PG8_SB(b, h) ((4 + (b) * 2 + (h)) * HTB)
#define PG8_STAGE(bufoff, gbase, voff) do { _Pragma("unroll") for (int _i = 0; _i < 2; ++_i) \
        __builtin_amdgcn_global_load_lds((const unsigned*)((const char*)(gbase) + (voff)[_i]), (PG8_LAS unsigned*)(lds + (bufoff) + ldsw + _i * 8192), 16, 0, 0); } while (0)
#define PG8_STAGE_G(bufoff, gbase, v0, v1) do { \
        __builtin_amdgcn_global_load_lds((const unsigned*)((const char*)(gbase) + (v0)), (PG8_LAS unsigned*)(lds + (bufoff) + ldsw), 16, 0, 0); \
        __builtin_amdgcn_global_load_lds((const unsigned*)((const char*)(gbase) + (v1)), (PG8_LAS unsigned*)(lds + (bufoff) + ldsw + 8192), 16, 0, 0); } while (0)
#define PG8_LDA(dst, b, h) do { if constexpr (F8) { _Pragma("unroll") for (int m = 0; m < 4; ++m) { const u32x4 lo_ = *(const PG8_LAS u32x4*)(lds + PG8_SA(b, h) + aoff + m * 2048), hi_ = *(const PG8_LAS u32x4*)(lds + PG8_SA(b, h) + aoff + 1024 + m * 2048); \
            dst##8[m] = (v8i){(int)lo_.x, (int)lo_.y, (int)lo_.z, (int)lo_.w, (int)hi_.x, (int)hi_.y, (int)hi_.z, (int)hi_.w}; } } \
        else { _Pragma("unroll") for (int m = 0; m < 4; ++m) _Pragma("unroll") for (int k = 0; k < 2; ++k) dst[m][k] = *(const PG8_LAS bf16x8*)(lds + PG8_SA(b, h) + aoff + m * 2048 + k * 1024); } } while (0)
#define PG8_LDB(dst, b, h) do { if constexpr (F8) { _Pragma("unroll") for (int n = 0; n < 2; ++n) { const u32x4 lo_ = *(const PG8_LAS u32x4*)(lds + PG8_SB(b, h) + boff + n * 2048), hi_ = *(const PG8_LAS u32x4*)(lds + PG8_SB(b, h) + boff + 1024 + n * 2048); \
            dst##8[n] = (v8i){(int)lo_.x, (int)lo_.y, (int)lo_.z, (int)lo_.w, (int)hi_.x, (int)hi_.y, (int)hi_.z, (int)hi_.w}; } } \
        else { _Pragma("unroll") for (int n = 0; n < 2; ++n) _Pragma("unroll") for (int k = 0; k < 2; ++k) dst[n][k] = *(const PG8_LAS bf16x8*)(lds + PG8_SB(b, h) + boff + n * 2048 + k * 1024); } } while (0)
#define PG8_MMA(ai, bj, At, Bt) do { __builtin_amdgcn_s_setprio(1); \
        if constexpr (F8) { _Pragma("unroll") for (int m = 0; m < 4; ++m) _Pragma("unroll") for (int n = 0; n < 2; ++n) \
            asm volatile("v_mfma_scale_f32_16x16x128_f8f6f4 %0, %1, %2, %0, %3, %4 op_sel_hi:[0,0,0]" : "+v"(acc[ai][bj][m][n]) : "v"(Bt##8[n]), "v"(At##8[m]), "v"(sc8_), "v"(sc8_)); } \
        else { _Pragma("unroll") for (int m = 0; m < 4; ++m) _Pragma("unroll") for (int n = 0; n < 2; ++n) _Pragma("unroll") for (int k = 0; k < 2; ++k) \
            acc[ai][bj][m][n] = __builtin_amdgcn_mfma_f32_16x16x32_bf16(Bt[n][k], At[m][k], acc[ai][bj][m][n], 0, 0, 0); } \
        __builtin_amdgcn_s_setprio(0); } while (0)
#define PG8_WAIT_V(n) asm volatile("s_waitcnt vmcnt(" #n ")" ::: "memory")
#define PG8_WAIT_L(n) asm volatile("s_waitcnt lgkmcnt(" #n ")" ::: "memory")
#define PG8_BAR __builtin_amdgcn_s_barrier()
#define PG8_SCHED __builtin_amdgcn_sched_barrier(0)
#define PG8_SCHED8 do { if constexpr (F8) __builtin_amdgcn_sched_barrier(0); } while (0)
    Unit cur, nxt; int ui = 0;
    if (!S.next(0, cur)) return;
    unsigned gc[2][2] = {{0u, 0u}, {0u, 0u}}, gn[2][2] = {{0u, 0u}, {0u, 0u}};
    int gR[2] = {0, 0}, gC[2] = {0, 0};
    if constexpr (GATH) {
#pragma unroll
        for (int i = 0; i < 2; ++i) stage_rc(tid * 16 + i * 8192, gR[i], gC[i]);
#pragma unroll
        for (int h = 0; h < 2; ++h)
#pragma unroll
            for (int i = 0; i < 2; ++i) { unsigned src = (unsigned)g.rowsrc[cur.pm * BM + h * HALF + gR[i]]; src = src < (unsigned)g.nsrc ? src : (unsigned)(g.nsrc - 1); gc[h][i] = (src * (unsigned)K + (unsigned)gC[i]) * 2u; }
    }
    f32x4 acc[2][2][4][2];
#pragma unroll
    for (int a = 0; a < 2; ++a)
#pragma unroll
        for (int b = 0; b < 2; ++b)
#pragma unroll
            for (int m = 0; m < 4; ++m)
#pragma unroll
                for (int n = 0; n < 2; ++n) acc[a][b][m][n] = (f32x4){0.f, 0.f, 0.f, 0.f};
    const int sc8_ = 0x7c7c7c7c;
    bf16x8 At[4][2], B0[2][2], B1[2][2]; v8i At8[4], B08[2], B18[2];
    const char* cA = GATH ? (const char*)g.A : (const char*)g.A + (size_t)cur.pm * tstepA; const char* cB = (const char*)g.Bt + S.boff(cur, tstep);
    S.a_ready(cur);
    if constexpr (SP2) {
        PG8_STAGE(PG8_SB(0, 0), cB, voffB); PG8_STAGE(PG8_SB(0, 1), cB + hstep, voffB);
        if constexpr (GATH) { PG8_STAGE_G(PG8_SA(0, 0), cA, gc[0][0], gc[0][1]); PG8_STAGE_G(PG8_SA(0, 1), cA, gc[1][0], gc[1][1]); } else { PG8_STAGE(PG8_SA(0, 0), cA, voffA); PG8_STAGE(PG8_SA(0, 1), cA + hstepA, voffA); }
        if (wr == 1) PG8_BAR;
        PG8_WAIT_V(2); PG8_BAR;
        PG8_STAGE(PG8_SB(1, 0), cB + kstep, voffB); if constexpr (GATH) PG8_STAGE_G(PG8_SA(1, 0), cA + kstep, gc[0][0], gc[0][1]); else PG8_STAGE(PG8_SA(1, 0), cA + kstep, voffA); PG8_STAGE(PG8_SB(1, 1), cB + hstep + kstep, voffB);
        PG8_WAIT_V(6); PG8_BAR;
    } else {
        PG8_STAGE(PG8_SB(0, 0), cB, voffB); PG8_STAGE(PG8_SA(0, 0), cA, voffA); PG8_STAGE(PG8_SB(0, 1), cB + hstep, voffB); PG8_STAGE(PG8_SA(0, 1), cA + hstepA, voffA);
        if (wr == 1) PG8_BAR;
        PG8_WAIT_V(4); PG8_BAR;
        PG8_STAGE(PG8_SB(1, 0), cB + kstep, voffB); PG8_STAGE(PG8_SA(1, 0), cA + kstep, voffA); PG8_STAGE(PG8_SB(1, 1), cB + hstep + kstep, voffB);
        PG8_WAIT_V(6); PG8_BAR;
    }
    for (;;) {
        const bool has_next = S.next(ui + 1, nxt);
        const char* nA = GATH ? cA : (has_next ? (const char*)g.A + (size_t)nxt.pm * tstepA : cA); const char* nB = has_next ? (const char*)g.Bt + S.boff(nxt, tstep) : cB;
        if constexpr (GATH) {
#pragma unroll
            for (int h = 0; h < 2; ++h)
#pragma unroll
                for (int i = 0; i < 2; ++i) { gn[h][i] = gc[h][i];
                    if (has_next) { unsigned src = (unsigned)g.rowsrc[nxt.pm * BM + h * HALF + gR[i]]; src = src < (unsigned)g.nsrc ? src : (unsigned)(g.nsrc - 1); gn[h][i] = (src * (unsigned)K + (unsigned)gC[i]) * 2u; } }
        }
#pragma nounroll
        for (int t = 0; t < nt; t += 2) {
            const bool last = (t == nt - 2);
            const char* a1 = cA + (size_t)(t + 1) * kstep;
            const char* a2 = last ? nA : cA + (size_t)(t + 2) * kstep; const char* b2 = last ? nB : cB + (size_t)(t + 2) * kstep;
            const char* a3 = a2 + kstep; const char* b3 = b2 + kstep;
            if (last && has_next) S.a_ready(nxt);
            if constexpr (SP2) {
            PG8_LDB(B0, 0, 0); PG8_LDB(B1, 0, 1); PG8_SCHED; PG8_LDA(At, 0, 0); if constexpr (GATH) PG8_STAGE_G(PG8_SA(1, 1), a1, gc[1][0], gc[1][1]); else PG8_STAGE(PG8_SA(1, 1), a1 + hstepA, voffA);
            PG8_WAIT_V(8); PG8_WAIT_L(0); PG8_BAR; PG8_SCHED8; PG8_MMA(0, 0, At, B0); PG8_MMA(0, 1, At, B1); PG8_SCHED8; PG8_BAR; PG8_SCHED;
            PG8_LDA(At, 0, 1); PG8_STAGE(PG8_SB(0, 0), b2, voffB); PG8_STAGE(PG8_SB(0, 1), b2 + hstep, voffB); if constexpr (GATH) PG8_STAGE_G(PG8_SA(0, 0), a2, last ? gn[0][0] : gc[0][0], last ? gn[0][1] : gc[0][1]); else PG8_STAGE(PG8_SA(0, 0), a2, voffA);
            PG8_WAIT_V(8); PG8_WAIT_L(0); PG8_BAR; PG8_SCHED8; PG8_MMA(1, 0, At, B0); PG8_MMA(1, 1, At, B1); PG8_SCHED8; PG8_BAR; PG8_SCHED;
            PG8_LDB(B0, 1, 0); PG8_LDB(B1, 1, 1); PG8_SCHED; PG8_LDA(At, 1, 0); if constexpr (GATH) PG8_STAGE_G(PG8_SA(0, 1), a2, last ? gn[1][0] : gc[1][0], last ? gn[1][1] : gc[1][1]); else PG8_STAGE(PG8_SA(0, 1), a2 + hstepA, voffA);
            PG8_WAIT_V(8); PG8_WAIT_L(0); PG8_BAR; PG8_SCHED8; PG8_MMA(0, 0, At, B0); PG8_MMA(0, 1, At, B1); PG8_SCHED8; PG8_BAR; PG8_SCHED;
            PG8_LDA(At, 1, 1); PG8_STAGE(PG8_SB(1, 0), b3, voffB); PG8_STAGE(PG8_SB(1, 1), b3 + hstep, voffB); if constexpr (GATH) PG8_STAGE_G(PG8_SA(1, 0), a3, last ? gn[0][0] : gc[0][0], last ? gn[0][1] : gc[0][1]); else PG8_STAGE(PG8_SA(1, 0), a3, voffA);
            PG8_WAIT_V(8); PG8_WAIT_L(0); PG8_BAR; PG8_SCHED8; PG8_MMA(1, 0, At, B0); PG8_MMA(1, 1, At, B1); PG8_SCHED8; PG8_BAR; PG8_SCHED;
            } else {
            PG8_LDB(B0, 0, 0); PG8_SCHED; PG8_LDA(At, 0, 0); PG8_STAGE(PG8_SA(1, 1), a1 + hstepA, voffA);
            PG8_WAIT_L(8); PG8_BAR; PG8_WAIT_L(0); PG8_MMA(0, 0, At, B0); PG8_BAR; PG8_SCHED;
            PG8_LDB(B1, 0, 1); PG8_STAGE(PG8_SB(0, 0), b2, voffB);
            PG8_BAR; PG8_WAIT_L(0); PG8_MMA(0, 1, At, B1); PG8_BAR;
            PG8_LDA(At, 0, 1); PG8_STAGE(PG8_SA(0, 0), a2, voffA);
            PG8_BAR; PG8_WAIT_L(0); PG8_MMA(1, 0, At, B0); PG8_BAR; PG8_SCHED;
            PG8_STAGE(PG8_SB(0, 1), b2 + hstep, voffB);
            PG8_WAIT_V(6); PG8_BAR; PG8_MMA(1, 1, At, B1); PG8_BAR;
            PG8_LDB(B0, 1, 0); PG8_SCHED; PG8_LDA(At, 1, 0); PG8_STAGE(PG8_SA(0, 1), a2 + hstepA, voffA);
            PG8_WAIT_L(8); PG8_BAR; PG8_WAIT_L(0); PG8_MMA(0, 0, At, B0); PG8_BAR; PG8_SCHED;
            PG8_LDB(B1, 1, 1); PG8_STAGE(PG8_SB(1, 0), b3, voffB);
            PG8_BAR; PG8_WAIT_L(0); PG8_MMA(0, 1, At, B1); PG8_BAR;
            PG8_LDA(At, 1, 1); PG8_STAGE(PG8_SA(1, 0), a3, voffA);
            PG8_BAR; PG8_WAIT_L(0); PG8_MMA(1, 0, At, B0); PG8_BAR; PG8_SCHED;
            PG8_STAGE(PG8_SB(1, 1), b3 + hstep, voffB);
            PG8_WAIT_V(6); PG8_BAR; PG8_MMA(1, 1, At, B1); PG8_BAR;
            }
        }
        if constexpr (F8) asm volatile("s_nop 15\n\ts_nop 15" ::: "memory");
        if constexpr (ALIGN_EPI) { if (wr == 0) PG8_BAR; }
        if constexpr (!Epi::AFTER_DRAIN) { E(acc, cur, wr, wc, fr, fq); S.done(cur); }
        if (!has_next) break;
#pragma unroll
        for (int a = 0; a < 2; ++a)
#pragma unroll
            for (int b = 0; b < 2; ++b)
#pragma unroll
                for (int m = 0; m < 4; ++m)
#pragma unroll
                    for (int n = 0; n < 2; ++n) acc[a][b][m][n] = (f32x4){0.f, 0.f, 0.f, 0.f};
        cur = nxt; cA = nA; cB = nB; ++ui;
        if constexpr (GATH) {
#pragma unroll
            for (int h = 0; h < 2; ++h)
#pragma unroll
                for (int i = 0; i < 2; ++i) gc[h][i] = gn[h][i]; }
        if constexpr (ALIGN_EPI) { if (wr == 1) PG8_BAR; }
    }
    PG8_WAIT_V(0);
    if constexpr (!ALIGN_EPI) { if (wr == 0) PG8_BAR; }
    PG8_BAR;
    if constexpr (Epi::AFTER_DRAIN) { E.fused(acc, cur, wr, wc, fr, fq, lds, wid, lane); S.done(cur); }
#undef PG8_SA
#undef PG8_SB
#undef PG8_STAGE
#undef PG8_STAGE_G
#undef PG8_LDA
#undef PG8_LDB
#undef PG8_MMA
#undef PG8_WAIT_V
#undef PG8_WAIT_L
#undef PG8_BAR
#undef PG8_SCHED
#undef PG8_SCHED8
}
}


constexpr int NB = 8, T = 8192, D = 1024, NTOK = NB * T, DIN = 2816, NL = 2, GW = 256;
constexpr int NWAVES = 8, NTHR = 512;
constexpr int HP = 2048;
constexpr int NEXP = 32, DEXP = 512;
constexpr int MAXTILES = (2 * NTOK) / 256 + NEXP;
constexpr int SROWS = MAXTILES * 256;
constexpr int C_HQ = 0, C_HF = 256, C_HI = 512, C_HG = 768, C_SU = 1024, C_RW = 1280, C_LG = 2304, C_LX = 2560;

constexpr size_t MiB = 1u << 20;
constexpr size_t WS_CTL = 0, CTL_ZERO_BYTES = 1 * MiB;
constexpr size_t WL_STRIDE = 105 * MiB;
constexpr size_t WO_IN = 0, WO_OUT = 6 * MiB, WO_GLU = 8 * MiB, WO_GU = 9 * MiB, WO_DN = 73 * MiB, WO_RT = 8 * MiB + 512 * 1024;
constexpr size_t WS_W = 1 * MiB;
constexpr size_t S5_STRIDE = 9 * MiB;
constexpr size_t S5O_F3 = 0, S5O_F1 = 4 * MiB, S5O_A16 = 8 * MiB;
constexpr size_t WS_S5 = 211 * MiB;
constexpr size_t WS_ACT = 229 * MiB;
constexpr size_t WS_PROJ = 357 * MiB;
constexpr size_t WS_MIX = 709 * MiB;
constexpr size_t WS_YG = WS_MIX + 128 * MiB;
constexpr size_t WS_VF = 869 * MiB;
constexpr size_t WS_HU = 901 * MiB;
constexpr size_t WS_XS = 933 * MiB;
constexpr size_t WS_ROUTE = 965 * MiB;
constexpr size_t WS_TCNT = 967 * MiB;
constexpr size_t WS_LG = 968 * MiB;
constexpr size_t WS_END = 986 * MiB;
static_assert(WS_PROJ + (size_t)NTOK * DIN * 2 <= WS_MIX && WS_PROJ + (size_t)SROWS * D * 2 <= WS_MIX, "proj region");
static_assert(WS_MIX + (size_t)SROWS * DEXP * 2 <= WS_VF, "mix region");
constexpr int CW_BAR = 4096;
constexpr int CW_CNT = 8192;
constexpr int CW_CUR = 8192 + 256;

constexpr int RING_BYTES = 131072;
constexpr int LDSCTL_OFF = RING_BYTES;
constexpr int LDS_TILE_E = LDSCTL_OFF + 64;
constexpr int LDS_MISC = LDS_TILE_E + MAXTILES * 4;
constexpr int LDS_BYTES = 147456;
static_assert(LDS_MISC + 1024 <= LDS_BYTES, "LDS map");

typedef unsigned short bf16;
typedef float f32x4 __attribute__((ext_vector_type(4)));
typedef float f32x2 __attribute__((ext_vector_type(2)));
typedef unsigned u32x4 __attribute__((ext_vector_type(4)));
typedef unsigned u32x2 __attribute__((ext_vector_type(2)));
typedef short bf16x8 __attribute__((ext_vector_type(8)));

typedef __bf16 hwbf2 __attribute__((ext_vector_type(2)));
__device__ __forceinline__ unsigned cvt2(float lo, float hi) { const f32x2 v = {lo, hi}; return __builtin_bit_cast(unsigned, __builtin_convertvector(v, hwbf2)); }
__device__ __forceinline__ unsigned pk2(float lo, float hi) { return cvt2(lo, hi); }
__device__ __forceinline__ unsigned f2bf(float f) { return cvt2(f, 0.f) & 0xffffu; }
__device__ __forceinline__ float bf2f(unsigned b) { return __builtin_bit_cast(float, b << 16); }
__device__ __forceinline__ float bflo(unsigned w) { return __builtin_bit_cast(float, w << 16); }
__device__ __forceinline__ float bfhi(unsigned w) { return __builtin_bit_cast(float, w & 0xffff0000u); }
__device__ __forceinline__ void unpack8(const u32x4 w, float (&o)[8]) { o[0] = bflo(w.x); o[1] = bfhi(w.x); o[2] = bflo(w.y); o[3] = bfhi(w.y); o[4] = bflo(w.z); o[5] = bfhi(w.z); o[6] = bflo(w.w); o[7] = bfhi(w.w); }
__device__ __forceinline__ float frcp(float x) { return __builtin_amdgcn_rcpf(x); }
__device__ __forceinline__ float sigmoidf_(float x) { return frcp(1.f + __expf(-x)); }
__device__ __forceinline__ float siluf_(float x) { return x * frcp(1.f + __expf(-x)); }
__device__ __forceinline__ float softplusf_(float x) { return x > 15.f ? x : __logf(1.f + __expf(x)); }
__device__ __forceinline__ float gelu_tanh(float x) { const float u = 0.7978845608028654f * (x + 0.044715f * x * x * x); return x * frcp(1.f + __expf(-2.f * u)); }
#define DPPF(v, ctrl) __builtin_bit_cast(float, __builtin_amdgcn_update_dpp(0, __builtin_bit_cast(int, (v)), (ctrl), 0xf, 0xf, true))
__device__ __forceinline__ float row16_sum(float v) {
    v += DPPF(v, 0xB1);
    v += DPPF(v, 0x4E);
    v += DPPF(v, 0x141);
    v += DPPF(v, 0x140);
    return v;
}
__device__ __forceinline__ float wave_sum(float v) {
    v = row16_sum(v);
    return (__builtin_bit_cast(float, __builtin_amdgcn_readlane(__builtin_bit_cast(int, v), 0)) + __builtin_bit_cast(float, __builtin_amdgcn_readlane(__builtin_bit_cast(int, v), 16)))
         + (__builtin_bit_cast(float, __builtin_amdgcn_readlane(__builtin_bit_cast(int, v), 32)) + __builtin_bit_cast(float, __builtin_amdgcn_readlane(__builtin_bit_cast(int, v), 48)));
}
__device__ __forceinline__ float half_sum(float v, int lane) {
    v = row16_sum(v);
    const float a = __builtin_bit_cast(float, __builtin_amdgcn_readlane(__builtin_bit_cast(int, v), 0)) + __builtin_bit_cast(float, __builtin_amdgcn_readlane(__builtin_bit_cast(int, v), 16));
    const float b = __builtin_bit_cast(float, __builtin_amdgcn_readlane(__builtin_bit_cast(int, v), 32)) + __builtin_bit_cast(float, __builtin_amdgcn_readlane(__builtin_bit_cast(int, v), 48));
    return (lane & 32) ? b : a;
}
#define PIN1(a) asm volatile("" : "+v"(a))
#define PIN2(v) asm volatile("" : "+v"((v).x), "+v"((v).y))
#define PIN4(v) asm volatile("" : "+v"((v).x), "+v"((v).y), "+v"((v).z), "+v"((v).w))
#define LDS_WAIT() asm volatile("s_waitcnt lgkmcnt(0)" ::: "memory")
#define LDS_BARRIER() do { asm volatile("s_waitcnt lgkmcnt(0)" ::: "memory"); __builtin_amdgcn_s_barrier(); asm volatile("" ::: "memory"); } while (0)


#define XB_TMO      128
#define XB_XCNT(j)  (256  + 64 * (j))
#define XB_XSUB(j)  (1280 + 64 * (j))
#define XB_XGEN(j)  (2304 + 64 * (j))
#define XB_TOP      3328
#define XB_TOPGEN   3392
#define XCD_BAR_WORDS 3456
#define XB_SPIN_CAP (1u << 18)

__device__ __forceinline__ unsigned xb_ld(unsigned* p)              { return __hip_atomic_load(p, __ATOMIC_RELAXED, __HIP_MEMORY_SCOPE_AGENT); }
__device__ __forceinline__ unsigned xb_add(unsigned* p, unsigned v) { return __hip_atomic_fetch_add(p, v, __ATOMIC_RELAXED, __HIP_MEMORY_SCOPE_AGENT); }
__device__ __forceinline__ unsigned xb_xcc_id() { return (unsigned)__builtin_amdgcn_s_getreg((3 << 11) | 20) & 0xFu; }
#define XB_SPIN(cond, bar) do { unsigned _sp = 0; while (cond) { __builtin_amdgcn_s_sleep(1); \
    if ((++_sp & 255u) == 0u) { if (xb_ld(&(bar)[XB_TMO])) break; if (_sp > XB_SPIN_CAP) { atomicAdd(&(bar)[XB_TMO], 1u); break; } } } } while (0)

struct XcdBarrier {
    unsigned* bar; unsigned x;
    volatile LAS unsigned* st;
};

__device__ __forceinline__ XcdBarrier xcd_barrier_post(unsigned* bar, volatile LAS unsigned* st) {
    XcdBarrier b; b.bar = bar; b.x = xb_xcc_id(); b.st = st;
    if (threadIdx.x == 0) (void)xb_add(&bar[XB_XCNT(b.x)], 1u);
    return b;
}
__device__ __forceinline__ void xcd_barrier_complete(unsigned* bar, unsigned x, unsigned& nloc, unsigned& nx) {
    const unsigned G = gridDim.x * gridDim.y * gridDim.z;
    unsigned sum, cnt, mine, sp = 0u;
    for (;;) {
        sum = 0u; cnt = 0u; mine = 0u;
#pragma unroll
        for (unsigned j = 0; j < 16; ++j) { const unsigned c = xb_ld(&bar[XB_XCNT(j)]); sum += c; cnt += (c > 0u) ? 1u : 0u; mine = (j == x) ? c : mine; }
        if (sum == G) break;
        __builtin_amdgcn_s_sleep(1);
        if ((++sp & 255u) == 0u) { if (xb_ld(&bar[XB_TMO])) break; if (sp > XB_SPIN_CAP) { atomicAdd(&bar[XB_TMO], 1u); break; } }
    }
    nloc = mine > 0u ? mine : 1u; nx = cnt > 0u ? cnt : 1u;
}

__device__ __forceinline__ void xcd_barrier(const XcdBarrier& b) {
    asm volatile("s_waitcnt vmcnt(0)" ::: "memory");
    __syncthreads();
    if (threadIdx.x == 0) {
        unsigned* bar = b.bar;
        __builtin_amdgcn_s_waitcnt(0);
        unsigned nloc = b.st[0], nx = b.st[1];
        if (nloc == 0u) { xcd_barrier_complete(bar, b.x, nloc, nx); b.st[0] = nloc; b.st[1] = nx; }
        const unsigned old = xb_add(&bar[XB_XSUB(b.x)], 1u);
        const unsigned gen = old / nloc;
        if (old + 1u == (gen + 1u) * nloc) {
            __builtin_amdgcn_fence(__ATOMIC_RELEASE, "agent");
            asm volatile("s_waitcnt vmcnt(0)" ::: "memory");
            const unsigned og = xb_add(&bar[XB_TOP], 1u);
            const unsigned tg = og / nx;
            if (og + 1u == (tg + 1u) * nx) xb_add(&bar[XB_TOPGEN], 1u);
            else XB_SPIN(xb_ld(&bar[XB_TOPGEN]) == tg, bar);
            __builtin_amdgcn_fence(__ATOMIC_ACQUIRE, "agent");
            xb_add(&bar[XB_XGEN(b.x)], 1u);
            asm volatile("s_waitcnt vmcnt(0)" ::: "memory");
        } else {
            XB_SPIN(xb_ld(&bar[XB_XGEN(b.x)]) == gen, bar);
            __builtin_amdgcn_fence(__ATOMIC_ACQUIRE, "agent");
            asm volatile("s_waitcnt vmcnt(0)" ::: "memory");
        }
    }
    __syncthreads();
}


struct Params { const float* in[46]; float* out; unsigned char* ws; int ph_lo, ph_hi; };
enum { I_X = 0, I_NORM1, I_WIN, I_HLB, I_HNW, I_S5LR, I_S5LI, I_S5DT, I_S5BR, I_S5BI, I_S5CR, I_S5CI, I_S5D, I_S5GLU, I_RMU, I_RW0, I_RW2, I_RA0, I_RA2, I_RG2,
       I_RKK, I_RKA, I_RRK, I_RV0, I_RV1, I_RV2, I_RLNW, I_RLNB, I_LCW, I_LCB, I_LWA, I_LBA, I_LWX, I_LBX, I_LLAM, I_MGAIN, I_WOUT, I_NORM2, I_MCW, I_MCB, I_MFW, I_MFB,
       I_MWG, I_MWU, I_MWD, I_FNW };

__device__ __forceinline__ void transpose_item(const float* W, int ldw, int k0, int n0, bf16* dst, int K, LAS float* scr, int lane) {
#pragma unroll 8
    for (int i = 0; i < 32; ++i) { const int kk = 2 * i + (lane >> 5); scr[kk * 33 + (lane & 31)] = W[(size_t)(k0 + kk) * ldw + n0 + (lane & 31)]; }
    LDS_WAIT(); asm volatile("" ::: "memory");
    const int c = lane & 7;
#pragma unroll
    for (int j = 0; j < 4; ++j) { const int n = (lane >> 3) + 8 * j; const LAS float* s = scr + (8 * c) * 33 + n;
        u32x4 o; o.x = pk2(s[0 * 33], s[1 * 33]); o.y = pk2(s[2 * 33], s[3 * 33]); o.z = pk2(s[4 * 33], s[5 * 33]); o.w = pk2(s[6 * 33], s[7 * 33]);
        *(u32x4*)(dst + (size_t)n * K + k0 + 8 * c) = o; }
    LDS_WAIT(); asm volatile("" ::: "memory");
}
__device__ __forceinline__ void transpose_item_f8(const float* W, int ldw, int k0, int n0, unsigned char* dst, int Kb, float sc, LAS float* scr, int lane) {
#pragma unroll 8
    for (int i = 0; i < 32; ++i) { const int kk = 2 * i + (lane >> 5); scr[kk * 33 + (lane & 31)] = W[(size_t)(k0 + kk) * ldw + n0 + (lane & 31)]; }
    LDS_WAIT(); asm volatile("" ::: "memory");
    const int c = lane & 7;
#pragma unroll
    for (int j = 0; j < 4; ++j) { const int n = (lane >> 3) + 8 * j; const LAS float* p = scr + (8 * c) * 33 + n; int w0 = 0, w1 = 0;
        w0 = __builtin_amdgcn_cvt_pk_fp8_f32(p[0 * 33] * sc, p[1 * 33] * sc, w0, false); w0 = __builtin_amdgcn_cvt_pk_fp8_f32(p[2 * 33] * sc, p[3 * 33] * sc, w0, true);
        w1 = __builtin_amdgcn_cvt_pk_fp8_f32(p[4 * 33] * sc, p[5 * 33] * sc, w1, false); w1 = __builtin_amdgcn_cvt_pk_fp8_f32(p[6 * 33] * sc, p[7 * 33] * sc, w1, true);
        *(unsigned long long*)(dst + (size_t)n * Kb + k0 + 8 * c) = (unsigned long long)(unsigned)w0 | ((unsigned long long)(unsigned)w1 << 32); }
    LDS_WAIT(); asm volatile("" ::: "memory");
}
constexpr int IT_IN = 16 * 88, IT_OUT = 16 * 32, IT_GLU = 4 * 16, IT_EXP = 32 * 256, IT_LAYER = IT_IN + IT_OUT + IT_GLU + 3 * IT_EXP;
__device__ __forceinline__ void prologue_item(const Params& P, int it, LAS float* scr, int lane) {
    const int l = it / IT_LAYER; int r = it % IT_LAYER;
    bf16* wl = (bf16*)(P.ws + WS_W + (size_t)l * WL_STRIDE);
    if (r < IT_IN) { const int kb = r / 88, nb = r % 88; transpose_item(P.in[I_WIN] + (size_t)l * D * DIN, DIN, 64 * kb, 32 * nb, (bf16*)((unsigned char*)wl + WO_IN) + (size_t)(32 * nb) * D, D, scr, lane); return; } r -= IT_IN;
    if (r < IT_OUT) { const int kb = r / 32, nb = r % 32; transpose_item(P.in[I_WOUT] + (size_t)l * D * D, D, 64 * kb, 32 * nb, (bf16*)((unsigned char*)wl + WO_OUT) + (size_t)(32 * nb) * D, D, scr, lane); return; } r -= IT_OUT;
    if (r < IT_GLU) { const int kb = r / 16, nb = r % 16, n0 = 32 * nb, nn = n0 & 255, drow = (nn >> 7) * 256 + (nn & 127) + ((n0 >> 8) ? 128 : 0);
        transpose_item(P.in[I_S5GLU] + (size_t)l * 256 * 512, 512, 64 * kb, n0, (bf16*)((unsigned char*)wl + WO_GLU) + (size_t)drow * 256, 256, scr, lane); return; } r -= IT_GLU;
    if (r < 2 * IT_EXP) { const int up = r / IT_EXP; r %= IT_EXP; const int e = r >> 8, q = r & 255, kb = q >> 4, nb = q & 15, n0 = 32 * nb, drow = (n0 >> 7) * 256 + (n0 & 127) + (up ? 128 : 0);
        transpose_item_f8(P.in[up ? I_MWU : I_MWG] + (size_t)(l * NEXP + e) * D * DEXP, DEXP, 64 * kb, n0, (unsigned char*)wl + WO_GU + (size_t)e * D * D + (size_t)drow * D, D, 64.f, scr, lane); return; } r -= 2 * IT_EXP;
    { const int e = r >> 8, q = r & 255, kb = q >> 5, nb = q & 31;
      transpose_item_f8(P.in[I_MWD] + (size_t)(l * NEXP + e) * DEXP * D, D, 64 * kb, 32 * nb, (unsigned char*)wl + WO_DN + (size_t)e * D * DEXP + (size_t)(32 * nb) * DEXP, DEXP, 64.f, scr, lane); }
}
__device__ __forceinline__ void rms_store_bf16(const f32x4 (&v)[4], const float* gain, bf16* orow, int lane) {
    float s = 0.f;
#pragma unroll
    for (int j = 0; j < 4; ++j) s += (v[j].x * v[j].x + v[j].y * v[j].y) + (v[j].z * v[j].z + v[j].w * v[j].w);
    const float rstd = 1.f / sqrtf(wave_sum(s) * (1.f / D) + 1e-6f);
    u32x2* o8 = (u32x2*)orow + lane;
#pragma unroll
    for (int j = 0; j < 4; ++j) { const f32x4 g = *((const f32x4*)gain + lane + 64 * j); u32x2 w; w.x = pk2(v[j].x * rstd * g.x, v[j].y * rstd * g.y); w.y = pk2(v[j].z * rstd * g.z, v[j].w * rstd * g.w); o8[64 * j] = w; }
}
__device__ __forceinline__ void s5_pow(float lr, float li, double dt, int j, float& ar, float& ai) {
    const double m = exp((double)lr * dt * (double)j); double ang = (double)li * dt * (double)j; ang -= 6.283185307179586 * rint(ang * 0.15915494309189535);
    ar = (float)(m * cos(ang)); ai = (float)(m * sin(ang));
}
__device__ __forceinline__ void s5_consts_unit(const Params& P, int l, int g, LAS unsigned char* lds, int tid) {
    LAS float* PW = (LAS float*)lds;
    LAS float* BBr = PW + 64 * 17 * 2;
    LAS float* BBi = BBr + 1024;
    LAS float* Cr = BBi + 1024;
    LAS float* Ci = Cr + 1024;
    LAS float* KT = Ci + 1024;
    const int lg = l * 16 + g;
    const double dt = exp((double)P.in[I_S5DT][lg]);
    const float* lrp = P.in[I_S5LR] + (size_t)lg * 64; const float* lip = P.in[I_S5LI] + (size_t)lg * 64;
    for (int idx = tid; idx < 64 * 17; idx += NTHR) { const int p = idx / 17, j = idx % 17; float ar, ai; s5_pow(lrp[p], lip[p], dt, j, ar, ai); PW[idx * 2] = ar; PW[idx * 2 + 1] = ai; }
    for (int idx = tid; idx < 1024; idx += NTHR) { const int p = idx >> 4, c = idx & 15; const float lr = lrp[p], li = lip[p]; float ar, ai; s5_pow(lr, li, dt, 1, ar, ai);
        const float den = lr * lr + li * li, kr = ((ar - 1.f) * lr + ai * li) / den, ki = (ai * lr - (ar - 1.f) * li) / den;
        const float br = P.in[I_S5BR][((size_t)lg * 64 + p) * 16 + c], bi = P.in[I_S5BI][((size_t)lg * 64 + p) * 16 + c];
        BBr[idx] = kr * br - ki * bi; BBi[idx] = kr * bi + ki * br;
        Cr[idx] = P.in[I_S5CR][(size_t)lg * 1024 + idx]; Ci[idx] = P.in[I_S5CI][(size_t)lg * 1024 + idx]; }
    __syncthreads();
    for (int idx = tid; idx < 4096; idx += NTHR) { const int j = idx >> 8, c = (idx >> 4) & 15, cp = idx & 15; float acc = 0.f;
        for (int p = 0; p < 64; ++p) { const float ar = PW[(p * 17 + j) * 2], ai = PW[(p * 17 + j) * 2 + 1], br = BBr[p * 16 + cp], bi = BBi[p * 16 + cp], cr = Cr[c * 64 + p], ci = Ci[c * 64 + p];
            const float zr = ar * br - ai * bi, zi = ar * bi + ai * br; acc += cr * zr - ci * zi; }
        KT[idx] = acc; }
    __syncthreads();
    unsigned char* sb = P.ws + WS_S5 + (size_t)l * S5_STRIDE;
    bf16* F3 = (bf16*)(sb + S5O_F3) + (size_t)g * 98304; bf16* F1 = (bf16*)(sb + S5O_F1) + (size_t)g * 32768; float* A16 = (float*)(sb + S5O_A16) + (size_t)g * 128;
    for (int idx = tid; idx < 98304; idx += NTHR) { const int j = idx & 7, ln = (idx >> 3) & 63, fk = idx >> 9, ks = fk % 12, rt = fk / 12; const int row = 16 * rt + (ln & 15), k = 32 * ks + 8 * (ln >> 4) + j, t = row >> 4, c = row & 15; float val;
        if (k < 256) { const int s2 = k >> 4, cp = k & 15; val = (s2 <= t) ? KT[((t - s2) * 16 + c) * 16 + cp] : 0.f; }
        else { const int n = k - 256, p = n & 63; const float ar = PW[(p * 17 + t + 1) * 2], ai = PW[(p * 17 + t + 1) * 2 + 1], cr = Cr[c * 64 + p], ci = Ci[c * 64 + p]; val = (n < 64) ? (cr * ar - ci * ai) : -(cr * ai + ci * ar); }
        F3[idx] = (bf16)f2bf(val); }
    for (int idx = tid; idx < 32768; idx += NTHR) { const int j = idx & 7, ln = (idx >> 3) & 63, fk = idx >> 9, ks = fk & 7, rt = fk >> 3; const int n = 16 * rt + (ln & 15), k = 32 * ks + 8 * (ln >> 4) + j, p = n & 63, s2 = k >> 4, cp = k & 15;
        const float ar = PW[(p * 17 + 15 - s2) * 2], ai = PW[(p * 17 + 15 - s2) * 2 + 1], br = BBr[p * 16 + cp], bi = BBi[p * 16 + cp];
        F1[idx] = (bf16)f2bf((n < 64) ? (ar * br - ai * bi) : (ar * bi + ai * br)); }
    if (tid < 64) { A16[tid * 2] = PW[(tid * 17 + 16) * 2]; A16[tid * 2 + 1] = PW[(tid * 17 + 16) * 2 + 1]; }
    __syncthreads();
}
__device__ __forceinline__ void ph_prologue(const Params& P, LAS unsigned char* lds, int tid, int lane, int wave) {
    for (int u = blockIdx.x; u < NL * 16; u += gridDim.x) s5_consts_unit(P, u >> 4, u & 15, lds, tid);
    LAS float* scr = (LAS float*)(lds + wave * 16384);
    const int gw = blockIdx.x * NWAVES + wave, NGW = gridDim.x * NWAVES;
    for (int it = gw; it < NL * IT_LAYER; it += NGW) prologue_item(P, it, scr, lane);
    for (int idx = blockIdx.x * NTHR + tid; idx < NL * 256 * 1024; idx += gridDim.x * NTHR) { const int l = idx >> 18, n = (idx >> 10) & 255, k = idx & 1023; float val = 0.f;
        if (n < 72) { const int j = n % 36; const float w = (j < 4) ? P.in[I_MCW][((size_t)l * D + k) * 4 + j] : P.in[I_MFW][(((size_t)l * 4 + ((j - 4) >> 3)) * D + k) * 8 + ((j - 4) & 7)]; val = w * P.in[I_NORM2][(size_t)l * D + k]; }
        const unsigned hi = f2bf(val); const float rem = val - __builtin_bit_cast(float, hi << 16);
        ((bf16*)(P.ws + WS_W + (size_t)l * WL_STRIDE + WO_RT))[(size_t)n * D + k] = (bf16)((n >= 36) ? f2bf(rem) : hi); }
    bf16* act = (bf16*)(P.ws + WS_ACT);
    for (int m = gw; m < NTOK; m += NGW) {
        const f32x4* xr = (const f32x4*)(P.in[I_X] + (size_t)m * D) + lane; f32x4 v[4];
#pragma unroll
        for (int j = 0; j < 4; ++j) v[j] = xr[64 * j];
        rms_store_bf16(v, P.in[I_NORM1], act + (size_t)m * D, lane);
    }
}


__device__ __forceinline__ u32x4 ldg16(const bf16* p) { return *(const u32x4*)p; }

#define MF(a, b, c) __builtin_amdgcn_mfma_f32_16x16x32_bf16((a), (b), (c), 0, 0, 0)
__device__ __forceinline__ u32x2 pack4(const f32x4 d) { u32x2 w; w.x = cvt2(d[0], d[1]); w.y = cvt2(d[2], d[3]); return w; }
__device__ __forceinline__ bf16x8 cat8(const u32x2 lo, const u32x2 hi) { u32x4 w; w.x = lo.x; w.y = lo.y; w.z = hi.x; w.w = hi.y; return __builtin_bit_cast(bf16x8, w); }
__device__ __forceinline__ bf16x8 pack_lo(const f32x4 d) { return cat8(pack4(d), (u32x2){0u, 0u}); }
__device__ __forceinline__ bf16x8 pack2(const f32x4 a, const f32x4 b) { return cat8(pack4(a), pack4(b)); }

__device__ __forceinline__ void role_hgrn(const Params& P, int l, int b, int hd, LAS unsigned char* lds, int tid, int lane, int wave) {
    LAS float* LF = (LAS float*)lds; LAS float* Oa = LF + 1024; LAS float* GamC = Oa + 1024;
    LAS bf16* Qh = (LAS bf16*)(GamC + 64); LAS bf16* Kt = Qh + 16 * 72; LAS bf16* KbarT = Kt + 16 * 72; LAS bf16* VmTb = KbarT + 64 * 24;
    const bf16* proj = (const bf16*)(P.ws + WS_PROJ); bf16* mix = (bf16*)(P.ws + WS_MIX);
    const int tl = tid & 255, tt = tl >> 4, j4 = (tl & 15) * 4, r = lane & 15, q = lane >> 4;
    const int tA = (wave < 4) ? (lane & 15) : tt, jA = (wave < 4) ? 16 * wave + 4 * (lane >> 4) : j4;
    f32x4 lb = {0.f, 0.f, 0.f, 0.f};
    if (l > 0) {
#pragma unroll
        for (int i = 0; i < 4; ++i) { const int c = hd * 64 + jA + i; lb[i] = 1.f / (1.f + expf(P.in[I_HLB][c] - P.in[I_HLB][256 + c])); } }
    const f32x4 nw = *(const f32x4*)(P.in[I_HNW] + l * 256 + hd * 64 + j4);
    f32x4 st[4];
#pragma unroll
    for (int i = 0; i < 4; ++i) st[i] = (f32x4){0.f, 0.f, 0.f, 0.f};
    const bf16* pr0 = proj + ((size_t)b * T + tA) * DIN + hd * 64 + jA;
    u32x2 n0a, n1a, n0b, n1b; f32x4 qv = lb, kkv = lb, civ = lb, cmv = lb, sgc = lb, sgn = lb;
    { const int o0 = (wave < 4) ? C_HQ : C_HI, o1 = (wave < 4) ? C_HF : C_HG;
      n0a = *(const u32x2*)(pr0 + o0); n1a = *(const u32x2*)(pr0 + o1); n0b = *(const u32x2*)(pr0 + (size_t)16 * DIN + o0); n1b = *(const u32x2*)(pr0 + (size_t)16 * DIN + o1); }
#define HG_STAGE_A(c, N0, N1) do { u32x2 rq = N0, rf = N1; PIN2(rq); PIN2(rf); \
        { const int cn_ = (c) + 2 < T / 16 ? (c) + 2 : T / 16 - 1; const bf16* pn = pr0 + (size_t)cn_ * 16 * DIN; N0 = *(const u32x2*)(pn + C_HQ); N1 = *(const u32x2*)(pn + C_HF); } \
        const f32x4 fx = {bflo(rf.x), bfhi(rf.x), bflo(rf.y), bfhi(rf.y)}, qx = {bflo(rq.x), bfhi(rq.x), bflo(rq.y), bfhi(rq.y)}; \
        f32x4 lfv; \
        _Pragma("unroll") for (int i = 0; i < 4; ++i) { const float e = __expf(fminf(-fx[i], 80.f)), ri_ = frcp(1.f + e); const float f = lb[i] + (1.f - lb[i]) * ri_; kkv[i] = (1.f - lb[i]) * e * ri_; lfv[i] = __logf(f); qv[i] = siluf_(qx[i]); } \
          \
        _Pragma("unroll") for (int i = 0; i < 4; ++i) { float p_ = lfv[i], s_ = lfv[i]; \
            p_ += DPPF(p_, 0x111); p_ += DPPF(p_, 0x112); p_ += DPPF(p_, 0x114); p_ += DPPF(p_, 0x118); \
            s_ += DPPF(s_, 0x101); s_ += DPPF(s_, 0x102); s_ += DPPF(s_, 0x104); s_ += DPPF(s_, 0x108); \
            civ[i] = p_; cmv[i] = s_ - lfv[i]; } } while (0)
#define HG_STAGE_V(c, N0, N1) do { u32x2 ri = N0, rg = N1; PIN2(ri); PIN2(rg); \
        { const int cn_ = (c) + 2 < T / 16 ? (c) + 2 : T / 16 - 1; const bf16* pn = pr0 + (size_t)cn_ * 16 * DIN; N0 = *(const u32x2*)(pn + C_HI); N1 = *(const u32x2*)(pn + C_HG); } \
        const f32x4 ix = {bflo(ri.x), bfhi(ri.x), bflo(ri.y), bfhi(ri.y)}, gx = {bflo(rg.x), bfhi(rg.x), bflo(rg.y), bfhi(rg.y)}; f32x4 vv; LAS bf16* VmT_ = VmTb + ((c) & 1) * 1536; \
        _Pragma("unroll") for (int i = 0; i < 4; ++i) { vv[i] = siluf_(ix[i]); sgn[i] = siluf_(gx[i]); } \
        { const u32x2 vp = pack4(vv); VmT_[(j4 + 0) * 24 + tt] = (bf16)(vp.x & 0xffffu); VmT_[(j4 + 1) * 24 + tt] = (bf16)(vp.x >> 16); VmT_[(j4 + 2) * 24 + tt] = (bf16)(vp.y & 0xffffu); VmT_[(j4 + 3) * 24 + tt] = (bf16)(vp.y >> 16); } } while (0)
#define HG_STAGE_B(c) do { f32x4 qh, kt, kb; \
        _Pragma("unroll") for (int i = 0; i < 4; ++i) { qh[i] = qv[i] * __expf(civ[i]); kt[i] = kkv[i] * __expf(fminf(-civ[i], 80.f)); kb[i] = kkv[i] * __expf(cmv[i]); } \
        *(LAS u32x2*)(Qh + tA * 72 + jA) = pack4(qh); *(LAS u32x2*)(Kt + tA * 72 + jA) = pack4(kt); \
        { const u32x2 kbp = pack4(kb); KbarT[(jA + 0) * 24 + tA] = (bf16)(kbp.x & 0xffffu); KbarT[(jA + 1) * 24 + tA] = (bf16)(kbp.x >> 16); KbarT[(jA + 2) * 24 + tA] = (bf16)(kbp.y & 0xffffu); KbarT[(jA + 3) * 24 + tA] = (bf16)(kbp.y >> 16); } \
        if (tA == 15) { f32x4 gc; _Pragma("unroll") for (int i = 0; i < 4; ++i) gc[i] = __expf(civ[i]); *(LAS f32x4*)(GamC + jA) = gc; } } while (0)
    if (wave < 4) HG_STAGE_A(0, n0a, n1a); else { HG_STAGE_V(0, n0a, n1a); sgc = sgn; }
    PIN2(n0b); PIN2(n1b);
    __syncthreads();
    if (wave < 4) HG_STAGE_B(0);
    __syncthreads();
    PIN2(n0a); PIN2(n1a);
    if (wave < 4) {
#pragma unroll 1
        for (int c = 0; c < T / 16; c += 2) { const int cn = c + 2 < T / 16 ? c + 2 : T / 16 - 1;
            HG_STAGE_A(c + 1, n0b, n1b); LDS_BARRIER(); HG_STAGE_B(c + 1); LDS_BARRIER();
            HG_STAGE_A(cn, n0a, n1a); LDS_BARRIER(); HG_STAGE_B(cn); LDS_BARRIER(); }
    } else {
#define HG_RO(c, cn, N0, N1) do { \
            { const int vt = wave - 4; const f32x4 z4 = {0.f, 0.f, 0.f, 0.f}; f32x4 AT = z4, o = z4; const LAS bf16* VmT_ = VmTb + ((c) & 1) * 1536; \
_Pragma("unroll")               for (int ks = 0; ks < 2; ++ks) AT = MF(*(const LAS bf16x8*)(Kt + r * 72 + ks * 32 + q * 8), *(const LAS bf16x8*)(Qh + r * 72 + ks * 32 + q * 8), AT);    \
_Pragma("unroll")               for (int i = 0; i < 4; ++i) AT[i] = (4 * q + i <= r) ? AT[i] : 0.f; \
              const u32x2 vmB = *(const LAS u32x2*)(VmT_ + (16 * vt + r) * 24 + 4 * q); const bf16x8 bV = cat8(vmB, (u32x2){0u, 0u}); \
_Pragma("unroll")               for (int ks = 0; ks < 2; ++ks) o = MF(cat8(*(const LAS u32x2*)(Qh + r * 72 + 32 * ks + 4 * q), *(const LAS u32x2*)(Qh + r * 72 + 32 * ks + 16 + 4 * q)), pack2(st[2 * ks], st[2 * ks + 1]), o); \
              o = MF(pack_lo(AT), bV, o); \
_Pragma("unroll")               for (int i = 0; i < 4; ++i) Oa[(4 * q + i) * 64 + 16 * vt + r] = o[i]; \
_Pragma("unroll")               for (int kt = 0; kt < 4; ++kt) { const f32x4 g4 = *(const LAS f32x4*)(GamC + 16 * kt + 4 * q); \
                  st[kt] = MF(cat8(*(const LAS u32x2*)(KbarT + (16 * kt + r) * 24 + 4 * q), (u32x2){0u, 0u}), bV, st[kt] * g4); } } \
            LDS_BARRIER(); \
            { const f32x4 o4 = *(const LAS f32x4*)(Oa + tt * 64 + j4); \
              const float ss = row16_sum((o4[0] * o4[0] + o4[1] * o4[1]) + (o4[2] * o4[2] + o4[3] * o4[3])); const float rs = __builtin_amdgcn_rsqf(ss * (1.f / 64.f) + 1e-6f); \
              *(u32x2*)(mix + ((size_t)b * T + (c) * 16 + tt) * D + hd * 64 + j4) = pack4(o4 * rs * nw * sgc); \
              HG_STAGE_V(cn, N0, N1); sgc = sgn; } \
            LDS_BARRIER(); \
    } while (0)
#pragma unroll 1
        for (int c = 0; c < T / 16; c += 2) { const int cn2 = c + 2 < T / 16 ? c + 2 : T / 16 - 1;
            HG_RO(c, c + 1, n0b, n1b); HG_RO(c + 1, cn2, n0a, n1a); }
#undef HG_RO
    }
#undef HG_STAGE_A
#undef HG_STAGE_V
#undef HG_STAGE_B
}

__device__ __forceinline__ f32x4 mma_tile(const LAS bf16* A, int lda, const LAS bf16* Bt, int ldb, int K, int lane) {
    f32x4 acc = {0.f, 0.f, 0.f, 0.f}; const int r = lane & 15, q = lane >> 4;
    for (int k0 = 0; k0 < K; k0 += 32) { const bf16x8 a = *(const LAS bf16x8*)(A + r * lda + k0 + q * 8); const bf16x8 b = *(const LAS bf16x8*)(Bt + r * ldb + k0 + q * 8);
        acc = __builtin_amdgcn_mfma_f32_16x16x32_bf16(a, b, acc, 0, 0, 0); }
    return acc;
}
__device__ __forceinline__ void lds_load_wT(const float* W, int ldw, int n0, int N, int K, LAS bf16* Wt, int ldt, int tid) {
#pragma unroll 2
    for (int idx = tid; idx < K * N; idx += NTHR) { const int k = idx / N, n = idx % N; Wt[n * ldt + k] = (bf16)f2bf(W[(size_t)k * ldw + n0 + n]); }
}

__device__ __forceinline__ void role_lru(const Params& P, int l, int b, int hd, LAS unsigned char* lds, int tid, int lane, int wave) {
    LAS float* XR = (LAS float*)lds; LAS float* LG = XR + 67 * 64; LAS float* XC = LG + 4096; LAS float* RL = XC + 4096; LAS float* GL = RL + 4096;
    LAS bf16* XCb = (LAS bf16*)(GL + 4096); LAS bf16* WaT = XCb + 64 * 72; LAS bf16* WxT = WaT + 64 * 72; LAS float* CWL = (LAS float*)(WxT + 64 * 72);
    const bf16* proj = (const bf16*)(P.ws + WS_PROJ); bf16* mix = (bf16*)(P.ws + WS_MIX);
    const int tt = tid >> 3, c8 = (tid & 7) * 8;
    lds_load_wT(P.in[I_LWA] + (size_t)(l * 4 + hd) * 4096, 64, 0, 64, 64, WaT, 72, tid);
    lds_load_wT(P.in[I_LWX] + (size_t)(l * 4 + hd) * 4096, 64, 0, 64, 64, WxT, 72, tid);
    if (tid < 320) { const int jj = tid >> 6, c = tid & 63; CWL[tid] = (jj < 4) ? P.in[I_LCW][(size_t)l * 4 * 256 + jj * 256 + hd * 64 + c] : P.in[I_LCB][l * 256 + hd * 64 + c]; }
    if (tid < 24) {
#pragma unroll
        for (int i = 0; i < 8; ++i) XR[(tid >> 3) * 64 + c8 + i] = 0.f; }
    float pba[2], pbx[2], pspl[2];
#pragma unroll
    for (int h2 = 0; h2 < 2; ++h2) { const int j = ((wave >> 2) * 2 + h2) * 16 + (lane & 15), c = l * 256 + hd * 64 + j; pba[h2] = P.in[I_LBA][c]; pbx[h2] = P.in[I_LBX][c]; pspl[h2] = log1pf(expf(-P.in[I_LLAM][c])); }
    float hstate = 0.f;
    const bf16* px = proj + ((size_t)b * T + tt) * DIN + C_LX + hd * 64 + c8; const bf16* pgp = proj + ((size_t)b * T + tt) * DIN + C_LG + hd * 64 + c8;
    u32x4 nx = ldg16(px), ngt = ldg16(pgp);
    __syncthreads();
#pragma unroll 1
    for (int blk = 0; blk < T / 64; ++blk) {
        const int t0 = blk * 64;
        {   float x[8], g[8]; unpack8(nx, x); unpack8(ngt, g);
            if (blk + 1 < T / 64) { nx = ldg16(px + (size_t)(t0 + 64) * DIN); ngt = ldg16(pgp + (size_t)(t0 + 64) * DIN); }
#pragma unroll
            for (int i = 0; i < 8; ++i) { XR[(tt + 3) * 64 + c8 + i] = x[i]; LG[tt * 64 + c8 + i] = g[i]; }
        }
        LDS_BARRIER();
        {   float xc[8];
#pragma unroll
            for (int i = 0; i < 8; ++i) { const int c = c8 + i; float a = CWL[256 + c];
#pragma unroll
                for (int jj = 0; jj < 4; ++jj) a += CWL[jj * 64 + c] * XR[(tt + jj) * 64 + c];
                XC[tt * 64 + c] = a; xc[i] = a; }
            u32x4 w; w.x = cvt2(xc[0], xc[1]); w.y = cvt2(xc[2], xc[3]); w.z = cvt2(xc[4], xc[5]); w.w = cvt2(xc[6], xc[7]); *(LAS u32x4*)(XCb + tt * 72 + c8) = w; }
        LDS_BARRIER();
        {   const int tt4 = wave & 3, r = lane & 15, q = lane >> 4;
#pragma unroll
            for (int h2 = 0; h2 < 2; ++h2) { const int nt = (wave >> 2) * 2 + h2, j = nt * 16 + r;
                const f32x4 ar = mma_tile(XCb + tt4 * 16 * 72, 72, WaT + nt * 16 * 72, 72, 64, lane), ag = mma_tile(XCb + tt4 * 16 * 72, 72, WxT + nt * 16 * 72, 72, 64, lane);
#pragma unroll
                for (int i = 0; i < 4; ++i) { const int t = tt4 * 16 + q * 4 + i; const float rr = sigmoidf_(ar[i] + pba[h2]), gi = sigmoidf_(ag[i] + pbx[h2]); const float la = -8.f * rr * pspl[h2];
                    const float e2 = __expf(2.f * la); RL[t * 64 + j] = __expf(la); GL[t * 64 + j] = sqrtf(1.f - e2) * gi * XC[t * 64 + j]; } }
            if (tid < 24) {
#pragma unroll
                for (int i = 0; i < 8; ++i) XR[(tid >> 3) * 64 + c8 + i] = XR[(64 + (tid >> 3)) * 64 + c8 + i]; }
        }
        LDS_BARRIER();
        if (tid < 64) {
#pragma unroll 8
            for (int t = 0; t < 64; ++t) { hstate = RL[t * 64 + tid] * hstate + GL[t * 64 + tid]; XC[t * 64 + tid] = hstate; } }
        LDS_BARRIER();
        {   u32x4 w; float o[8];
#pragma unroll
            for (int i = 0; i < 8; ++i) o[i] = gelu_tanh(LG[tt * 64 + c8 + i]) * XC[tt * 64 + c8 + i];
            w.x = cvt2(o[0], o[1]); w.y = cvt2(o[2], o[3]); w.z = cvt2(o[4], o[5]); w.w = cvt2(o[6], o[7]);
            *(u32x4*)(mix + ((size_t)b * T + t0 + tt) * D + 768 + hd * 64 + c8) = w; }
        LDS_BARRIER();
    }
}

__device__ __forceinline__ void s5_stage_u(const bf16* proj, int b, int g, int t0, LAS unsigned char* UL, int tid) {
#pragma unroll
    for (int rep = 0; rep < 4; ++rep) { const int tk = rep * 256 + (tid >> 1), half = tid & 1; const u32x4 v = ldg16(proj + ((size_t)b * T + t0 + tk) * DIN + C_SU + g * 16 + half * 8);
        const int cl = tk >> 4, s = tk & 15; *(LAS u32x4*)(UL + (cl >> 4) * 8192 + ((s * 16 + (cl & 15)) * 32 + half * 16)) = v; }
}
__device__ __forceinline__ void role_s5(const Params& P, int l, int b, int g, LAS unsigned char* lds, int tid, int lane, int wave) {
    LAS unsigned char* UL = lds; LAS unsigned char* XL = lds + 32768; LAS float* ES = (LAS float*)(lds + 49152);
    const bf16* proj = (const bf16*)(P.ws + WS_PROJ); bf16* yg = (bf16*)(P.ws + WS_YG);
    const unsigned char* sb = P.ws + WS_S5 + (size_t)l * S5_STRIDE;
    const bf16* F3 = (const bf16*)(sb + S5O_F3) + (size_t)g * 98304; const bf16* F1 = (const bf16*)(sb + S5O_F1) + (size_t)g * 32768; const float* A16 = (const float*)(sb + S5O_A16) + (size_t)g * 128;
    float* Hu = (float*)(P.ws + WS_HU) + (size_t)(b * 16 + g) * 512 * 128; float* Xs = (float*)(P.ws + WS_XS) + (size_t)(b * 16 + g) * 512 * 128;
    const int c16 = lane & 15, q = lane >> 4;
    {
        bf16x8 af[8];
#pragma unroll
        for (int ks = 0; ks < 8; ++ks) af[ks] = *(const bf16x8*)(F1 + ((size_t)(wave * 8 + ks) * 64 + lane) * 8);
#pragma unroll 1
        for (int it = 0; it < 8; ++it) {
            s5_stage_u(proj, b, g, it * 1024, UL, tid);
            __syncthreads();
#pragma unroll 1
            for (int ct = 0; ct < 4; ++ct) { f32x4 acc = {0.f, 0.f, 0.f, 0.f};
#pragma unroll
                for (int ks = 0; ks < 8; ++ks) { const bf16x8 bv = *(const LAS bf16x8*)(UL + ct * 8192 + (((2 * ks + (q >> 1)) * 16 + c16) * 32 + (q & 1) * 16)); acc = __builtin_amdgcn_mfma_f32_16x16x32_bf16(af[ks], bv, acc, 0, 0, 0); }
                *(f32x4*)(Hu + (size_t)(it * 64 + ct * 16 + c16) * 128 + 16 * wave + 4 * q) = acc; }
            __syncthreads();
        }
    }
    __threadfence(); __syncthreads();
    {
        const float ar = A16[lane * 2], ai = A16[lane * 2 + 1]; const float* hb = Hu + (size_t)(wave * 64) * 128; float xr = 0.f, xi = 0.f;
#pragma unroll 8
        for (int j = 0; j < 64; ++j) { const float hr = hb[j * 128 + lane], hi = hb[j * 128 + 64 + lane]; const float nr = ar * xr - ai * xi + hr, ni = ar * xi + ai * xr + hi; xr = nr; xi = ni; }
        ES[wave * 128 + lane] = xr; ES[wave * 128 + 64 + lane] = xi;
        __syncthreads();
        float pr = ar, pi = ai;
#pragma unroll
        for (int i = 0; i < 6; ++i) { const float nr = pr * pr - pi * pi, ni = 2.f * pr * pi; pr = nr; pi = ni; }
        float cr = 0.f, ci = 0.f;
        for (int w2 = 0; w2 < wave; ++w2) { const float er = ES[w2 * 128 + lane], ei = ES[w2 * 128 + 64 + lane]; const float nr = pr * cr - pi * ci + er, ni = pr * ci + pi * cr + ei; cr = nr; ci = ni; }
        xr = cr; xi = ci; float* xb = Xs + (size_t)(wave * 64) * 128;
#pragma unroll 8
        for (int j = 0; j < 64; ++j) { const float hr = hb[j * 128 + lane], hi = hb[j * 128 + 64 + lane]; xb[j * 128 + lane] = xr; xb[j * 128 + 64 + lane] = xi; const float nr = ar * xr - ai * xi + hr, ni = ar * xi + ai * xr + hi; xr = nr; xi = ni; }
    }
    __threadfence(); __syncthreads();
    {
        bf16x8 af[2][12];
#pragma unroll
        for (int r2 = 0; r2 < 2; ++r2)
#pragma unroll
            for (int ks = 0; ks < 12; ++ks) af[r2][ks] = *(const bf16x8*)(F3 + ((size_t)((2 * wave + r2) * 12 + ks) * 64 + lane) * 8);
        float dsk[4];
#pragma unroll
        for (int i = 0; i < 4; ++i) dsk[i] = P.in[I_S5D][l * 256 + g * 16 + 4 * q + i];
#pragma unroll 1
        for (int it = 0; it < 8; ++it) {
            s5_stage_u(proj, b, g, it * 1024, UL, tid);
#pragma unroll
            for (int rep = 0; rep < 4; ++rep) { const int cl = rep * 16 + (tid >> 5), n4 = (tid & 31) * 4; const f32x4 x = *(const f32x4*)(Xs + (size_t)(it * 64 + cl) * 128 + n4);
                u32x2 w; w.x = pk2(x.x, x.y); w.y = pk2(x.z, x.w);
                *(LAS u32x2*)(XL + (cl >> 4) * 4096 + ((((n4 >> 5) * 4 + ((n4 >> 3) & 3)) * 16 + (cl & 15)) * 16 + (n4 & 7) * 2)) = w; }
            __syncthreads();
#pragma unroll 1
            for (int ct = 0; ct < 4; ++ct) { f32x4 acc0 = {0.f, 0.f, 0.f, 0.f}, acc1 = {0.f, 0.f, 0.f, 0.f};
#pragma unroll
                for (int ks = 0; ks < 8; ++ks) { const bf16x8 bv = *(const LAS bf16x8*)(UL + ct * 8192 + (((2 * ks + (q >> 1)) * 16 + c16) * 32 + (q & 1) * 16));
                    acc0 = __builtin_amdgcn_mfma_f32_16x16x32_bf16(af[0][ks], bv, acc0, 0, 0, 0); acc1 = __builtin_amdgcn_mfma_f32_16x16x32_bf16(af[1][ks], bv, acc1, 0, 0, 0); }
#pragma unroll
                for (int ks = 0; ks < 4; ++ks) { const bf16x8 bv = *(const LAS bf16x8*)(XL + ct * 4096 + ((ks * 4 + q) * 16 + c16) * 16);
                    acc0 = __builtin_amdgcn_mfma_f32_16x16x32_bf16(af[0][8 + ks], bv, acc0, 0, 0, 0); acc1 = __builtin_amdgcn_mfma_f32_16x16x32_bf16(af[1][8 + ks], bv, acc1, 0, 0, 0); }
#pragma unroll
                for (int r2 = 0; r2 < 2; ++r2) { const int t = 2 * wave + r2; const f32x4 acc = r2 ? acc1 : acc0;
                    const u32x2 uw = *(const LAS u32x2*)(UL + ct * 8192 + ((t * 16 + c16) * 32 + (4 * q) * 2));
                    const float y0 = gelu_tanh(acc[0] + dsk[0] * bflo(uw.x)), y1 = gelu_tanh(acc[1] + dsk[1] * bfhi(uw.x)), y2 = gelu_tanh(acc[2] + dsk[2] * bflo(uw.y)), y3 = gelu_tanh(acc[3] + dsk[3] * bfhi(uw.y));
                    u32x2 o; o.x = pk2(y0, y1); o.y = pk2(y2, y3);
                    *(u32x2*)(yg + ((size_t)b * T + it * 1024 + (ct * 16 + c16) * 16 + t) * 256 + g * 16 + 4 * q) = o; } }
            __syncthreads();
        }
    }
}

__device__ __forceinline__ void rw_load8(const bf16* cur, const bf16* prev, const float* mu, float (&o)[8]) {
    float p[8], q[8]; unpack8(ldg16(cur), p);
    if (prev) unpack8(ldg16(prev), q); else {
#pragma unroll
        for (int i = 0; i < 8; ++i) q[i] = 0.f; }
    const f32x4 m0 = *(const f32x4*)mu, m1 = *(const f32x4*)(mu + 4);
#pragma unroll
    for (int i = 0; i < 4; ++i) { o[i] = p[i] + m0[i] * (q[i] - p[i]); o[4 + i] = p[4 + i] + m1[i] * (q[4 + i] - p[4 + i]); }
}
__device__ __forceinline__ void rw_mix8(const u32x4 c, const u32x4 pv, const LAS float* mu, float (&o)[8]) {
    float p[8], q[8]; unpack8(c, p); unpack8(pv, q);
    const f32x4 m0 = *(const LAS f32x4*)mu, m1 = *(const LAS f32x4*)(mu + 4);
#pragma unroll
    for (int i = 0; i < 4; ++i) { o[i] = p[i] + m0[i] * (q[i] - p[i]); o[4 + i] = p[4 + i] + m1[i] * (q[4 + i] - p[4 + i]); }
}
__device__ __forceinline__ void st8f(LAS float* d, const float (&o)[8]) { *(LAS f32x4*)d = (f32x4){o[0], o[1], o[2], o[3]}; *(LAS f32x4*)(d + 4) = (f32x4){o[4], o[5], o[6], o[7]}; }
__device__ __forceinline__ void st8b(LAS bf16* d, const float (&o)[8]) { u32x4 w; w.x = cvt2(o[0], o[1]); w.y = cvt2(o[2], o[3]); w.z = cvt2(o[4], o[5]); w.w = cvt2(o[6], o[7]); *(LAS u32x4*)d = w; }
constexpr int RW_SLAB = 64, RW_NSLAB = 8, RW_RING = 3, RW_RUN = 8;
constexpr size_t RWB_STRIDE = 18944;
constexpr int RWB_WQ = 0, RWB_BB = 4096, RWB_KB = 6144, RWB_VM = 8192, RWB_GC = 10240, RWB_W2 = 10496, RWB_YL = 12544, RWB_G = 14592, RWB_BON = 16640;
constexpr int CW_TMO = 64, CW_RWP = 16384, CW_RWC = 32768;
static_assert((size_t)32 * RW_RING * RW_SLAB * RWB_STRIDE <= (size_t)128 * MiB, "bundle ring fits the ACT buffer");
__device__ __forceinline__ unsigned char* rw_bundle(const Params& P, int seq, int chunk) { return P.ws + WS_ACT + (size_t)((seq * RW_RING + ((chunk >> 6) % RW_RING)) * RW_SLAB + (chunk & 63)) * RWB_STRIDE; }
#define RLX_AGENT __ATOMIC_RELAXED, __HIP_MEMORY_SCOPE_AGENT
__device__ __forceinline__ void st_wt8(void* p, u32x2 v) { __hip_atomic_store((unsigned long long*)p, (unsigned long long)v.x | ((unsigned long long)v.y << 32), RLX_AGENT); }
__device__ __forceinline__ void wait_ge(unsigned* word, unsigned want, unsigned* tmo) {
    unsigned spins = 0;
    while ((unsigned)__builtin_amdgcn_readfirstlane(__hip_atomic_load(word, RLX_AGENT)) < want) {
        __builtin_amdgcn_s_sleep(2);
        if (++spins > (1u << 20)) { __hip_atomic_store(tmo, 1u, RLX_AGENT); break; }
        if ((spins & 1023u) == 0u && __builtin_amdgcn_readfirstlane(__hip_atomic_load(tmo, RLX_AGENT))) break;
    }
}
__device__ __forceinline__ void rwkv_producer(const Params& P, int l, int hd, int gp, int NPG, LAS unsigned char* lds, int tid, int lane, int wave) {
    unsigned* ctl = (unsigned*)(P.ws + WS_CTL);
    LAS bf16* W2T = (LAS bf16*)lds;
    LAS bf16* A2T = W2T + 64 * 72;
    LAS bf16* G2T = A2T + 64 * 72;
    LAS bf16* V1T = G2T + 64 * 136;
    LAS bf16* V2T = V1T + 32 * 264;
    LAS bf16* TWD = V2T + 64 * 40;
    LAS bf16* ADb = TWD + 16 * 72;
    LAS bf16* SGD = ADb + 16 * 72;
    LAS bf16* VALb = SGD + 16 * 136;
    LAS bf16* VHb = VALb + 16 * 264;
    LAS float* R = (LAS float*)(VHb + 16 * 40); LAS float* K = R + 1024; LAS float* V = K + 1024; LAS float* WL = V + 1024; LAS float* KK = WL + 1024; LAS float* Bb = KK + 1024;
    LAS float* G = Bb + 1024; LAS float* Y = G + 1024; LAS float* RK = Y + 1024  ; LAS float* AL = RK + 16; LAS float* VG = AL + 1024;
    LAS bf16* KKh = TWD; LAS bf16* Rh = KKh + 16 * 72; LAS bf16* Bt = Rh + 16 * 72; LAS bf16* Kt = Bt + 16 * 72; LAS bf16* BbarT = Kt + 16 * 72; LAS bf16* KbarT = BbarT + 64 * 24;
    LAS bf16* VmT = (LAS bf16*)AL; LAS bf16* KKhT = VmT + 64 * 24; LAS bf16* RhT = KKhT + 64 * 24; LAS float* GamC = (LAS float*)(RhT + 64 * 24); LAS bf16* WQ = (LAS bf16*)(GamC + 64); LAS float* MU = (LAS float*)(WQ + 32 * 72); LAS float* PT = MU + 1024;
    const bf16* proj = (const bf16*)(P.ws + WS_PROJ); bf16* mix = (bf16*)(P.ws + WS_MIX); bf16* vf = (bf16*)(P.ws + WS_VF);
    const float* mu_base = P.in[I_RMU] + (size_t)l * 1024;
    lds_load_wT(P.in[I_RW2] + (size_t)l * 64 * 256, 256, hd * 64, 64, 64, W2T, 72, tid);
    lds_load_wT(P.in[I_RA2] + (size_t)l * 64 * 256, 256, hd * 64, 64, 64, A2T, 72, tid);
    lds_load_wT(P.in[I_RG2] + (size_t)l * 128 * 256, 256, hd * 64, 64, 128, G2T, 136, tid);
    if (l > 0) { lds_load_wT(P.in[I_RV1], 32, 0, 32, 256, V1T, 264, tid); lds_load_wT(P.in[I_RV2], 256, hd * 64, 64, 32, V2T, 40, tid); }
    const int tt0 = tid >> 5, l320 = tid & 31;
    for (int i = tid; i < 1024; i += NTHR) MU[i] = mu_base[i];
    if (tid < 64) { const int c = l * 256 + hd * 64 + tid; PT[tid] = P.in[I_RW0][c]; PT[64 + tid] = P.in[I_RA0][c]; PT[128 + tid] = P.in[I_RKK][c]; PT[192 + tid] = P.in[I_RKA][c]; PT[256 + tid] = P.in[I_RRK][c];
        PT[320 + tid] = (l > 0) ? P.in[I_RV0][hd * 64 + tid] : 0.f; PT[384 + tid] = P.in[I_RLNW][c]; PT[448 + tid] = P.in[I_RLNB][c]; }
    const int segA = l320 >> 3, chA = l320 & 7, colA = (segA == 0 ? hd * 64 : segA == 1 ? 256 + hd * 64 : segA == 2 ? 768 : 832) + chA * 8, colB = 896 + (l320 & 15) * 8;
    const bool hasB = l320 < 16, hasC = (l > 0) || (l320 >= 16 && l320 < 24); const int colC = (l > 0) ? 512 + l320 * 8 : 512 + hd * 64 + (l320 & 7) * 8;
    const u32x4 zero4 = {0u, 0u, 0u, 0u};
    __syncthreads();
    const int nun = (NPG == 40) ? (gp < 32 ? 12 : gp < 40 ? 13 : 3) : 0;
#pragma unroll 1
    for (int k = 0; ; ++k) { int u;
        if (NPG == 40) { if (k >= nun) break; u = (gp >= 40) ? 488 + 8 * k + (gp - 40) : (k < 12 ? gp + 40 * k : 480 + (gp - 32)); }
        else { u = gp + k * NPG; if (u >= 512) break; }
    const int slab = u >> 6, b = (u >> 3) & 7, run = u & 7, seq = b * 4 + hd, cfirst = slab * RW_SLAB + run * RW_RUN;
    if (slab >= RW_RING) { if (wave == 0) wait_ge(ctl + CW_RWC + l * 1024 + seq * 16, (unsigned)(slab - RW_RING + 1), ctl + CW_TMO); __syncthreads(); }
    const bf16* rowp = proj + ((size_t)b * T + tt0) * DIN + C_RW; const bf16* vfp = vf + ((size_t)b * T + tt0) * 256 + hd * 64 + l320 * 2;
    u32x4 nAc, nAp, nBc = zero4, nBp = zero4, nCc = zero4, nCp = zero4; unsigned nvf = 0u;
    {   const bf16* rn = rowp + (size_t)(cfirst * 16) * DIN; const bool hp = (cfirst * 16 + tt0) > 0;
        nAc = ldg16(rn + colA); nAp = hp ? ldg16(rn - DIN + colA) : zero4;
        if (hasB) { nBc = ldg16(rn + colB); nBp = hp ? ldg16(rn - DIN + colB) : zero4; }
        if (hasC) { nCc = ldg16(rn + colC); nCp = hp ? ldg16(rn - DIN + colC) : zero4; }
        if (l > 0) nvf = *(const unsigned*)(vfp + (size_t)(cfirst * 16) * 256); }
#pragma unroll 1
    for (int blk = cfirst; blk < cfirst + RW_RUN; ++blk) {
        const int t0 = blk * 16; int tidl = tid; asm volatile("" : "+v"(tidl));
        const int tt = tidl >> 5, l32 = tidl & 31, lane = tidl & 63;
        const u32x4 rAc = nAc, rAp = nAp, rBc = nBc, rBp = nBp, rCc = nCc, rCp = nCp; const unsigned rvf = nvf;
        if (blk + 1 < cfirst + RW_RUN) { const bf16* rn = rowp + (size_t)(t0 + 16) * DIN;
            nAc = ldg16(rn + colA); nAp = ldg16(rn - DIN + colA);
            if (hasB) { nBc = ldg16(rn + colB); nBp = ldg16(rn - DIN + colB); }
            if (hasC) { nCc = ldg16(rn + colC); nCp = ldg16(rn - DIN + colC); }
            if (l > 0) nvf = *(const unsigned*)(vfp + (size_t)(t0 + 16) * 256); }
        unsigned char* bp = rw_bundle(P, seq, blk);
        {   float o[8];
            rw_mix8(rAc, rAp, MU + colA, o);
            if (segA == 0) st8f(R + tt * 64 + chA * 8, o); else if (segA == 1) st8f(K + tt * 64 + chA * 8, o);
            else if (segA == 2) {
#pragma unroll
                for (int i = 0; i < 8; ++i) { const float e = __expf(2.f * o[i]); o[i] = 1.f - 2.f * frcp(e + 1.f); }
                st8b(TWD + tt * 72 + chA * 8, o); }
            else st8b(ADb + tt * 72 + chA * 8, o);
            if (hasB) { rw_mix8(rBc, rBp, MU + colB, o);
#pragma unroll
                for (int i = 0; i < 8; ++i) o[i] = sigmoidf_(o[i]);
                st8b(SGD + tt * 136 + (l32 & 15) * 8, o); }
            if (hasC) { rw_mix8(rCc, rCp, MU + colC, o);
                if (l == 0) st8f(V + tt * 64 + (l32 & 7) * 8, o);
                else { st8b(VALb + tt * 264 + l32 * 8, o); if ((l32 >> 3) == hd) st8f(V + tt * 64 + (l32 & 7) * 8, o); } }
        }
        LDS_BARRIER();
        {   const int r = lane & 15, q = lane >> 4;
            if (wave < 4) { const f32x4 cw_ = mma_tile(TWD, 72, W2T + wave * 16 * 72, 72, 64, lane), ca = mma_tile(ADb, 72, A2T + wave * 16 * 72, 72, 64, lane);
#pragma unroll
                for (int i = 0; i < 4; ++i) { WL[(q * 4 + i) * 64 + wave * 16 + r] = cw_[i]; AL[(q * 4 + i) * 64 + wave * 16 + r] = ca[i]; }
                if (l > 0 && wave < 2) { const f32x4 ch_ = mma_tile(VALb, 264, V1T + wave * 16 * 264, 264, 256, lane);
#pragma unroll
                    for (int i = 0; i < 4; ++i) VHb[(q * 4 + i) * 40 + wave * 16 + r] = (bf16)f2bf(ch_[i]); } }
            else { const int nt = wave - 4; const f32x4 cg = mma_tile(SGD, 136, G2T + nt * 16 * 136, 136, 128, lane);
#pragma unroll
                for (int i = 0; i < 4; ++i) G[(q * 4 + i) * 64 + nt * 16 + r] = cg[i]; }
        }
        LDS_BARRIER();
        if (l > 0) {
            if (wave < 4) { const int r = lane & 15, q = lane >> 4; const f32x4 cv = mma_tile(VHb, 40, V2T + wave * 16 * 40, 40, 32, lane);
#pragma unroll
                for (int i = 0; i < 4; ++i) VG[(q * 4 + i) * 64 + wave * 16 + r] = cv[i]; }
            LDS_BARRIER();
        }
        {   const int j2 = l32 * 2; float ssq = 0.f, rk = 0.f; float kkv[2], av[2], vv2[2];
            const size_t tok = (size_t)b * T + t0 + tt;
#pragma unroll
            for (int i = 0; i < 2; ++i) { const int j = j2 + i, x = tt * 64 + j;
                const float wl = -softplusf_(-(PT[j] + WL[x])) - 0.5f; WL[x] = -__expf(wl);
                const float a = sigmoidf_(PT[64 + j] + AL[x]); av[i] = a;
                const float kr = K[x]; kkv[i] = kr * PT[128 + j]; ssq += kkv[i] * kkv[i];
                const float km = kr * (1.f + (a - 1.f) * PT[192 + j]); K[x] = km;
                float v = V[x];
                if (l > 0) { const float vfv = i ? bfhi(rvf) : bflo(rvf); v = v + (vfv - v) * sigmoidf_(PT[320 + j] + VG[x]); V[x] = v; }
                vv2[i] = v;
                rk += R[x] * km * PT[256 + j]; }
            if (l == 0) *(unsigned*)(vf + tok * 256 + hd * 64 + j2) = cvt2(vv2[0], vv2[1]);
            ssq = half_sum(ssq, lane); rk = half_sum(rk, lane);
            const float inv = frcp(fmaxf(sqrtf(ssq), 1e-12f));
#pragma unroll
            for (int i = 0; i < 2; ++i) { const int x = tt * 64 + j2 + i; const float kn = kkv[i] * inv; KK[x] = kn; Bb[x] = kn * av[i]; }
            if (l32 == 0) RK[tt] = rk;
        }
        LDS_BARRIER();
        {   const int j2 = l32 * 2; float ce0 = 0.f, ce1 = 0.f, ct0 = 0.f, ct1 = 0.f;
#pragma unroll
            for (int s2 = 0; s2 < 16; ++s2) { const f32x2 w2 = *(const LAS f32x2*)(WL + s2 * 64 + j2); if (s2 < tt) { ce0 += w2.x; ce1 += w2.y; } ct0 += w2.x; ct1 += w2.y; }
            const f32x2 wme = *(const LAS f32x2*)(WL + tt * 64 + j2); const float ci0 = ce0 + wme.x, ci1 = ce1 + wme.y;
            const float ex0 = __expf(ce0), ex1 = __expf(ce1), in0 = __expf(ci0), in1 = __expf(ci1), ng0 = __expf(-ci0), ng1 = __expf(-ci1), br0 = __expf(ct0 - ci0), br1 = __expf(ct1 - ci1);
            const int x = tt * 64 + j2; const f32x2 kk2 = *(const LAS f32x2*)(KK + x), r2 = *(const LAS f32x2*)(R + x), b2 = *(const LAS f32x2*)(Bb + x), k2 = *(const LAS f32x2*)(K + x), v2_ = *(const LAS f32x2*)(V + x);
            const unsigned kkh = cvt2(kk2.x * ex0, kk2.y * ex1), rh = cvt2(r2.x * in0, r2.y * in1);
            *(LAS unsigned*)(KKh + tt * 72 + j2) = kkh; *(LAS unsigned*)(Rh + tt * 72 + j2) = rh;
            *(LAS unsigned*)(Bt + tt * 72 + j2) = cvt2(b2.x * ng0, b2.y * ng1); *(LAS unsigned*)(Kt + tt * 72 + j2) = cvt2(k2.x * ng0, k2.y * ng1);
            KKhT[j2 * 24 + tt] = (bf16)(kkh & 0xffffu); KKhT[(j2 + 1) * 24 + tt] = (bf16)(kkh >> 16); RhT[j2 * 24 + tt] = (bf16)(rh & 0xffffu); RhT[(j2 + 1) * 24 + tt] = (bf16)(rh >> 16);
            { const unsigned bb = cvt2(b2.x * br0, b2.y * br1), kb = cvt2(k2.x * br0, k2.y * br1); BbarT[j2 * 24 + tt] = (bf16)(bb & 0xffffu); BbarT[(j2 + 1) * 24 + tt] = (bf16)(bb >> 16); KbarT[j2 * 24 + tt] = (bf16)(kb & 0xffffu); KbarT[(j2 + 1) * 24 + tt] = (bf16)(kb >> 16); }
            { const unsigned vv = cvt2(v2_.x, v2_.y); VmT[j2 * 24 + tt] = (bf16)(vv & 0xffffu); VmT[(j2 + 1) * 24 + tt] = (bf16)(vv >> 16); }
            if (tt == 0) { GamC[j2] = __expf(ct0); GamC[j2 + 1] = __expf(ct1); }
        }
        LDS_BARRIER();
        u32x2 vmB = {0u, 0u};
        {   const int r = lane & 15, q = lane >> 4; const f32x4 z4 = {0.f, 0.f, 0.f, 0.f};
            f32x4 NT = z4, Nn = z4, ArbT = z4;
#pragma unroll
            for (int ks = 0; ks < 2; ++ks) { const bf16x8 fb = *(const LAS bf16x8*)(Bt + r * 72 + ks * 32 + q * 8), fk = *(const LAS bf16x8*)(KKh + r * 72 + ks * 32 + q * 8), fr = *(const LAS bf16x8*)(Rh + r * 72 + ks * 32 + q * 8);
                NT = MF(fb, fk, NT); Nn = MF(fk, fb, Nn); ArbT = MF(fb, fr, ArbT); }
#pragma unroll
            for (int i = 0; i < 4; ++i) { const int rr = 4 * q + i; NT[i] = (rr < r) ? NT[i] : 0.f; Nn[i] = (r < rr) ? Nn[i] : 0.f; ArbT[i] = (rr <= r) ? ArbT[i] : 0.f; }
            const f32x4 N2 = MF(pack_lo(NT), pack_lo(Nn), z4), N2T = MF(pack_lo(Nn), pack_lo(NT), z4);
            const f32x4 N4 = MF(pack_lo(N2T), pack_lo(N2), z4), N4T = MF(pack_lo(N2), pack_lo(N2T), z4);
            const f32x4 N8T = MF(pack_lo(N4), pack_lo(N4T), z4);
            const bf16x8 aN8 = pack_lo(N8T), aN4 = pack_lo(N4T), aN2 = pack_lo(N2T), aN1 = pack_lo(-NT);
            if (wave < 4) {
                const int kt = wave; const u32x2 zb = *(const LAS u32x2*)(KKhT + (16 * kt + r) * 24 + 4 * q);
                f32x4 z = {bflo(zb.x), bfhi(zb.x), bflo(zb.y), bfhi(zb.y)};
                z = MF(aN8, pack_lo(z), z); z = MF(aN4, pack_lo(z), z); z = MF(aN2, pack_lo(z), z); z = MF(aN1, pack_lo(z), z);
                const u32x2 rb = *(const LAS u32x2*)(RhT + (16 * kt + r) * 24 + 4 * q); const f32x4 rc = {bflo(rb.x), bfhi(rb.x), bflo(rb.y), bfhi(rb.y)};
                const f32x4 qe = MF(pack_lo(-ArbT), pack_lo(z), rc);
#pragma unroll
                for (int i = 0; i < 4; ++i) { WQ[(4 * q + i) * 72 + 16 * kt + r] = (bf16)f2bf(z[i]); WQ[(16 + 4 * q + i) * 72 + 16 * kt + r] = (bf16)f2bf(qe[i]); }
            } else {
                const int vt = wave - 4; f32x4 AakT = z4, ArkT = z4;
#pragma unroll
                for (int ks = 0; ks < 2; ++ks) { const bf16x8 fkt = *(const LAS bf16x8*)(Kt + r * 72 + ks * 32 + q * 8), fk = *(const LAS bf16x8*)(KKh + r * 72 + ks * 32 + q * 8), fr = *(const LAS bf16x8*)(Rh + r * 72 + ks * 32 + q * 8);
                    AakT = MF(fkt, fk, AakT); ArkT = MF(fkt, fr, ArkT); }
#pragma unroll
                for (int i = 0; i < 4; ++i) { const int rr = 4 * q + i; AakT[i] = (rr < r) ? AakT[i] : 0.f; ArkT[i] = (rr <= r) ? ArkT[i] : 0.f; }
                vmB = *(const LAS u32x2*)(VmT + (16 * vt + r) * 24 + 4 * q);
                f32x4 z = MF(pack_lo(AakT), cat8(vmB, (u32x2){0u, 0u}), z4);
                z = MF(aN8, pack_lo(z), z); z = MF(aN4, pack_lo(z), z); z = MF(aN2, pack_lo(z), z); z = MF(aN1, pack_lo(z), z);
                const f32x4 yl_ = MF(pack2(ArkT, -ArbT), cat8(vmB, pack4(z)), z4);
                st_wt8(bp + RWB_W2 + (vt * 64 + lane) * 8, pack4(z)); st_wt8(bp + RWB_YL + (vt * 64 + lane) * 8, pack4(yl_));
            }
        }
        LDS_BARRIER();
        {
            { const int row = tidl >> 4, pc = tidl & 15, rr = row & 15, half = row >> 4, ks = pc >> 3, hi = (pc >> 2) & 1, qq = pc & 3;
              st_wt8(bp + RWB_WQ + (((2 * ks + half) * 64 + qq * 16 + rr) * 2 + hi) * 8, *(const LAS u32x2*)(WQ + row * 72 + pc * 4)); }
            for (int idx = tidl; idx < 768; idx += NTHR) { const int arr = idx >> 8, pi = idx & 255, row = pi >> 2, pc = pi & 3; const LAS bf16* src = (arr == 0 ? BbarT : arr == 1 ? KbarT : VmT) + row * 24 + pc * 4;
                const int ln = pc * 16 + (row & 15), t4 = row >> 4;
                st_wt8(bp + (arr < 2 ? RWB_BB + ((t4 * 64 + ln) * 2 + arr) * 8 : RWB_VM + (t4 * 64 + ln) * 8), *(const LAS u32x2*)src); }
            if (tidl < 32) st_wt8(bp + RWB_GC + tidl * 8, *(const LAS u32x2*)(GamC + tidl * 2));
            if (tidl < 256) { const int t = tidl >> 4, v4 = (tidl & 15) * 4; const f32x4 g4 = *(const LAS f32x4*)(G + t * 64 + v4); const f32x4 v4f = *(const LAS f32x4*)(V + t * 64 + v4); const float rkt = RK[t];
                st_wt8(bp + RWB_G + (t * 64 + v4) * 2, pack4(g4)); st_wt8(bp + RWB_BON + (t * 64 + v4) * 2, pack4(v4f * rkt)); }
        }
        LDS_BARRIER();
    }
    asm volatile("s_waitcnt vmcnt(0)" ::: "memory");
    __syncthreads();
    if (tid == 0) __hip_atomic_fetch_add(ctl + CW_RWP + l * 4096 + (seq * 8 + slab) * 16, 1u, RLX_AGENT);
    }
}
struct RwOps { u32x4 w[4]; u32x4 bk[4]; u32x2 vm, w2, yl; f32x4 gc[4]; };
__device__ __forceinline__ void rw_ops_load(RwOps& o, const unsigned char* bp, int vt, int r, int q, int lane) {
#pragma unroll
    for (int f = 0; f < 4; ++f) { o.w[f] = *(const u32x4*)(bp + RWB_WQ + (f * 64 + lane) * 16); o.bk[f] = *(const u32x4*)(bp + RWB_BB + (f * 64 + lane) * 16); o.gc[f] = *(const f32x4*)(bp + RWB_GC + (16 * f + 4 * q) * 4); }
    o.vm = *(const u32x2*)(bp + RWB_VM + (vt * 64 + lane) * 8); o.w2 = *(const u32x2*)(bp + RWB_W2 + (vt * 64 + lane) * 8); o.yl = *(const u32x2*)(bp + RWB_YL + (vt * 64 + lane) * 8);
}
__device__ __forceinline__ void rw_ops_load_lds(RwOps& o, const LAS unsigned char* sp, int vt, int q, int lane) {
#pragma unroll
    for (int f = 0; f < 4; ++f) { o.w[f] = *(const LAS u32x4*)(sp + RWB_WQ + (f * 64 + lane) * 16); o.bk[f] = *(const LAS u32x4*)(sp + RWB_BB + (f * 64 + lane) * 16); o.gc[f] = *(const LAS f32x4*)(sp + RWB_GC + (16 * f + 4 * q) * 4); }
    o.vm = *(const LAS u32x2*)(sp + RWB_VM + (vt * 64 + lane) * 8); o.w2 = *(const LAS u32x2*)(sp + RWB_W2 + (vt * 64 + lane) * 8); o.yl = *(const LAS u32x2*)(sp + RWB_YL + (vt * 64 + lane) * 8);
}
constexpr int RWL_N = 6, RWL_D = 6, RWL_SLOT = 20480;
static_assert(8192 + RWL_N * RWL_SLOT <= 131072, "consumer LDS ring");
__device__ __forceinline__ void rwkv_consumer(const Params& P, int l, int b, int hd, LAS unsigned char* lds, int tid, int lane, int wave) {
    LAS float* Yb = (LAS float*)lds;
    LAS unsigned char* ring = lds + 8192;
    unsigned* ctl = (unsigned*)(P.ws + WS_CTL); const int seq = b * 4 + hd;
    unsigned* prod = ctl + CW_RWP + l * 4096 + seq * 8 * 16; unsigned* cons = ctl + CW_RWC + l * 1024 + seq * 16; unsigned* tmo = ctl + CW_TMO;
    bf16* mix = (bf16*)(P.ws + WS_MIX);
    const int r = lane & 15, q = lane >> 4, vt = wave & 3;
    f32x4 st[4];
#pragma unroll
    for (int i = 0; i < 4; ++i) st[i] = (f32x4){0.f, 0.f, 0.f, 0.f};
    const int ot = (tid >> 4) & 15, ov4 = (tid & 15) * 4;
    f32x4 lnw = *(const f32x4*)(P.in[I_RLNW] + l * 256 + hd * 64 + ov4), lnb = *(const f32x4*)(P.in[I_RLNB] + l * 256 + hd * 64 + ov4);
    if (wave == 0) { wait_ge(prod, (unsigned)RW_RUN, tmo); __builtin_amdgcn_fence(__ATOMIC_ACQUIRE, "agent"); asm volatile("s_waitcnt vmcnt(0)" ::: "memory"); }
    __syncthreads();
    RwOps opA, opB; u32x2 gA = {0u, 0u}, bA = gA, gB = gA, bB = gA;
#define RW_DMA(X, SL) do { const unsigned char* bp_ = rw_bundle(P, seq, (X)); LAS unsigned char* sl_ = ring + (SL) * RWL_SLOT; \
        _Pragma("unroll") for (int rd = 0; rd < 5; ++rd) __builtin_amdgcn_global_load_lds((const unsigned*)(bp_ + (size_t)(rd * 256 + wave * 64 + lane) * 16), (LAS unsigned*)(sl_ + (rd * 256 + wave * 64) * 16), 16, 0, 0); } while (0)
    if (wave < 4) {
#pragma unroll
        for (int x = 0; x < RWL_D; ++x) RW_DMA(x, x); }
    asm volatile("s_waitcnt vmcnt(0)" ::: "memory");
    __syncthreads();
    if (wave >= 4) { rw_ops_load_lds(opA, ring, vt, q, lane); rw_ops_load_lds(opB, ring + RWL_SLOT, vt, q, lane); }
    else { gA = *(const LAS u32x2*)(ring + RWB_G + (ot * 64 + ov4) * 2); bA = *(const LAS u32x2*)(ring + RWB_BON + (ot * 64 + ov4) * 2); PIN4(lnw); PIN4(lnb); }
    u32x2* const dummy = (u32x2*)(P.ws + WS_LG) + tid;
#define RW_OUT(cp, GG, BN, DST) do { \
        const f32x4 y = *(const LAS f32x4*)(Yb + ((cp) & 1) * 1024 + ot * 64 + ov4); \
        const float mean = row16_sum((y[0] + y[1]) + (y[2] + y[3])) * (1.f / 64.f); const f32x4 d = y - mean; \
        const float var = row16_sum((d[0] * d[0] + d[1] * d[1]) + (d[2] * d[2] + d[3] * d[3])) * (1.f / 64.f); const float rs = __builtin_amdgcn_rsqf(var + 64e-5f); \
        const f32x4 o = (d * rs * lnw + lnb + (BN)) * (GG); \
        *(DST) = pack4(o); } while (0)
#define RW_SLABCHK(c) do { if ((((c) + RWL_D) & 63) == 0 && (c) + RWL_D < T / 16) { \
            if (wave == 0) { wait_ge(prod + (((c) + RWL_D) >> 6) * 16, (unsigned)RW_RUN, tmo); __builtin_amdgcn_fence(__ATOMIC_ACQUIRE, "agent"); asm volatile("s_waitcnt vmcnt(0)" ::: "memory"); } \
            __syncthreads(); } } while (0)
#define RW_REC(c, OP) do { RW_SLABCHK(c); \
            f32x4 d1 = {0.f, 0.f, 0.f, 0.f}, d2 = {0.f, 0.f, 0.f, 0.f}; \
            _Pragma("unroll") for (int ks = 0; ks < 2; ++ks) { const bf16x8 bS = pack2(st[2 * ks], st[2 * ks + 1]); d1 = MF(__builtin_bit_cast(bf16x8, OP.w[2 * ks]), bS, d1); d2 = MF(__builtin_bit_cast(bf16x8, OP.w[2 * ks + 1]), bS, d2); } \
            const f32x4 w2f = {bflo(OP.w2.x), bfhi(OP.w2.x), bflo(OP.w2.y), bfhi(OP.w2.y)}, ylf = {bflo(OP.yl.x), bfhi(OP.yl.x), bflo(OP.yl.y), bfhi(OP.yl.y)}; \
            const f32x4 un = -(d1 + w2f), yv = d2 + ylf; \
            LAS float* Y = Yb + ((c) & 1) * 1024; \
            _Pragma("unroll") for (int i = 0; i < 4; ++i) Y[(4 * q + i) * 64 + 16 * vt + r] = yv[i]; \
            const bf16x8 bUV = cat8(pack4(un), OP.vm); \
            _Pragma("unroll") for (int kt = 0; kt < 4; ++kt) st[kt] = MF(__builtin_bit_cast(bf16x8, OP.bk[kt]), bUV, st[kt] * OP.gc[kt]); \
            { const int cl_ = (c) + 2 < T / 16 ? (c) + 2 : T / 16 - 1; rw_ops_load_lds(OP, ring + (cl_ % RWL_N) * RWL_SLOT, vt, q, lane); } \
            LDS_BARRIER(); } while (0)
#define RW_OSTEP(c, GP, BP) do { RW_SLABCHK(c); \
            const f32x4 gg = {bflo(GP.x), bfhi(GP.x), bflo(GP.y), bfhi(GP.y)}, bn = {bflo(BP.x), bfhi(BP.x), bflo(BP.y), bfhi(BP.y)}; \
            { const int cn_ = (c) + 1 < T / 16 ? (c) + 1 : T / 16 - 1; const LAS unsigned char* sp_ = ring + (cn_ % RWL_N) * RWL_SLOT; GP = *(const LAS u32x2*)(sp_ + RWB_G + (ot * 64 + ov4) * 2); BP = *(const LAS u32x2*)(sp_ + RWB_BON + (ot * 64 + ov4) * 2); } \
            u32x2* dst_ = ((c) > 0) ? (u32x2*)(mix + ((size_t)b * T + ((c) - 1) * 16 + ot) * D + 512 + hd * 64 + ov4) : dummy; \
            RW_OUT((c) - 1, gg, bn, dst_); \
              \
            { const int cd_ = (c) + RWL_D < T / 16 ? (c) + RWL_D : T / 16 - 1; RW_DMA(cd_, ((c) + RWL_D) % RWL_N); asm volatile("s_waitcnt vmcnt(18)" ::: "memory"); } \
            LDS_BARRIER(); \
            if (((c) & 63) == 2 && (c) > 2 && tid == 0) { const unsigned cv_ = (unsigned)((c) >> 6);        \
                asm volatile("global_store_dword %0, %1, off sc1" :: "v"(cons), "v"(cv_) : "memory"); } } while (0)
    if (wave >= 4) {
#pragma unroll 1
        for (int c2 = 0; c2 < T / 16; c2 += 2) { RW_REC(c2, opA); RW_REC(c2 + 1, opB); }
    } else {
#pragma unroll 1
        for (int c2 = 0; c2 < T / 16; c2 += 2) { RW_OSTEP(c2, gB, bB); RW_OSTEP(c2 + 1, gA, bA); }
        const f32x4 gg = {bflo(gB.x), bfhi(gB.x), bflo(gB.y), bfhi(gB.y)}, bn = {bflo(bB.x), bfhi(bB.x), bflo(bB.y), bfhi(bB.y)};
        RW_OUT(T / 16 - 1, gg, bn, (u32x2*)(mix + ((size_t)b * T + (T / 16 - 1) * 16 + ot) * D + 512 + hd * 64 + ov4));
    }
#undef RW_SLABCHK
#undef RW_REC
#undef RW_OSTEP
#undef RW_OUT
#undef RW_DMA
    asm volatile("s_waitcnt vmcnt(0)" ::: "memory");
    __syncthreads();
}

__device__ __forceinline__ int lds_add(LAS int* p, int v) { return __hip_atomic_fetch_add(p, v, __ATOMIC_RELAXED, __HIP_MEMORY_SCOPE_WORKGROUP); }
__device__ __forceinline__ void ph_fin(const Params& P, int l, int lane, int wave) {
    const bf16* mix = (const bf16*)(P.ws + WS_MIX); bf16* act = (bf16*)(P.ws + WS_ACT); const float* gain = P.in[I_MGAIN] + (size_t)l * D;
    const int gw = blockIdx.x * NWAVES + wave, NGW = gridDim.x * NWAVES;
    const f32x4* gp = (const f32x4*)(gain + lane * 16); const f32x4 g0 = gp[0], g1 = gp[1], g2 = gp[2], g3 = gp[3];
#pragma unroll 1
    for (int m0 = gw * 4; m0 < NTOK; m0 += NGW * 4) {
        u32x4 ra[4], rb[4];
#pragma unroll
        for (int k = 0; k < 4; ++k) { ra[k] = ldg16(mix + (size_t)(m0 + k) * D + lane * 16); rb[k] = ldg16(mix + (size_t)(m0 + k) * D + lane * 16 + 8); }
#pragma unroll
        for (int k = 0; k < 4; ++k) { float v[16]; { float a[8], b2[8]; unpack8(ra[k], a); unpack8(rb[k], b2);
#pragma unroll
                for (int i = 0; i < 8; ++i) { v[i] = a[i]; v[8 + i] = b2[i]; } }
            float s2 = 0.f;
#pragma unroll
            for (int i = 0; i < 16; ++i) s2 += v[i] * v[i];
            s2 = row16_sum(s2);
            const float rstd = 1.f / sqrtf(s2 * (1.f / 256.f) + 1e-6f); u32x4 w0, w1;
            w0.x = cvt2(v[0] * rstd * g0.x, v[1] * rstd * g0.y); w0.y = cvt2(v[2] * rstd * g0.z, v[3] * rstd * g0.w); w0.z = cvt2(v[4] * rstd * g1.x, v[5] * rstd * g1.y); w0.w = cvt2(v[6] * rstd * g1.z, v[7] * rstd * g1.w);
            w1.x = cvt2(v[8] * rstd * g2.x, v[9] * rstd * g2.y); w1.y = cvt2(v[10] * rstd * g2.z, v[11] * rstd * g2.w); w1.z = cvt2(v[12] * rstd * g3.x, v[13] * rstd * g3.y); w1.w = cvt2(v[14] * rstd * g3.z, v[15] * rstd * g3.w);
            *(u32x4*)(act + (size_t)(m0 + k) * D + lane * 16) = w0; *(u32x4*)(act + (size_t)(m0 + k) * D + lane * 16 + 8) = w1; }
    }
}
__device__ __forceinline__ void ph_route(const Params& P, int l, LAS unsigned char* lds, int tid, int lane, int wave) {
    LAS int* hist = (LAS int*)(lds + LDS_MISC + 256);
    unsigned char* wl = P.ws + WS_W + (size_t)l * WL_STRIDE;
    pg8::StaticOrder S; S.init(NTOK / 256, 1, gridDim.x, blockIdx.x);
    { pg8::Gemm g{(const bf16*)P.out, (const bf16*)(wl + WO_RT), NTOK, 256, D, nullptr, 0, HP}; pg8::EpiLogits E{(float*)(P.ws + WS_LG)};
      pg8::gemm_phase<pg8::EpiLogits, pg8::StaticOrder, true, true>(lds, g, S, E); }
    bf16* act = (bf16*)(P.ws + WS_ACT); int* route = (int*)(P.ws + WS_ROUTE); int* tcnt = (int*)(P.ws + WS_TCNT);
    const float* n2 = P.in[I_NORM2] + (size_t)l * D; const float* cb = P.in[I_MCB] + l * 4; const float* fbias = P.in[I_MFB] + l * 32;
    LAS float* rsl = (LAS float*)lds;
    f32x4 gn[4];
#pragma unroll
    for (int j = 0; j < 4; ++j) gn[j] = *((const f32x4*)n2 + lane + 64 * j);
    for (int ui = 0; ; ++ui) {
    pg8::Unit un; if (!S.next(ui, un)) break;
    const int tile = un.pm;
    if (tid < NEXP) hist[tid] = 0;
    { const int mb = tile * 256 + wave * 32; u32x2 va[4], vb[4];
#define RT_LOAD(V, mm) do { const u32x2* hr_ = (const u32x2*)((const bf16*)P.out + (size_t)(mm) * HP) + lane; _Pragma("unroll") for (int j = 0; j < 4; ++j) V[j] = hr_[64 * j]; } while (0)
#define RT_ROW(V, kk) do { f32x4 v[4]; float s_ = 0.f; \
        _Pragma("unroll") for (int j = 0; j < 4; ++j) { v[j] = (f32x4){bflo(V[j].x), bfhi(V[j].x), bflo(V[j].y), bfhi(V[j].y)}; s_ += (v[j].x * v[j].x + v[j].y * v[j].y) + (v[j].z * v[j].z + v[j].w * v[j].w); } \
        if ((kk) + 2 < 32) RT_LOAD(V, mb + (kk) + 2); \
        const float rstd = 1.f / sqrtf(wave_sum(s_) * (1.f / D) + 1e-6f); if (lane == 0) rsl[wave * 32 + (kk)] = rstd; \
        unsigned* o4 = (unsigned*)((unsigned char*)act + (size_t)(mb + (kk)) * D) + lane; \
        _Pragma("unroll") for (int j = 0; j < 4; ++j) { const f32x4 g = gn[j]; int w8 = 0; w8 = __builtin_amdgcn_cvt_pk_fp8_f32(pg8::sat8(v[j].x * rstd * g.x), pg8::sat8(v[j].y * rstd * g.y), w8, false); w8 = __builtin_amdgcn_cvt_pk_fp8_f32(pg8::sat8(v[j].z * rstd * g.z), pg8::sat8(v[j].w * rstd * g.w), w8, true); o4[64 * j] = (unsigned)w8; } } while (0)
      RT_LOAD(va, mb); RT_LOAD(vb, mb + 1);
#pragma unroll 1
      for (int k = 0; k < 32; k += 2) { RT_ROW(va, k); RT_ROW(vb, k + 1); }
#undef RT_LOAD
#undef RT_ROW
    }
    __syncthreads();
    if (tid < 256) { const int m = tile * 256 + tid; const float rstd = rsl[tid];
        const f32x4* lp = (const f32x4*)((const float*)(P.ws + WS_LG) + (size_t)m * 72); f32x4 q[18];
#pragma unroll
        for (int i = 0; i < 18; ++i) q[i] = lp[i];
        float L[36];
#pragma unroll
        for (int j = 0; j < 36; ++j) L[j] = (q[j >> 2][j & 3] + q[(36 + j) >> 2][(36 + j) & 3]) * rstd + (j < 4 ? cb[j] : fbias[j - 4]);
        const float c0 = L[0], c1 = L[1], c2 = L[2], c3 = L[3];
        int gs = 0; float cm = c0; if (c1 > cm) { cm = c1; gs = 1; } if (c2 > cm) { cm = c2; gs = 2; } if (c3 > cm) { cm = c3; gs = 3; }
        const float pg = 1.f / (expf(c0 - cm) + expf(c1 - cm) + expf(c2 - cm) + expf(c3 - cm));
        float fa[8];
#pragma unroll
        for (int i = 0; i < 8; ++i) fa[i] = (gs == 0) ? L[4 + i] : (gs == 1) ? L[12 + i] : (gs == 2) ? L[20 + i] : L[28 + i];
        int i0 = 0; float m0 = fa[0];
#pragma unroll
        for (int i = 1; i < 8; ++i) if (fa[i] > m0) { m0 = fa[i]; i0 = i; }
        int i1 = (i0 == 0) ? 1 : 0; float m1 = -3.0e38f;
#pragma unroll
        for (int i = 0; i < 8; ++i) if (i != i0 && fa[i] > m1) { m1 = fa[i]; i1 = i; }
        const float e1w = expf(m1 - m0), w0 = pg / (1.f + e1w), w1 = pg * e1w / (1.f + e1w);
        const int e0 = gs * 8 + i0, e1 = gs * 8 + i1;
        typedef int i32x4 __attribute__((ext_vector_type(4)));
        *(i32x4*)(route + (size_t)m * 8) = (i32x4){e0, e1, __builtin_bit_cast(int, w0), __builtin_bit_cast(int, w1)};
        lds_add(&hist[e0], 1); lds_add(&hist[e1], 1); }
    __syncthreads();
    if (tid < NEXP) { tcnt[tile * 32 + tid] = hist[tid]; atomicAdd((unsigned*)(P.ws + WS_CTL) + CW_CNT + l * 64 + tid, (unsigned)hist[tid]); }
    __syncthreads();
    }
}
__device__ __forceinline__ int build_tiles(const Params& P, int l, LAS unsigned char* ldsall, int tid) {
    LAS int* tile_e = (LAS int*)(ldsall + LDS_TILE_E); LAS int* misc = (LAS int*)(ldsall + LDS_MISC);
    LAS int* ntl = (LAS int*)(ldsall + LDS_MISC + 512);
    if (tid < NEXP) { const unsigned* cnt = (const unsigned*)(P.ws + WS_CTL) + CW_CNT + l * 64; const int c = (int)__hip_atomic_load(cnt + tid, __ATOMIC_RELAXED, __HIP_MEMORY_SCOPE_AGENT); ntl[tid] = (c + 255) >> 8; }
    __syncthreads();
    if (tid < NEXP) { int r = 0; for (int e = 0; e < tid; ++e) r += ntl[e];
        const int nt = ntl[tid]; r = r < MAXTILES ? r : MAXTILES; misc[1 + tid] = r * 256;
        for (int q = 0; q < nt && r + q < MAXTILES; ++q) tile_e[r + q] = tid;
        if (tid == NEXP - 1) misc[0] = (r + nt < MAXTILES) ? r + nt : MAXTILES; }
    __syncthreads();
    return misc[0];
}
__device__ __forceinline__ void ph_scatter(const Params& P, int l, LAS unsigned char* ldsall, int tid, int lane, int wave) {
    build_tiles(P, l, ldsall, tid);
    LAS int* misc = (LAS int*)(ldsall + LDS_MISC); LAS int* base = (LAS int*)ldsall; LAS int* EL = base + 32; LAS int* POS = EL + 512; LAS int* part = POS + 512;
    int* route = (int*)(P.ws + WS_ROUTE); const int* tcnt = (const int*)(P.ws + WS_TCNT); int* rowsrc = (int*)(P.ws + WS_TCNT + 65536);
    for (int tile = blockIdx.x; tile < NTOK / 256; tile += gridDim.x) {
        { const int e = tid & 31, q = tid >> 5; int c[16];
#pragma unroll
          for (int i = 0; i < 16; ++i) { const int t2 = q + 16 * i; c[i] = (t2 < tile) ? tcnt[t2 * 32 + e] : 0; }
          int s = 0;
#pragma unroll
          for (int i = 0; i < 16; ++i) s += c[i];
          part[q * 32 + e] = s; }
        int e0 = 0, e1 = 0; const size_t tok = (size_t)tile * 256 + tid;
        if (tid < 256) { e0 = route[tok * 8]; e1 = route[tok * 8 + 1]; EL[tid * 2] = e0; EL[tid * 2 + 1] = e1; }
        __syncthreads();
        if (tid < 32) { int s = misc[1 + tid]; for (int q = 0; q < 16; ++q) s += part[q * 32 + tid]; base[tid] = s; }
        __syncthreads();
        if (tid < 256) { int r0 = 0, r1 = 0;
            for (int i = 0; i < 2 * tid; ++i) { const int e = EL[i]; r0 += (e == e0); r1 += (e == e1); }
            const int p0 = base[e0] + r0, p1 = base[e1] + r1;
            route[tok * 8 + 4] = p0; route[tok * 8 + 5] = p1; rowsrc[p0] = (int)tok; rowsrc[p1] = (int)tok; }
        __syncthreads();
        __syncthreads();
    }
}
__device__ __forceinline__ void cb_load(const Params& P, const unsigned char* ys, int m, int p0, int p1, int lane, u32x2 (&h)[4], unsigned (&a)[4], unsigned (&b2)[4]) {
    const u32x2* hr = (const u32x2*)((const bf16*)P.out + (size_t)m * HP) + lane; const unsigned* y0 = (const unsigned*)(ys + (size_t)p0 * D) + lane; const unsigned* y1 = (const unsigned*)(ys + (size_t)p1 * D) + lane;
#pragma unroll
    for (int j = 0; j < 4; ++j) { h[j] = hr[64 * j]; a[j] = y0[64 * j]; b2[j] = y1[64 * j]; }
}
__device__ __forceinline__ void ph_combine(const Params& P, int l, int lane, int wave) {
    const unsigned char* ys = (const unsigned char*)(P.ws + WS_PROJ); bf16* act = (bf16*)(P.ws + WS_ACT); const int* route = (const int*)(P.ws + WS_ROUTE);
    const float* gain = (l + 1 < NL) ? P.in[I_NORM1] + (size_t)(l + 1) * D : P.in[I_FNW];
    f32x4 gn[4];
#pragma unroll
    for (int j = 0; j < 4; ++j) gn[j] = *((const f32x4*)gain + lane + 64 * j);
    for (int tile = blockIdx.x; tile < NTOK / 256; tile += gridDim.x) {
        const int mb = tile * 256 + wave * 32;
        const int* rp = route + (size_t)(mb + (lane & 31)) * 8; const int rw0 = rp[2], rw1 = rp[3], rp0 = rp[4], rp1 = rp[5];
        u32x2 nh[4]; unsigned na[4], nb[4];
        cb_load(P, ys, mb, __builtin_amdgcn_readlane(rp0, 0), __builtin_amdgcn_readlane(rp1, 0), lane, nh, na, nb);
#pragma unroll 1
        for (int k = 0; k < 32; ++k) {
            const int m = mb + k; f32x4 v[4]; unsigned a[4], b2[4];
#pragma unroll
            for (int j = 0; j < 4; ++j) { v[j] = (f32x4){bflo(nh[j].x), bfhi(nh[j].x), bflo(nh[j].y), bfhi(nh[j].y)}; a[j] = na[j]; b2[j] = nb[j]; }
            const float w0 = __builtin_bit_cast(float, __builtin_amdgcn_readlane(rw0, k)) * 0.0625f, w1 = __builtin_bit_cast(float, __builtin_amdgcn_readlane(rw1, k)) * 0.0625f;
            if (k + 1 < 32) cb_load(P, ys, m + 1, __builtin_amdgcn_readlane(rp0, k + 1), __builtin_amdgcn_readlane(rp1, k + 1), lane, nh, na, nb);
            float s2 = 0.f;
#pragma unroll
            for (int j = 0; j < 4; ++j) { const f32x2 a01 = __builtin_amdgcn_cvt_pk_f32_fp8((int)a[j], false), a23 = __builtin_amdgcn_cvt_pk_f32_fp8((int)a[j], true), b01 = __builtin_amdgcn_cvt_pk_f32_fp8((int)b2[j], false), b23 = __builtin_amdgcn_cvt_pk_f32_fp8((int)b2[j], true);
                v[j].x += w0 * a01[0] + w1 * b01[0]; v[j].y += w0 * a01[1] + w1 * b01[1]; v[j].z += w0 * a23[0] + w1 * b23[0]; v[j].w += w0 * a23[1] + w1 * b23[1];
                s2 += (v[j].x * v[j].x + v[j].y * v[j].y) + (v[j].z * v[j].z + v[j].w * v[j].w); }
            const float rstd = 1.f / sqrtf(wave_sum(s2) * (1.f / D) + 1e-6f);
            f32x4* hr = (f32x4*)(P.out + (size_t)m * D) + lane;
            if (l + 1 < NL) { u32x2* o8 = (u32x2*)(act + (size_t)m * D) + lane; u32x2* hb = (u32x2*)((bf16*)P.out + (size_t)m * HP) + lane;
#pragma unroll
                for (int j = 0; j < 4; ++j) { u32x2 hw; hw.x = cvt2(v[j].x, v[j].y); hw.y = cvt2(v[j].z, v[j].w); hb[64 * j] = hw; u32x2 w; w.x = cvt2(v[j].x * rstd * gn[j].x, v[j].y * rstd * gn[j].y); w.y = cvt2(v[j].z * rstd * gn[j].z, v[j].w * rstd * gn[j].w); o8[64 * j] = w; }
            } else {
#pragma unroll
                for (int j = 0; j < 4; ++j) { f32x4 o; o.x = v[j].x * rstd * gn[j].x; o.y = v[j].y * rstd * gn[j].y; o.z = v[j].z * rstd * gn[j].z; o.w = v[j].w * rstd * gn[j].w; hr[64 * j] = o; }
            }
        }
    }
}

#ifndef MK_ONE_LAUNCH
#define MK_ONE_LAUNCH 1
#endif
constexpr int PH_PER_LAYER = 10, N_PHASES = 1 + NL * PH_PER_LAYER;
#ifndef PH_MASK
#ifdef DBG_NOMOE
#define PH_MASK 0x61f
#else
#define PH_MASK 0x7ff
#endif
#endif
#define PHE(j) (((PH_MASK) >> (j)) & 1)
#ifndef DUP_MASK
#define DUP_MASK 0
#endif
#define NREP(j) ((((DUP_MASK) >> (j)) & 1) ? 2 : 1)
#if MK_ONE_LAUNCH
#define GRID_BAR() xcd_barrier(bar)
#else
#define GRID_BAR() do {} while (0)
#endif
#define IN(k) (lo <= (k) && (k) < hi)
#define SEAM(k) do { if (IN(k) && IN((k) + 1)) GRID_BAR(); } while (0)
#ifndef DUP_ROLE
#define DUP_ROLE 0
#endif
#ifndef DUP_N
#define DUP_N 1
#endif
#define MIXBODY() do { \
            const int u_ = blockIdx.x; \
            if (u_ < 32) rwkv_consumer(P, l, u_ >> 2, u_ & 3, lds, tid, lane, wave); \
            else if (u_ < 64) role_hgrn(P, l, (u_ - 32) >> 2, u_ & 3, lds, tid, lane, wave); \
            else if (u_ < 96) { role_lru(P, l, (u_ - 64) >> 2, u_ & 3, lds, tid, lane, wave); __syncthreads(); rwkv_producer(P, l, u_ & 3, 40 + ((u_ - 64) >> 2), 40, lds, tid, lane, wave); } \
            else { rwkv_producer(P, l, (u_ - 96) & 3, (u_ - 96) >> 2, 40, lds, tid, lane, wave);        \
                   if (u_ < 224) { __syncthreads(); role_s5(P, l, (u_ - 96) >> 4, (u_ - 96) & 15, lds, tid, lane, wave); } } \
} while (0)
template <int l> __device__ __forceinline__ void layer_phases(const Params& P, LAS unsigned char* lds, const XcdBarrier& bar, int tid, int lane, int wave, int lo, int hi) {
        const int pb = 1 + l * PH_PER_LAYER;
        const unsigned char* wl = P.ws + WS_W + (size_t)l * WL_STRIDE;
        if (PHE(0) && IN(pb + 0)) {
            pg8::Gemm g{(const bf16*)(P.ws + WS_ACT), (const bf16*)(wl + WO_IN), NTOK, DIN, D}; pg8::StaticOrder S; S.init(NTOK / 256, DIN / 256, gridDim.x, blockIdx.x);
            pg8::EpiBf16 E{(bf16*)(P.ws + WS_PROJ), DIN};
            pg8::gemm_phase<pg8::EpiBf16, pg8::StaticOrder, true, true>(lds, g, S, E);
        } SEAM(pb + 0);
        if (PHE(1) && IN(pb + 1)) {
            MIXBODY();
            if (NREP(1) == 2) { GRID_BAR(); MIXBODY(); }
        } SEAM(pb + 1);
        if (PHE(2) && IN(pb + 2)) {
            pg8::Gemm g{(const bf16*)(P.ws + WS_YG), (const bf16*)(wl + WO_GLU), NTOK, 512, 256}; pg8::StaticOrder S; S.init(NTOK / 256, 2, gridDim.x, blockIdx.x);
            pg8::EpiGated<1> E{(bf16*)(P.ws + WS_MIX) + 256, D};
            pg8::gemm_phase<pg8::EpiGated<1>, pg8::StaticOrder, true, true>(lds, g, S, E);
        } SEAM(pb + 2);
        if (PHE(3) && IN(pb + 3)) { ph_fin(P, l, lane, wave); } SEAM(pb + 3);
        if (PHE(4) && IN(pb + 4)) {
            pg8::Gemm g{(const bf16*)(P.ws + WS_ACT), (const bf16*)(wl + WO_OUT), NTOK, D, D}; pg8::StaticOrder S; S.init(NTOK / 256, D / 256, gridDim.x, blockIdx.x);
            if (l == 0) { pg8::EpiResB<true> E{(bf16*)P.out, (const void*)P.in[I_X], HP, D}; pg8::gemm_phase<pg8::EpiResB<true>, pg8::StaticOrder, true, true>(lds, g, S, E); }
            else { pg8::EpiResB<false> E{(bf16*)P.out, (const void*)P.out, HP, HP}; pg8::gemm_phase<pg8::EpiResB<false>, pg8::StaticOrder, true, true>(lds, g, S, E); }
        } SEAM(pb + 4);
        if (PHE(5) && IN(pb + 5)) { ph_route(P, l, lds, tid, lane, wave); } SEAM(pb + 5);
        if (PHE(6) && IN(pb + 6)) { ph_scatter(P, l, lds, tid, lane, wave); } SEAM(pb + 6);
        if (PHE(7) && IN(pb + 7)) {
            const int R = build_tiles(P, l, lds, tid);
            pg8::Gemm g{(const bf16*)(P.ws + WS_ACT), (const bf16*)(wl + WO_GU), SROWS, D, D / 2  , (const int*)(P.ws + WS_TCNT + 65536), NTOK}; pg8::StaticOrder S; S.init(R, 4, gridDim.x, blockIdx.x);
            S.tile_e = (const LAS int*)(lds + LDS_TILE_E); S.estride = (size_t)D * D;
            pg8::EpiGatedF8 E{(unsigned char*)(P.ws + WS_MIX), DEXP};
            pg8::gemm_phase<pg8::EpiGatedF8, pg8::StaticOrder, true, true, true, true>(lds, g, S, E);
        } SEAM(pb + 7);
        if (PHE(8) && IN(pb + 8)) {
            const int R = build_tiles(P, l, lds, tid);
            pg8::Gemm g{(const bf16*)(P.ws + WS_MIX), (const bf16*)(wl + WO_DN), SROWS, D, DEXP / 2  }; pg8::StaticOrder S; S.init(R, 4, gridDim.x, blockIdx.x);
            S.tile_e = (const LAS int*)(lds + LDS_TILE_E); S.estride = (size_t)D * DEXP;
            pg8::EpiF8 E{(unsigned char*)(P.ws + WS_PROJ), D, 16.f};
            pg8::gemm_phase<pg8::EpiF8, pg8::StaticOrder, true, true, false, true>(lds, g, S, E);
        } SEAM(pb + 8);
        if (PHE(9) && IN(pb + 9)) { ph_combine(P, l, lane, wave); } SEAM(pb + 9);
    }
__global__ void __launch_bounds__(NTHR, 2) fwd_kernel(Params P) {
    extern __shared__ __attribute__((aligned(16))) unsigned char lds_raw[];
    LAS unsigned char* lds = (LAS unsigned char*)lds_raw;
    const int tid = threadIdx.x, lane = tid & 63, wave = __builtin_amdgcn_readfirstlane(tid >> 6);
    if (tid < 16) ((LAS unsigned*)(lds + LDSCTL_OFF))[tid] = 0u;
    __syncthreads();
#if MK_ONE_LAUNCH
    XcdBarrier bar = xcd_barrier_post((unsigned*)(P.ws + WS_CTL) + CW_BAR, (volatile LAS unsigned*)(lds + LDSCTL_OFF));
#else
    XcdBarrier bar; bar.bar = nullptr; bar.x = 0; bar.st = nullptr;
#endif
    const int lo = P.ph_lo, hi = P.ph_hi;
    if (PHE(10) && IN(0)) { ph_prologue(P, lds, tid, lane, wave); } SEAM(0);
    layer_phases<0>(P, lds, bar, tid, lane, wave, lo, hi);
    layer_phases<1>(P, lds, bar, tid, lane, wave, lo, hi);
}
#undef IN
#undef SEAM

extern "C" void kernel_launch(void* const* d_in, const int* in_sizes, int n_in, void* d_out, int out_size, void* d_ws, size_t ws_size, hipStream_t stream) {
    static int grid = 0;
    if (grid == 0) {
        if (n_in != 46 || out_size != NTOK * D || ws_size < WS_END) { fprintf(stderr, "kernel_launch: unexpected sizes n_in %d out %d ws %zu\n", n_in, out_size, ws_size); grid = -1; return; }
        int dev = 0, cus = 0;
        if (hipGetDevice(&dev) != hipSuccess || hipDeviceGetAttribute(&cus, hipDeviceAttributeMultiprocessorCount, dev) != hipSuccess) { grid = -1; return; }
        if (hipFuncSetAttribute((const void*)fwd_kernel, hipFuncAttributeMaxDynamicSharedMemorySize, LDS_BYTES) != hipSuccess) { grid = -1; return; }
        int per_cu = 0;
        if (hipOccupancyMaxActiveBlocksPerMultiprocessor(&per_cu, (const void*)fwd_kernel, NTHR, LDS_BYTES) != hipSuccess || per_cu < 1) { fprintf(stderr, "kernel_launch: occupancy query says %d\n", per_cu); }
        (void)hipGetLastError();
        (void)cus; grid = 256;
    }
    if (grid < 0) return;
    if (hipMemsetAsync((char*)d_ws + WS_CTL, 0, CTL_ZERO_BYTES, stream) != hipSuccess) return;
    Params p; memset(&p, 0, sizeof(p));
    for (int i = 0; i < 46; ++i) p.in[i] = (const float*)d_in[i];
    p.out = (float*)d_out; p.ws = (unsigned char*)d_ws;
#if MK_ONE_LAUNCH
    p.ph_lo = 0; p.ph_hi = N_PHASES;
    hipLaunchKernelGGL(fwd_kernel, dim3(grid), dim3(NTHR), LDS_BYTES, stream, p);
#else
    for (int k = 0; k < N_PHASES; ++k) { p.ph_lo = k; p.ph_hi = k + 1; hipLaunchKernelGGL(fwd_kernel, dim3(grid), dim3(NTHR), LDS_BYTES, stream, p); }
#endif
}
```

```cpp
#include <hip/hip_runtime.h>
#include <cstdio>
#include <cstdint>
#include <cstring>

#define LAS __attribute__((address_space(3)))
#define GAS __attribute__((address_space(1)))

namespace pg8 {
#define PG8_LAS __attribute__((address_space(3)))
typedef unsigned short bf16_t;
typedef short bf16x8 __attribute__((ext_vector_type(8)));
typedef float f32x4 __attribute__((ext_vector_type(4)));
typedef unsigned u32x4 __attribute__((ext_vector_type(4)));
typedef int v8i __attribute__((ext_vector_type(8)));
constexpr int BM = 256, BK = 64, HALF = 128, HTB = HALF * BK * 2  , STAGE_BYTES = 8 * HTB, NXCD = 8, WGM = 8;

__host__ __device__ __forceinline__ int lds_byte(int r, int c) { const int st = (r >> 4) * 2 + (c >> 5), rr = r & 15, cc = c & 31, ob = rr * 64 + cc * 2; return st * 1024 + (ob ^ (((ob >> 9) & 1) << 5)); }
__host__ __device__ __forceinline__ void stage_rc(int b, int& R, int& C) { const int st = b / 1024, sb = b % 1024, swz = sb ^ (((sb >> 9) & 1) << 5); R = (st >> 1) * 16 + swz / 64; C = (st & 1) * 32 + (swz % 64) / 2; }
__host__ __device__ __forceinline__ int perm32(int rho) { const int n = rho >> 4, i = rho & 15; return 8 * (i >> 2) + 4 * n + (i & 3); }

struct Unit { int pm, pn; };
struct Gemm { const bf16_t* A; const bf16_t* Bt; int M, N, K; const int* rowsrc; int nsrc; int lda; };

struct StaticOrder {
    int nM, nN, nwg, G, c; const PG8_LAS int* tile_e; size_t estride;
    __device__ void init(int nM_, int nN_, int G_, int c_) { nM = nM_; nN = nN_; nwg = nM * nN; G = G_; c = c_; tile_e = nullptr; estride = 0; }
    __device__ bool next(int i, Unit& u) const {
        const long L = (long)i * G + c; if (L >= nwg) return false;
        int wgid = (int)L; { const int q = nwg / NXCD, r = nwg % NXCD, xcd = wgid % NXCD, off = wgid / NXCD; wgid = (xcd < r ? xcd * (q + 1) : r * (q + 1) + (xcd - r) * q) + off; }
        const int nig = WGM * nN, gid = wgid / nig, fm = gid * WGM, gsz = (nM - fm) < WGM ? (nM - fm) : WGM;
        u.pm = fm + ((wgid % nig) % gsz); u.pn = (wgid % nig) / gsz; return true;
    }
    __device__ __forceinline__ size_t boff(const Unit& u, size_t tstep) const { return (size_t)u.pn * tstep + (tile_e ? (size_t)tile_e[u.pm] * estride : (size_t)0); }
    __device__ __forceinline__ void a_ready(const Unit&) const {}
    __device__ __forceinline__ void done(const Unit&) const {}
};

__device__ __forceinline__ unsigned cvt_pk_bf16(float lo, float hi) { unsigned r; asm volatile("v_cvt_pk_bf16_f32 %0, %1, %2" : "=v"(r) : "v"(lo), "v"(hi)); return r; }

__device__ __forceinline__ float sat8(float x) { return __builtin_amdgcn_fmed3f(x, -448.f, 448.f); }
struct EpiBf16 {
    static constexpr bool PERM = true, AFTER_DRAIN = false;
    bf16_t* O; int ldc;
    __device__ __forceinline__ void operator()(const f32x4 (&acc)[2][2][4][2], const Unit& u, int wr, int wc, int fr, int fq) const {
        const int row0 = u.pm * BM + wr * 64 + fr, col0 = u.pn * BM + wc * 32 + 8 * fq;
#pragma unroll
        for (int ai = 0; ai < 2; ++ai)
#pragma unroll
            for (int m = 0; m < 4; ++m) { bf16_t* rowp = O + (size_t)(row0 + ai * HALF + m * 16) * ldc + col0;
#pragma unroll
                for (int bj = 0; bj < 2; ++bj) { const f32x4 v0 = acc[ai][bj][m][0], v1 = acc[ai][bj][m][1];
                    u32x4 w; w.x = cvt_pk_bf16(v0[0], v0[1]); w.y = cvt_pk_bf16(v0[2], v0[3]); w.z = cvt_pk_bf16(v1[0], v1[1]); w.w = cvt_pk_bf16(v1[2], v1[3]);
                    *(u32x4*)(rowp + bj * HALF) = w; } }
    }
};
struct EpiLogits {
    static constexpr bool PERM = true, AFTER_DRAIN = false;
    float* O;
    __device__ __forceinline__ void operator()(const f32x4 (&acc)[2][2][4][2], const Unit& u, int wr, int wc, int fr, int fq) const {
        const int row0 = u.pm * BM + wr * 64 + fr, col0 = wc * 32 + 8 * fq;
        if (col0 < 72) {
#pragma unroll
            for (int ai = 0; ai < 2; ++ai)
#pragma unroll
                for (int m = 0; m < 4; ++m) { float* rowp = O + (size_t)(row0 + ai * HALF + m * 16) * 72 + col0; *(f32x4*)rowp = acc[ai][0][m][0]; *(f32x4*)(rowp + 4) = acc[ai][0][m][1]; }
        }
    }
};
template <int MODE> struct EpiGated {
    static constexpr bool PERM = true, AFTER_DRAIN = false;
    bf16_t* O; int ldc;
    __device__ __forceinline__ void operator()(const f32x4 (&acc)[2][2][4][2], const Unit& u, int wr, int wc, int fr, int fq) const {
        const int row0 = u.pm * BM + wr * 64 + fr, col0 = u.pn * HALF + wc * 32 + 8 * fq;
#pragma unroll
        for (int ai = 0; ai < 2; ++ai)
#pragma unroll
            for (int m = 0; m < 4; ++m) { bf16_t* rowp = O + (size_t)(row0 + ai * HALF + m * 16) * ldc + col0;
                float o[8];
#pragma unroll
                for (int n = 0; n < 2; ++n)
#pragma unroll
                    for (int j = 0; j < 4; ++j) { const float a = acc[ai][0][m][n][j], b = acc[ai][1][m][n][j];
                        o[n * 4 + j] = (MODE == 0) ? (a / (1.f + __expf(-a))) * b : a / (1.f + __expf(-b)); }
                u32x4 w; w.x = cvt_pk_bf16(o[0], o[1]); w.y = cvt_pk_bf16(o[2], o[3]); w.z = cvt_pk_bf16(o[4], o[5]); w.w = cvt_pk_bf16(o[6], o[7]);
                *(u32x4*)rowp = w; }
    }
};
template <bool RF32> struct EpiResB {
    static constexpr bool PERM = true, AFTER_DRAIN = false;
    bf16_t* C; const void* R; int ldc, ldr;
    __device__ __forceinline__ void operator()(const f32x4 (&acc)[2][2][4][2], const Unit& u, int wr, int wc, int fr, int fq) const {
        const int row0 = u.pm * BM + wr * 64 + fr, col0 = u.pn * BM + wc * 32 + 8 * fq;
#pragma unroll
        for (int ai = 0; ai < 2; ++ai)
#pragma unroll
            for (int m = 0; m < 4; ++m) { const size_t row = (size_t)(row0 + ai * HALF + m * 16);
#pragma unroll
                for (int bj = 0; bj < 2; ++bj) { float r[8];
                    if constexpr (RF32) { const f32x4 a = *(const f32x4*)((const float*)R + row * ldr + col0 + bj * HALF), b = *(const f32x4*)((const float*)R + row * ldr + col0 + bj * HALF + 4);
                        r[0] = a[0]; r[1] = a[1]; r[2] = a[2]; r[3] = a[3]; r[4] = b[0]; r[5] = b[1]; r[6] = b[2]; r[7] = b[3]; }
                    else { const u32x4 w = *(const u32x4*)((const bf16_t*)R + row * ldr + col0 + bj * HALF);
                        r[0] = __builtin_bit_cast(float, w.x << 16); r[1] = __builtin_bit_cast(float, w.x & 0xffff0000u); r[2] = __builtin_bit_cast(float, w.y << 16); r[3] = __builtin_bit_cast(float, w.y & 0xffff0000u);
                        r[4] = __builtin_bit_cast(float, w.z << 16); r[5] = __builtin_bit_cast(float, w.z & 0xffff0000u); r[6] = __builtin_bit_cast(float, w.w << 16); r[7] = __builtin_bit_cast(float, w.w & 0xffff0000u); }
                    const f32x4 v0 = acc[ai][bj][m][0], v1 = acc[ai][bj][m][1];
                    u32x4 o; o.x = cvt_pk_bf16(v0[0] + r[0], v0[1] + r[1]); o.y = cvt_pk_bf16(v0[2] + r[2], v0[3] + r[3]); o.z = cvt_pk_bf16(v1[0] + r[4], v1[1] + r[5]); o.w = cvt_pk_bf16(v1[2] + r[6], v1[3] + r[7]);
                    *(u32x4*)(C + row * ldc + col0 + bj * HALF) = o; } }
    }
};
struct EpiGatedF8 {
    static constexpr bool PERM = true, AFTER_DRAIN = false;
    unsigned char* O; int ldc;
    __device__ __forceinline__ void operator()(const f32x4 (&acc)[2][2][4][2], const Unit& u, int wr, int wc, int fr, int fq) const {
        const int row0 = u.pm * BM + wr * 64 + fr, col0 = u.pn * HALF + wc * 32 + 8 * fq;
#pragma unroll
        for (int ai = 0; ai < 2; ++ai)
#pragma unroll
            for (int m = 0; m < 4; ++m) { unsigned char* rowp = O + (size_t)(row0 + ai * HALF + m * 16) * ldc + col0;
                float o[8];
#pragma unroll
                for (int n = 0; n < 2; ++n)
#pragma unroll
                    for (int j = 0; j < 4; ++j) { const float a = acc[ai][0][m][n][j], b = acc[ai][1][m][n][j]; o[n * 4 + j] = sat8((a / (1.f + __expf(-a))) * b); }
                int w0 = 0, w1 = 0;
                w0 = __builtin_amdgcn_cvt_pk_fp8_f32(o[0], o[1], w0, false); w0 = __builtin_amdgcn_cvt_pk_fp8_f32(o[2], o[3], w0, true);
                w1 = __builtin_amdgcn_cvt_pk_fp8_f32(o[4], o[5], w1, false); w1 = __builtin_amdgcn_cvt_pk_fp8_f32(o[6], o[7], w1, true);
                unsigned long long pk = (unsigned long long)(unsigned)w0 | ((unsigned long long)(unsigned)w1 << 32); *(unsigned long long*)rowp = pk; }
    }
};
struct EpiF8 {
    static constexpr bool PERM = true, AFTER_DRAIN = false;
    unsigned char* O; int ldc; float sc;
    __device__ __forceinline__ void operator()(const f32x4 (&acc)[2][2][4][2], const Unit& u, int wr, int wc, int fr, int fq) const {
        const int row0 = u.pm * BM + wr * 64 + fr, col0 = u.pn * BM + wc * 32 + 8 * fq;
#pragma unroll
        for (int ai = 0; ai < 2; ++ai)
#pragma unroll
            for (int m = 0; m < 4; ++m) { unsigned char* rowp = O + (size_t)(row0 + ai * HALF + m * 16) * ldc + col0;
#pragma unroll
                for (int bj = 0; bj < 2; ++bj) { const f32x4 v0 = acc[ai][bj][m][0] * sc, v1 = acc[ai][bj][m][1] * sc; int w0 = 0, w1 = 0;
                    w0 = __builtin_amdgcn_cvt_pk_fp8_f32(sat8(v0[0]), sat8(v0[1]), w0, false); w0 = __builtin_amdgcn_cvt_pk_fp8_f32(sat8(v0[2]), sat8(v0[3]), w0, true);
                    w1 = __builtin_amdgcn_cvt_pk_fp8_f32(sat8(v1[0]), sat8(v1[1]), w1, false); w1 = __builtin_amdgcn_cvt_pk_fp8_f32(sat8(v1[2]), sat8(v1[3]), w1, true);
                    *(unsigned long long*)(rowp + bj * HALF) = (unsigned long long)(unsigned)w0 | ((unsigned long long)(unsigned)w1 << 32); } }
    }
};
struct EpiResF32 {
    static constexpr bool PERM = false, AFTER_DRAIN = false;
    float* C; const float* R; int ldc;
    __device__ __forceinline__ void operator()(const f32x4 (&acc)[2][2][4][2], const Unit& u, int wr, int wc, int fr, int fq) const {
        const int row0 = u.pm * BM + wr * 64 + fr, col0 = u.pn * BM + wc * 32 + 4 * fq;
#pragma unroll
        for (int ai = 0; ai < 2; ++ai)
#pragma unroll
            for (int m = 0; m < 4; ++m) { const size_t ro = (size_t)(row0 + ai * HALF + m * 16) * ldc + col0;
#pragma unroll
                for (int bj = 0; bj < 2; ++bj)
#pragma unroll
                    for (int n = 0; n < 2; ++n) { const f32x4 r = *(const f32x4*)(R + ro + bj * HALF + n * 16); *(f32x4*)(C + ro + bj * HALF + n * 16) = acc[ai][bj][m][n] + r; } }
    }
};


template <class Epi, class Sched, bool ALIGN_EPI = false, bool SP2 = false, bool GATH = false, bool F8 = false>
__device__ __forceinline__ void gemm_phase(PG8_LAS unsigned char* lds, const Gemm g, const Sched& S, const Epi& E) {
    static_assert(!GATH || SP2, "the gathered-A variant exists for the SP2 loop only");
    const int tid = threadIdx.x, wid = __builtin_amdgcn_readfirstlane(tid >> 6), lane = tid & 63, wr = wid >> 2, wc = wid & 3, fr = lane & 15, fq = lane >> 4;
    const int K = g.K, nt = K / BK, ldA = g.lda ? g.lda : K;
    unsigned voffA[2], voffB[2];
#pragma unroll
    for (int i = 0; i < 2; ++i) { int R, C; stage_rc(tid * 16 + i * 8192, R, C); const int Rb = Epi::PERM ? ((R & ~31) + perm32(R & 31)) : R;
        voffA[i] = (unsigned)(R * ldA + C) * 2u; voffB[i] = (unsigned)(Rb * K + C) * 2u; }
    const size_t kstep = (size_t)(BK * 2);
    const size_t hstep = (size_t)HALF * K * 2;
    const size_t tstep = 2 * hstep;
    const size_t hstepA = (size_t)HALF * ldA * 2, tstepA = 2 * hstepA;
    const unsigned ldsw = (unsigned)wid * 1024u;
    const int aoff = lds_byte(wr * 64 + fr, fq * 8), boff = lds_byte(wc * 32 + fr, fq * 8);
#define PG8_SA(b, h) (((b) * 2 + (h)) * HTB)
#define PG8_SB(b, h) ((4 + (b) * 2 + (h)) * HTB)
#define PG8_STAGE(bufoff, gbase, voff) do { _Pragma("unroll") for (int _i = 0; _i < 2; ++_i) \
        __builtin_amdgcn_global_load_lds((const unsigned*)((const char*)(gbase) + (voff)[_i]), (PG8_LAS unsigned*)(lds + (bufoff) + ldsw + _i * 8192), 16, 0, 0); } while (0)
#define PG8_STAGE_G(bufoff, gbase, v0, v1) do { \
        __builtin_amdgcn_global_load_lds((const unsigned*)((const char*)(gbase) + (v0)), (PG8_LAS unsigned*)(lds + (bufoff) + ldsw), 16, 0, 0); \
        __builtin_amdgcn_global_load_lds((const unsigned*)((const char*)(gbase) + (v1)), (PG8_LAS unsigned*)(lds + (bufoff) + ldsw + 8192), 16, 0, 0); } while (0)
#define PG8_LDA(dst, b, h) do { if constexpr (F8) { _Pragma("unroll") for (int m = 0; m < 4; ++m) { const u32x4 lo_ = *(const PG8_LAS u32x4*)(lds + PG8_SA(b, h) + aoff + m * 2048), hi_ = *(const PG8_LAS u32x4*)(lds + PG8_SA(b, h) + aoff + 1024 + m * 2048); \
            dst##8[m] = (v8i){(int)lo_.x, (int)lo_.y, (int)lo_.z, (int)lo_.w, (int)hi_.x, (int)hi_.y, (int)hi_.z, (int)hi_.w}; } } \
        else { _Pragma("unroll") for (int m = 0; m < 4; ++m) _Pragma("unroll") for (int k = 0; k < 2; ++k) dst[m][k] = *(const PG8_LAS bf16x8*)(lds + PG8_SA(b, h) + aoff + m * 2048 + k * 1024); } } while (0)
#define PG8_LDB(dst, b, h) do { if constexpr (F8) { _Pragma("unroll") for (int n = 0; n < 2; ++n) { const u32x4 lo_ = *(const PG8_LAS u32x4*)(lds + PG8_SB(b, h) + boff + n * 2048), hi_ = *(const PG8_LAS u32x4*)(lds + PG8_SB(b, h) + boff + 1024 + n * 2048); \
            dst##8[n] = (v8i){(int)lo_.x, (int)lo_.y, (int)lo_.z, (int)lo_.w, (int)hi_.x, (int)hi_.y, (int)hi_.z, (int)hi_.w}; } } \
        else { _Pragma("unroll") for (int n = 0; n < 2; ++n) _Pragma("unroll") for (int k = 0; k < 2; ++k) dst[n][k] = *(const PG8_LAS bf16x8*)(lds + PG8_SB(b, h) + boff + n * 2048 + k * 1024); } } while (0)
#define PG8_MMA(ai, bj, At, Bt) do { __builtin_amdgcn_s_setprio(1); \
        if constexpr (F8) { _Pragma("unroll") for (int m = 0; m < 4; ++m) _Pragma("unroll") for (int n = 0; n < 2; ++n) \
            asm volatile("v_mfma_scale_f32_16x16x128_f8f6f4 %0, %1, %2, %0, %3, %4 op_sel_hi:[0,0,0]" : "+v"(acc[ai][bj][m][n]) : "v"(Bt##8[n]), "v"(At##8[m]), "v"(sc8_), "v"(sc8_)); } \
        else { _Pragma("unroll") for (int m = 0; m < 4; ++m) _Pragma("unroll") for (int n = 0; n < 2; ++n) _Pragma("unroll") for (int k = 0; k < 2; ++k) \
            acc[ai][bj][m][n] = __builtin_amdgcn_mfma_f32_16x16x32_bf16(Bt[n][k], At[m][k], acc[ai][bj][m][n], 0, 0, 0); } \
        __builtin_amdgcn_s_setprio(0); } while (0)
#define PG8_WAIT_V(n) asm volatile("s_waitcnt vmcnt(" #n ")" ::: "memory")
#define PG8_WAIT_L(n) asm volatile("s_waitcnt lgkmcnt(" #n ")" ::: "memory")
#define PG8_BAR __builtin_amdgcn_s_barrier()
#define PG8_SCHED __builtin_amdgcn_sched_barrier(0)
#define PG8_SCHED8 do { if constexpr (F8) __builtin_amdgcn_sched_barrier(0); } while (0)
    Unit cur, nxt; int ui = 0;
    if (!S.next(0, cur)) return;
    unsigned gc[2][2] = {{0u, 0u}, {0u, 0u}}, gn[2][2] = {{0u, 0u}, {0u, 0u}};
    int gR[2] = {0, 0}, gC[2] = {0, 0};
    if constexpr (GATH) {
#pragma unroll
        for (int i = 0; i < 2; ++i) stage_rc(tid * 16 + i * 8192, gR[i], gC[i]);
#pragma unroll
        for (int h = 0; h < 2; ++h)
#pragma unroll
            for (int i = 0; i < 2; ++i) { unsigned src = (unsigned)g.rowsrc[cur.pm * BM + h * HALF + gR[i]]; src = src < (unsigned)g.nsrc ? src : (unsigned)(g.nsrc - 1); gc[h][i] = (src * (unsigned)K + (unsigned)gC[i]) * 2u; }
    }
    f32x4 acc[2][2][4][2];
#pragma unroll
    for (int a = 0; a < 2; ++a)
#pragma unroll
        for (int b = 0; b < 2; ++b)
#pragma unroll
            for (int m = 0; m < 4; ++m)
#pragma unroll
                for (int n = 0; n < 2; ++n) acc[a][b][m][n] = (f32x4){0.f, 0.f, 0.f, 0.f};
    const int sc8_ = 0x7c7c7c7c;
    bf16x8 At[4][2], B0[2][2], B1[2][2]; v8i At8[4], B08[2], B18[2];
    const char* cA = GATH ? (const char*)g.A : (const char*)g.A + (size_t)cur.pm * tstepA; const char* cB = (const char*)g.Bt + S.boff(cur, tstep);
    S.a_ready(cur);
    if constexpr (SP2) {
        PG8_STAGE(PG8_SB(0, 0), cB, voffB); PG8_STAGE(PG8_SB(0, 1), cB + hstep, voffB);
        if constexpr (GATH) { PG8_STAGE_G(PG8_SA(0, 0), cA, gc[0][0], gc[0][1]); PG8_STAGE_G(PG8_SA(0, 1), cA, gc[1][0], gc[1][1]); } else { PG8_STAGE(PG8_SA(0, 0), cA, voffA); PG8_STAGE(PG8_SA(0, 1), cA + hstepA, voffA); }
        if (wr == 1) PG8_BAR;
        PG8_WAIT_V(2); PG8_BAR;
        PG8_STAGE(PG8_SB(1, 0), cB + kstep, voffB); if constexpr (GATH) PG8_STAGE_G(PG8_SA(1, 0), cA + kstep, gc[0][0], gc[0][1]); else PG8_STAGE(PG8_SA(1, 0), cA + kstep, voffA); PG8_STAGE(PG8_SB(1, 1), cB + hstep + kstep, voffB);
        PG8_WAIT_V(6); PG8_BAR;
    } else {
        PG8_STAGE(PG8_SB(0, 0), cB, voffB); PG8_STAGE(PG8_SA(0, 0), cA, voffA); PG8_STAGE(PG8_SB(0, 1), cB + hstep, voffB); PG8_STAGE(PG8_SA(0, 1), cA + hstepA, voffA);
        if (wr == 1) PG8_BAR;
        PG8_WAIT_V(4); PG8_BAR;
        PG8_STAGE(PG8_SB(1, 0), cB + kstep, voffB); PG8_STAGE(PG8_SA(1, 0), cA + kstep, voffA); PG8_STAGE(PG8_SB(1, 1), cB + hstep + kstep, voffB);
        PG8_WAIT_V(6); PG8_BAR;
    }
    for (;;) {
        const bool has_next = S.next(ui + 1, nxt);
        const char* nA = GATH ? cA : (has_next ? (const char*)g.A + (size_t)nxt.pm * tstepA : cA); const char* nB = has_next ? (const char*)g.Bt + S.boff(nxt, tstep) : cB;
        if constexpr (GATH) {
#pragma unroll
            for (int h = 0; h < 2; ++h)
#pragma unroll
                for (int i = 0; i < 2; ++i) { gn[h][i] = gc[h][i];
                    if (has_next) { unsigned src = (unsigned)g.rowsrc[nxt.pm * BM + h * HALF + gR[i]]; src = src < (unsigned)g.nsrc ? src : (unsigned)(g.nsrc - 1); gn[h][i] = (src * (unsigned)K + (unsigned)gC[i]) * 2u; } }
        }
#pragma nounroll
        for (int t = 0; t < nt; t += 2) {
            const bool last = (t == nt - 2);
            const char* a1 = cA + (size_t)(t + 1) * kstep;
            const char* a2 = last ? nA : cA + (size_t)(t + 2) * kstep; const char* b2 = last ? nB : cB + (size_t)(t + 2) * kstep;
            const char* a3 = a2 + kstep; const char* b3 = b2 + kstep;
            if (last && has_next) S.a_ready(nxt);
            if constexpr (SP2) {
            PG8_LDB(B0, 0, 0); PG8_LDB(B1, 0, 1); PG8_SCHED; PG8_LDA(At, 0, 0); if constexpr (GATH) PG8_STAGE_G(PG8_SA(1, 1), a1, gc[1][0], gc[1][1]); else PG8_STAGE(PG8_SA(1, 1), a1 + hstepA, voffA);
            PG8_WAIT_V(8); PG8_WAIT_L(0); PG8_BAR; PG8_SCHED8; PG8_MMA(0, 0, At, B0); PG8_MMA(0, 1, At, B1); PG8_SCHED8; PG8_BAR; PG8_SCHED;
            PG8_LDA(At, 0, 1); PG8_STAGE(PG8_SB(0, 0), b2, voffB); PG8_STAGE(PG8_SB(0, 1), b2 + hstep, voffB); if constexpr (GATH) PG8_STAGE_G(PG8_SA(0, 0), a2, last ? gn[0][0] : gc[0][0], last ? gn[0][1] : gc[0][1]); else PG8_STAGE(PG8_SA(0, 0), a2, voffA);
            PG8_WAIT_V(8); PG8_WAIT_L(0); PG8_BAR; PG8_SCHED8; PG8_MMA(1, 0, At, B0); PG8_MMA(1, 1, At, B1); PG8_SCHED8; PG8_BAR; PG8_SCHED;
            PG8_LDB(B0, 1, 0); PG8_LDB(B1, 1, 1); PG8_SCHED; PG8_LDA(At, 1, 0); if constexpr (GATH) PG8_STAGE_G(PG8_SA(0, 1), a2, last ? gn[1][0] : gc[1][0], last ? gn[1][1] : gc[1][1]); else PG8_STAGE(PG8_SA(0, 1), a2 + hstepA, voffA);
            PG8_WAIT_V(8); PG8_WAIT_L(0); PG8_BAR; PG8_SCHED8; PG8_MMA(0, 0, At, B0); PG8_MMA(0, 1, At, B1); PG8_SCHED8; PG8_BAR; PG8_SCHED;
            PG8_LDA(At, 1, 1); PG8_STAGE(PG8_SB(1, 0), b3, voffB); PG8_STAGE(PG8_SB(1, 1), b3 + hstep, voffB); if constexpr (GATH) PG8_STAGE_G(PG8_SA(1, 0), a3, last ? gn[0][0] : gc[0][0], last ? gn[0][1] : gc[0][1]); else PG8_STAGE(PG8_SA(1, 0), a3, voffA);
            PG8_WAIT_V(8); PG8_WAIT_L(0); PG8_BAR; PG8_SCHED8; PG8_MMA(1, 0, At, B0); PG8_MMA(1, 1, At, B1); PG8_SCHED8; PG8_BAR; PG8_SCHED;
            } else {
            PG8_LDB(B0, 0, 0); PG8_SCHED; PG8_LDA(At, 0, 0); PG8_STAGE(PG8_SA(1, 1), a1 + hstepA, voffA);
            PG8_WAIT_L(8); PG8_BAR; PG8_WAIT_L(0); PG8_MMA(0, 0, At, B0); PG8_BAR; PG8_SCHED;
            PG8_LDB(B1, 0, 1); PG8_STAGE(PG8_SB(0, 0), b2, voffB);
            PG8_BAR; PG8_WAIT_L(0); PG8_MMA(0, 1, At, B1); PG8_BAR;
            PG8_LDA(At, 0, 1); PG8_STAGE(PG8_SA(0, 0), a2, voffA);
            PG8_BAR; PG8_WAIT_L(0); PG8_MMA(1, 0, At, B0); PG8_BAR; PG8_SCHED;
            PG8_STAGE(PG8_SB(0, 1), b2 + hstep, voffB);
            PG8_WAIT_V(6); PG8_BAR; PG8_MMA(1, 1, At, B1); PG8_BAR;
            PG8_LDB(B0, 1, 0); PG8_SCHED; PG8_LDA(At, 1, 0); PG8_STAGE(PG8_SA(0, 1), a2 + hstepA, voffA);
            PG8_WAIT_L(8); PG8_BAR; PG8_WAIT_L(0); PG8_MMA(0, 0, At, B0); PG8_BAR; PG8_SCHED;
            PG8_LDB(B1, 1, 1); PG8_STAGE(PG8_SB(1, 0), b3, voffB);
            PG8_BAR; PG8_WAIT_L(0); PG8_MMA(0, 1, At, B1); PG8_BAR;
            PG8_LDA(At, 1, 1); PG8_STAGE(PG8_SA(1, 0), a3, voffA);
            PG8_BAR; PG8_WAIT_L(0); PG8_MMA(1, 0, At, B0); PG8_BAR; PG8_SCHED;
            PG8_STAGE(PG8_SB(1, 1), b3 + hstep, voffB);
            PG8_WAIT_V(6); PG8_BAR; PG8_MMA(1, 1, At, B1); PG8_BAR;
            }
        }
        if constexpr (F8) asm volatile("s_nop 15\n\ts_nop 15" ::: "memory");
        if constexpr (ALIGN_EPI) { if (wr == 0) PG8_BAR; }
        if constexpr (!Epi::AFTER_DRAIN) { E(acc, cur, wr, wc, fr, fq); S.done(cur); }
        if (!has_next) break;
#pragma unroll
        for (int a = 0; a < 2; ++a)
#pragma unroll
            for (int b = 0; b < 2; ++b)
#pragma unroll
                for (int m = 0; m < 4; ++m)
#pragma unroll
                    for (int n = 0; n < 2; ++n) acc[a][b][m][n] = (f32x4){0.f, 0.f, 0.f, 0.f};
        cur = nxt; cA = nA; cB = nB; ++ui;
        if constexpr (GATH) {
#pragma unroll
            for (int h = 0; h < 2; ++h)
#pragma unroll
                for (int i = 0; i < 2; ++i) gc[h][i] = gn[h][i]; }
        if constexpr (ALIGN_EPI) { if (wr == 1) PG8_BAR; }
    }
    PG8_WAIT_V(0);
    if constexpr (!ALIGN_EPI) { if (wr == 0) PG8_BAR; }
    PG8_BAR;
    if constexpr (Epi::AFTER_DRAIN) { E.fused(acc, cur, wr, wc, fr, fq, lds, wid, lane); S.done(cur); }
#undef PG8_SA
#undef PG8_SB
#undef PG8_STAGE
#undef PG8_STAGE_G
#undef PG8_LDA
#undef PG8_LDB
#undef PG8_MMA
#undef PG8_WAIT_V
#undef PG8_WAIT_L
#undef PG8_BAR
#undef PG8_SCHED
#undef PG8_SCHED8
}
}


constexpr int NB = 8, T = 8192, D = 1024, NTOK = NB * T, DIN = 2816, NL = 2, GW = 256;
constexpr int NWAVES = 8, NTHR = 512;
constexpr int HP = 2048;
constexpr int NEXP = 32, DEXP = 512;
constexpr int MAXTILES = (2 * NTOK) / 256 + NEXP;
constexpr int SROWS = MAXTILES * 256;
constexpr int C_HQ = 0, C_HF = 256, C_HI = 512, C_HG = 768, C_SU = 1024, C_RW = 1280, C_LG = 2304, C_LX = 2560;

constexpr size_t MiB = 1u << 20;
constexpr size_t WS_CTL = 0, CTL_ZERO_BYTES = 1 * MiB;
constexpr size_t WL_STRIDE = 105 * MiB;
constexpr size_t WO_IN = 0, WO_OUT = 6 * MiB, WO_GLU = 8 * MiB, WO_GU = 9 * MiB, WO_DN = 73 * MiB, WO_RT = 8 * MiB + 512 * 1024;
constexpr size_t WS_W = 1 * MiB;
constexpr size_t S5_STRIDE = 9 * MiB;
constexpr size_t S5O_F3 = 0, S5O_F1 = 4 * MiB, S5O_A16 = 8 * MiB;
constexpr size_t WS_S5 = 211 * MiB;
constexpr size_t WS_ACT = 229 * MiB;
constexpr size_t WS_PROJ = 357 * MiB;
constexpr size_t WS_MIX = 709 * MiB;
constexpr size_t WS_YG = WS_MIX + 128 * MiB;
constexpr size_t WS_VF = 869 * MiB;
constexpr size_t WS_HU = 901 * MiB;
constexpr size_t WS_XS = 933 * MiB;
constexpr size_t WS_ROUTE = 965 * MiB;
constexpr size_t WS_TCNT = 967 * MiB;
constexpr size_t WS_LG = 968 * MiB;
constexpr size_t WS_END = 986 * MiB;
static_assert(WS_PROJ + (size_t)NTOK * DIN * 2 <= WS_MIX && WS_PROJ + (size_t)SROWS * D * 2 <= WS_MIX, "proj region");
static_assert(WS_MIX + (size_t)SROWS * DEXP * 2 <= WS_VF, "mix region");
constexpr int CW_BAR = 4096;
constexpr int CW_CNT = 8192;
constexpr int CW_CUR = 8192 + 256;

constexpr int RING_BYTES = 131072;
constexpr int LDSCTL_OFF = RING_BYTES;
constexpr int LDS_TILE_E = LDSCTL_OFF + 64;
constexpr int LDS_MISC = LDS_TILE_E + MAXTILES * 4;
constexpr int LDS_BYTES = 147456;
static_assert(LDS_MISC + 1024 <= LDS_BYTES, "LDS map");

typedef unsigned short bf16;
typedef float f32x4 __attribute__((ext_vector_type(4)));
typedef float f32x2 __attribute__((ext_vector_type(2)));
typedef unsigned u32x4 __attribute__((ext_vector_type(4)));
typedef unsigned u32x2 __attribute__((ext_vector_type(2)));
typedef short bf16x8 __attribute__((ext_vector_type(8)));

typedef __bf16 hwbf2 __attribute__((ext_vector_type(2)));
__device__ __forceinline__ unsigned cvt2(float lo, float hi) { const f32x2 v = {lo, hi}; return __builtin_bit_cast(unsigned, __builtin_convertvector(v, hwbf2)); }
__device__ __forceinline__ unsigned pk2(float lo, float hi) { return cvt2(lo, hi); }
__device__ __forceinline__ unsigned f2bf(float f) { return cvt2(f, 0.f) & 0xffffu; }
__device__ __forceinline__ float bf2f(unsigned b) { return __builtin_bit_cast(float, b << 16); }
__device__ __forceinline__ float bflo(unsigned w) { return __builtin_bit_cast(float, w << 16); }
__device__ __forceinline__ float bfhi(unsigned w) { return __builtin_bit_cast(float, w & 0xffff0000u); }
__device__ __forceinline__ void unpack8(const u32x4 w, float (&o)[8]) { o[0] = bflo(w.x); o[1] = bfhi(w.x); o[2] = bflo(w.y); o[3] = bfhi(w.y); o[4] = bflo(w.z); o[5] = bfhi(w.z); o[6] = bflo(w.w); o[7] = bfhi(w.w); }
__device__ __forceinline__ float frcp(float x) { return __builtin_amdgcn_rcpf(x); }
__device__ __forceinline__ float sigmoidf_(float x) { return frcp(1.f + __expf(-x)); }
__device__ __forceinline__ float siluf_(float x) { return x * frcp(1.f + __expf(-x)); }
__device__ __forceinline__ float softplusf_(float x) { return x > 15.f ? x : __logf(1.f + __expf(x)); }
__device__ __forceinline__ float gelu_tanh(float x) { const float u = 0.7978845608028654f * (x + 0.044715f * x * x * x); return x * frcp(1.f + __expf(-2.f * u)); }
#define DPPF(v, ctrl) __builtin_bit_cast(float, __builtin_amdgcn_update_dpp(0, __builtin_bit_cast(int, (v)), (ctrl), 0xf, 0xf, true))
__device__ __forceinline__ float row16_sum(float v) {
    v += DPPF(v, 0xB1);
    v += DPPF(v, 0x4E);
    v += DPPF(v, 0x141);
    v += DPPF(v, 0x140);
    return v;
}
__device__ __forceinline__ float wave_sum(float v) {
    v = row16_sum(v);
    return (__builtin_bit_cast(float, __builtin_amdgcn_readlane(__builtin_bit_cast(int, v), 0)) + __builtin_bit_cast(float, __builtin_amdgcn_readlane(__builtin_bit_cast(int, v), 16)))
         + (__builtin_bit_cast(float, __builtin_amdgcn_readlane(__builtin_bit_cast(int, v), 32)) + __builtin_bit_cast(float, __builtin_amdgcn_readlane(__builtin_bit_cast(int, v), 48)));
}
__device__ __forceinline__ float half_sum(float v, int lane) {
    v = row16_sum(v);
    const float a = __builtin_bit_cast(float, __builtin_amdgcn_readlane(__builtin_bit_cast(int, v), 0)) + __builtin_bit_cast(float, __builtin_amdgcn_readlane(__builtin_bit_cast(int, v), 16));
    const float b = __builtin_bit_cast(float, __builtin_amdgcn_readlane(__builtin_bit_cast(int, v), 32)) + __builtin_bit_cast(float, __builtin_amdgcn_readlane(__builtin_bit_cast(int, v), 48));
    return (lane & 32) ? b : a;
}
#define PIN1(a) asm volatile("" : "+v"(a))
#define PIN2(v) asm volatile("" : "+v"((v).x), "+v"((v).y))
#define PIN4(v) asm volatile("" : "+v"((v).x), "+v"((v).y), "+v"((v).z), "+v"((v).w))
#define LDS_WAIT() asm volatile("s_waitcnt lgkmcnt(0)" ::: "memory")
#define LDS_BARRIER() do { asm volatile("s_waitcnt lgkmcnt(0)" ::: "memory"); __builtin_amdgcn_s_barrier(); asm volatile("" ::: "memory"); } while (0)


#define XB_TMO      128
#define XB_XCNT(j)  (256  + 64 * (j))
#define XB_XSUB(j)  (1280 + 64 * (j))
#define XB_XGEN(j)  (2304 + 64 * (j))
#define XB_TOP      3328
#define XB_TOPGEN   3392
#define XCD_BAR_WORDS 3456
#define XB_SPIN_CAP (1u << 18)

__device__ __forceinline__ unsigned xb_ld(unsigned* p)              { return __hip_atomic_load(p, __ATOMIC_RELAXED, __HIP_MEMORY_SCOPE_AGENT); }
__device__ __forceinline__ unsigned xb_add(unsigned* p, unsigned v) { return __hip_atomic_fetch_add(p, v, __ATOMIC_RELAXED, __HIP_MEMORY_SCOPE_AGENT); }
__device__ __forceinline__ unsigned xb_xcc_id() { return (unsigned)__builtin_amdgcn_s_getreg((3 << 11) | 20) & 0xFu; }
#define XB_SPIN(cond, bar) do { unsigned _sp = 0; while (cond) { __builtin_amdgcn_s_sleep(1); \
    if ((++_sp & 255u) == 0u) { if (xb_ld(&(bar)[XB_TMO])) break; if (_sp > XB_SPIN_CAP) { atomicAdd(&(bar)[XB_TMO], 1u); break; } } } } while (0)

struct XcdBarrier {
    unsigned* bar; unsigned x;
    volatile LAS unsigned* st;
};

__device__ __forceinline__ XcdBarrier xcd_barrier_post(unsigned* bar, volatile LAS unsigned* st) {
    XcdBarrier b; b.bar = bar; b.x = xb_xcc_id(); b.st = st;
    if (threadIdx.x == 0) (void)xb_add(&bar[XB_XCNT(b.x)], 1u);
    return b;
}
__device__ __forceinline__ void xcd_barrier_complete(unsigned* bar, unsigned x, unsigned& nloc, unsigned& nx) {
    const unsigned G = gridDim.x * gridDim.y * gridDim.z;
    unsigned sum, cnt, mine, sp = 0u;
    for (;;) {
        sum = 0u; cnt = 0u; mine = 0u;
#pragma unroll
        for (unsigned j = 0; j < 16; ++j) { const unsigned c = xb_ld(&bar[XB_XCNT(j)]); sum += c; cnt += (c > 0u) ? 1u : 0u; mine = (j == x) ? c : mine; }
        if (sum == G) break;
        __builtin_amdgcn_s_sleep(1);
        if ((++sp & 255u) == 0u) { if (xb_ld(&bar[XB_TMO])) break; if (sp > XB_SPIN_CAP) { atomicAdd(&bar[XB_TMO], 1u); break; } }
    }
    nloc = mine > 0u ? mine : 1u; nx = cnt > 0u ? cnt : 1u;
}

__device__ __forceinline__ void xcd_barrier(const XcdBarrier& b) {
    asm volatile("s_waitcnt vmcnt(0)" ::: "memory");
    __syncthreads();
    if (threadIdx.x == 0) {
        unsigned* bar = b.bar;
        __builtin_amdgcn_s_waitcnt(0);
        unsigned nloc = b.st[0], nx = b.st[1];
        if (nloc == 0u) { xcd_barrier_complete(bar, b.x, nloc, nx); b.st[0] = nloc; b.st[1] = nx; }
        const unsigned old = xb_add(&bar[XB_XSUB(b.x)], 1u);
        const unsigned gen = old / nloc;
        if (old + 1u == (gen + 1u) * nloc) {
            __builtin_amdgcn_fence(__ATOMIC_RELEASE, "agent");
            asm volatile("s_waitcnt vmcnt(0)" ::: "memory");
            const unsigned og = xb_add(&bar[XB_TOP], 1u);
            const unsigned tg = og / nx;
            if (og + 1u == (tg + 1u) * nx) xb_add(&bar[XB_TOPGEN], 1u);
            else XB_SPIN(xb_ld(&bar[XB_TOPGEN]) == tg, bar);
            __builtin_amdgcn_fence(__ATOMIC_ACQUIRE, "agent");
            xb_add(&bar[XB_XGEN(b.x)], 1u);
            asm volatile("s_waitcnt vmcnt(0)" ::: "memory");
        } else {
            XB_SPIN(xb_ld(&bar[XB_XGEN(b.x)]) == gen, bar);
            __builtin_amdgcn_fence(__ATOMIC_ACQUIRE, "agent");
            asm volatile("s_waitcnt vmcnt(0)" ::: "memory");
        }
    }
    __syncthreads();
}


struct Params { const float* in[46]; float* out; unsigned char* ws; int ph_lo, ph_hi; };
enum { I_X = 0, I_NORM1, I_WIN, I_HLB, I_HNW, I_S5LR, I_S5LI, I_S5DT, I_S5BR, I_S5BI, I_S5CR, I_S5CI, I_S5D, I_S5GLU, I_RMU, I_RW0, I_RW2, I_RA0, I_RA2, I_RG2,
       I_RKK, I_RKA, I_RRK, I_RV0, I_RV1, I_RV2, I_RLNW, I_RLNB, I_LCW, I_LCB, I_LWA, I_LBA, I_LWX, I_LBX, I_LLAM, I_MGAIN, I_WOUT, I_NORM2, I_MCW, I_MCB, I_MFW, I_MFB,
       I_MWG, I_MWU, I_MWD, I_FNW };

__device__ __forceinline__ void transpose_item(const float* W, int ldw, int k0, int n0, bf16* dst, int K, LAS float* scr, int lane) {
#pragma unroll 8
    for (int i = 0; i < 32; ++i) { const int kk = 2 * i + (lane >> 5); scr[kk * 33 + (lane & 31)] = W[(size_t)(k0 + kk) * ldw + n0 + (lane & 31)]; }
    LDS_WAIT(); asm volatile("" ::: "memory");
    const int c = lane & 7;
#pragma unroll
    for (int j = 0; j < 4; ++j) { const int n = (lane >> 3) + 8 * j; const LAS float* s = scr + (8 * c) * 33 + n;
        u32x4 o; o.x = pk2(s[0 * 33], s[1 * 33]); o.y = pk2(s[2 * 33], s[3 * 33]); o.z = pk2(s[4 * 33], s[5 * 33]); o.w = pk2(s[6 * 33], s[7 * 33]);
        *(u32x4*)(dst + (size_t)n * K + k0 + 8 * c) = o; }
    LDS_WAIT(); asm volatile("" ::: "memory");
}
__device__ __forceinline__ void transpose_item_f8(const float* W, int ldw, int k0, int n0, unsigned char* dst, int Kb, float sc, LAS float* scr, int lane) {
#pragma unroll 8
    for (int i = 0; i < 32; ++i) { const int kk = 2 * i + (lane >> 5); scr[kk * 33 + (lane & 31)] = W[(size_t)(k0 + kk) * ldw + n0 + (lane & 31)]; }
    LDS_WAIT(); asm volatile("" ::: "memory");
    const int c = lane & 7;
#pragma unroll
    for (int j = 0; j < 4; ++j) { const int n = (lane >> 3) + 8 * j; const LAS float* p = scr + (8 * c) * 33 + n; int w0 = 0, w1 = 0;
        w0 = __builtin_amdgcn_cvt_pk_fp8_f32(p[0 * 33] * sc, p[1 * 33] * sc, w0, false); w0 = __builtin_amdgcn_cvt_pk_fp8_f32(p[2 * 33] * sc, p[3 * 33] * sc, w0, true);
        w1 = __builtin_amdgcn_cvt_pk_fp8_f32(p[4 * 33] * sc, p[5 * 33] * sc, w1, false); w1 = __builtin_amdgcn_cvt_pk_fp8_f32(p[6 * 33] * sc, p[7 * 33] * sc, w1, true);
        *(unsigned long long*)(dst + (size_t)n * Kb + k0 + 8 * c) = (unsigned long long)(unsigned)w0 | ((unsigned long long)(unsigned)w1 << 32); }
    LDS_WAIT(); asm volatile("" ::: "memory");
}
constexpr int IT_IN = 16 * 88, IT_OUT = 16 * 32, IT_GLU = 4 * 16, IT_EXP = 32 * 256, IT_LAYER = IT_IN + IT_OUT + IT_GLU + 3 * IT_EXP;
__device__ __forceinline__ void prologue_item(const Params& P, int it, LAS float* scr, int lane) {
    const int l = it / IT_LAYER; int r = it % IT_LAYER;
    bf16* wl = (bf16*)(P.ws + WS_W + (size_t)l * WL_STRIDE);
    if (r < IT_IN) { const int kb = r / 88, nb = r % 88; transpose_item(P.in[I_WIN] + (size_t)l * D * DIN, DIN, 64 * kb, 32 * nb, (bf16*)((unsigned char*)wl + WO_IN) + (size_t)(32 * nb) * D, D, scr, lane); return; } r -= IT_IN;
    if (r < IT_OUT) { const int kb = r / 32, nb = r % 32; transpose_item(P.in[I_WOUT] + (size_t)l * D * D, D, 64 * kb, 32 * nb, (bf16*)((unsigned char*)wl + WO_OUT) + (size_t)(32 * nb) * D, D, scr, lane); return; } r -= IT_OUT;
    if (r < IT_GLU) { const int kb = r / 16, nb = r % 16, n0 = 32 * nb, nn = n0 & 255, drow = (nn >> 7) * 256 + (nn & 127) + ((n0 >> 8) ? 128 : 0);
        transpose_item(P.in[I_S5GLU] + (size_t)l * 256 * 512, 512, 64 * kb, n0, (bf16*)((unsigned char*)wl + WO_GLU) + (size_t)drow * 256, 256, scr, lane); return; } r -= IT_GLU;
    if (r < 2 * IT_EXP) { const int up = r / IT_EXP; r %= IT_EXP; const int e = r >> 8, q = r & 255, kb = q >> 4, nb = q & 15, n0 = 32 * nb, drow = (n0 >> 7) * 256 + (n0 & 127) + (up ? 128 : 0);
        transpose_item_f8(P.in[up ? I_MWU : I_MWG] + (size_t)(l * NEXP + e) * D * DEXP, DEXP, 64 * kb, n0, (unsigned char*)wl + WO_GU + (size_t)e * D * D + (size_t)drow * D, D, 64.f, scr, lane); return; } r -= 2 * IT_EXP;
    { const int e = r >> 8, q = r & 255, kb = q >> 5, nb = q & 31;
      transpose_item_f8(P.in[I_MWD] + (size_t)(l * NEXP + e) * DEXP * D, D, 64 * kb, 32 * nb, (unsigned char*)wl + WO_DN + (size_t)e * D * DEXP + (size_t)(32 * nb) * DEXP, DEXP, 64.f, scr, lane); }
}
__device__ __forceinline__ void rms_store_bf16(const f32x4 (&v)[4], const float* gain, bf16* orow, int lane) {
    float s = 0.f;
#pragma unroll
    for (int j = 0; j < 4; ++j) s += (v[j].x * v[j].x + v[j].y * v[j].y) + (v[j].z * v[j].z + v[j].w * v[j].w);
    const float rstd = 1.f / sqrtf(wave_sum(s) * (1.f / D) + 1e-6f);
    u32x2* o8 = (u32x2*)orow + lane;
#pragma unroll
    for (int j = 0; j < 4; ++j) { const f32x4 g = *((const f32x4*)gain + lane + 64 * j); u32x2 w; w.x = pk2(v[j].x * rstd * g.x, v[j].y * rstd * g.y); w.y = pk2(v[j].z * rstd * g.z, v[j].w * rstd * g.w); o8[64 * j] = w; }
}
__device__ __forceinline__ void s5_pow(float lr, float li, double dt, int j, float& ar, float& ai) {
    const double m = exp((double)lr * dt * (double)j); double ang = (double)li * dt * (double)j; ang -= 6.283185307179586 * rint(ang * 0.15915494309189535);
    ar = (float)(m * cos(ang)); ai = (float)(m * sin(ang));
}
__device__ __forceinline__ void s5_consts_unit(const Params& P, int l, int g, LAS unsigned char* lds, int tid) {
    LAS float* PW = (LAS float*)lds;
    LAS float* BBr = PW + 64 * 17 * 2;
    LAS float* BBi = BBr + 1024;
    LAS float* Cr = BBi + 1024;
    LAS float* Ci = Cr + 1024;
    LAS float* KT = Ci + 1024;
    const int lg = l * 16 + g;
    const double dt = exp((double)P.in[I_S5DT][lg]);
    const float* lrp = P.in[I_S5LR] + (size_t)lg * 64; const float* lip = P.in[I_S5LI] + (size_t)lg * 64;
    for (int idx = tid; idx < 64 * 17; idx += NTHR) { const int p = idx / 17, j = idx % 17; float ar, ai; s5_pow(lrp[p], lip[p], dt, j, ar, ai); PW[idx * 2] = ar; PW[idx * 2 + 1] = ai; }
    for (int idx = tid; idx < 1024; idx += NTHR) { const int p = idx >> 4, c = idx & 15; const float lr = lrp[p], li = lip[p]; float ar, ai; s5_pow(lr, li, dt, 1, ar, ai);
        const float den = lr * lr + li * li, kr = ((ar - 1.f) * lr + ai * li) / den, ki = (ai * lr - (ar - 1.f) * li) / den;
        const float br = P.in[I_S5BR][((size_t)lg * 64 + p) * 16 + c], bi = P.in[I_S5BI][((size_t)lg * 64 + p) * 16 + c];
        BBr[idx] = kr * br - ki * bi; BBi[idx] = kr * bi + ki * br;
        Cr[idx] = P.in[I_S5CR][(size_t)lg * 1024 + idx]; Ci[idx] = P.in[I_S5CI][(size_t)lg * 1024 + idx]; }
    __syncthreads();
    for (int idx = tid; idx < 4096; idx += NTHR) { const int j = idx >> 8, c = (idx >> 4) & 15, cp = idx & 15; float acc = 0.f;
        for (int p = 0; p < 64; ++p) { const float ar = PW[(p * 17 + j) * 2], ai = PW[(p * 17 + j) * 2 + 1], br = BBr[p * 16 + cp], bi = BBi[p * 16 + cp], cr = Cr[c * 64 + p], ci = Ci[c * 64 + p];
            const float zr = ar * br - ai * bi, zi = ar * bi + ai * br; acc += cr * zr - ci * zi; }
        KT[idx] = acc; }
    __syncthreads();
    unsigned char* sb = P.ws + WS_S5 + (size_t)l * S5_STRIDE;
    bf16* F3 = (bf16*)(sb + S5O_F3) + (size_t)g * 98304; bf16* F1 = (bf16*)(sb + S5O_F1) + (size_t)g * 32768; float* A16 = (float*)(sb + S5O_A16) + (size_t)g * 128;
    for (int idx = tid; idx < 98304; idx += NTHR) { const int j = idx & 7, ln = (idx >> 3) & 63, fk = idx >> 9, ks = fk % 12, rt = fk / 12; const int row = 16 * rt + (ln & 15), k = 32 * ks + 8 * (ln >> 4) + j, t = row >> 4, c = row & 15; float val;
        if (k < 256) { const int s2 = k >> 4, cp = k & 15; val = (s2 <= t) ? KT[((t - s2) * 16 + c) * 16 + cp] : 0.f; }
        else { const int n = k - 256, p = n & 63; const float ar = PW[(p * 17 + t + 1) * 2], ai = PW[(p * 17 + t + 1) * 2 + 1], cr = Cr[c * 64 + p], ci = Ci[c * 64 + p]; val = (n < 64) ? (cr * ar - ci * ai) : -(cr * ai + ci * ar); }
        F3[idx] = (bf16)f2bf(val); }
    for (int idx = tid; idx < 32768; idx += NTHR) { const int j = idx & 7, ln = (idx >> 3) & 63, fk = idx >> 9, ks = fk & 7, rt = fk >> 3; const int n = 16 * rt + (ln & 15), k = 32 * ks + 8 * (ln >> 4) + j, p = n & 63, s2 = k >> 4, cp = k & 15;
        const float ar = PW[(p * 17 + 15 - s2) * 2], ai = PW[(p * 17 + 15 - s2) * 2 + 1], br = BBr[p * 16 + cp], bi = BBi[p * 16 + cp];
        F1[idx] = (bf16)f2bf((n < 64) ? (ar * br - ai * bi) : (ar * bi + ai * br)); }
    if (tid < 64) { A16[tid * 2] = PW[(tid * 17 + 16) * 2]; A16[tid * 2 + 1] = PW[(tid * 17 + 16) * 2 + 1]; }
    __syncthreads();
}
__device__ __forceinline__ void ph_prologue(const Params& P, LAS unsigned char* lds, int tid, int lane, int wave) {
    for (int u = blockIdx.x; u < NL * 16; u += gridDim.x) s5_consts_unit(P, u >> 4, u & 15, lds, tid);
    LAS float* scr = (LAS float*)(lds + wave * 16384);
    const int gw = blockIdx.x * NWAVES + wave, NGW = gridDim.x * NWAVES;
    for (int it = gw; it < NL * IT_LAYER; it += NGW) prologue_item(P, it, scr, lane);
    for (int idx = blockIdx.x * NTHR + tid; idx < NL * 256 * 1024; idx += gridDim.x * NTHR) { const int l = idx >> 18, n = (idx >> 10) & 255, k = idx & 1023; float val = 0.f;
        if (n < 72) { const int j = n % 36; const float w = (j < 4) ? P.in[I_MCW][((size_t)l * D + k) * 4 + j] : P.in[I_MFW][(((size_t)l * 4 + ((j - 4) >> 3)) * D + k) * 8 + ((j - 4) & 7)]; val = w * P.in[I_NORM2][(size_t)l * D + k]; }
        const unsigned hi = f2bf(val); const float rem = val - __builtin_bit_cast(float, hi << 16);
        ((bf16*)(P.ws + WS_W + (size_t)l * WL_STRIDE + WO_RT))[(size_t)n * D + k] = (bf16)((n >= 36) ? f2bf(rem) : hi); }
    bf16* act = (bf16*)(P.ws + WS_ACT);
    for (int m = gw; m < NTOK; m += NGW) {
        const f32x4* xr = (const f32x4*)(P.in[I_X] + (size_t)m * D) + lane; f32x4 v[4];
#pragma unroll
        for (int j = 0; j < 4; ++j) v[j] = xr[64 * j];
        rms_store_bf16(v, P.in[I_NORM1], act + (size_t)m * D, lane);
    }
}


__device__ __forceinline__ u32x4 ldg16(const bf16* p) { return *(const u32x4*)p; }

#define MF(a, b, c) __builtin_amdgcn_mfma_f32_16x16x32_bf16((a), (b), (c), 0, 0, 0)
__device__ __forceinline__ u32x2 pack4(const f32x4 d) { u32x2 w; w.x = cvt2(d[0], d[1]); w.y = cvt2(d[2], d[3]); return w; }
__device__ __forceinline__ bf16x8 cat8(const u32x2 lo, const u32x2 hi) { u32x4 w; w.x = lo.x; w.y = lo.y; w.z = hi.x; w.w = hi.y; return __builtin_bit_cast(bf16x8, w); }
__device__ __forceinline__ bf16x8 pack_lo(const f32x4 d) { return cat8(pack4(d), (u32x2){0u, 0u}); }
__device__ __forceinline__ bf16x8 pack2(const f32x4 a, const f32x4 b) { return cat8(pack4(a), pack4(b)); }

__device__ __forceinline__ void role_hgrn(const Params& P, int l, int b, int hd, LAS unsigned char* lds, int tid, int lane, int wave) {
    LAS float* LF = (LAS float*)lds; LAS float* Oa = LF + 1024; LAS float* GamC = Oa + 1024;
    LAS bf16* Qh = (LAS bf16*)(GamC + 64); LAS bf16* Kt = Qh + 16 * 72; LAS bf16* KbarT = Kt + 16 * 72; LAS bf16* VmTb = KbarT + 64 * 24;
    const bf16* proj = (const bf16*)(P.ws + WS_PROJ); bf16* mix = (bf16*)(P.ws + WS_MIX);
    const int tl = tid & 255, tt = tl >> 4, j4 = (tl & 15) * 4, r = lane & 15, q = lane >> 4;
    const int tA = (wave < 4) ? (lane & 15) : tt, jA = (wave < 4) ? 16 * wave + 4 * (lane >> 4) : j4;
    f32x4 lb = {0.f, 0.f, 0.f, 0.f};
    if (l > 0) {
#pragma unroll
        for (int i = 0; i < 4; ++i) { const int c = hd * 64 + jA + i; lb[i] = 1.f / (1.f + expf(P.in[I_HLB][c] - P.in[I_HLB][256 + c])); } }
    const f32x4 nw = *(const f32x4*)(P.in[I_HNW] + l * 256 + hd * 64 + j4);
    f32x4 st[4];
#pragma unroll
    for (int i = 0; i < 4; ++i) st[i] = (f32x4){0.f, 0.f, 0.f, 0.f};
    const bf16* pr0 = proj + ((size_t)b * T + tA) * DIN + hd * 64 + jA;
    u32x2 n0a, n1a, n0b, n1b; f32x4 qv = lb, kkv = lb, civ = lb, cmv = lb, sgc = lb, sgn = lb;
    { const int o0 = (wave < 4) ? C_HQ : C_HI, o1 = (wave < 4) ? C_HF : C_HG;
      n0a = *(const u32x2*)(pr0 + o0); n1a = *(const u32x2*)(pr0 + o1); n0b = *(const u32x2*)(pr0 + (size_t)16 * DIN + o0); n1b = *(const u32x2*)(pr0 + (size_t)16 * DIN + o1); }
#define HG_STAGE_A(c, N0, N1) do { u32x2 rq = N0, rf = N1; PIN2(rq); PIN2(rf); \
        { const int cn_ = (c) + 2 < T / 16 ? (c) + 2 : T / 16 - 1; const bf16* pn = pr0 + (size_t)cn_ * 16 * DIN; N0 = *(const u32x2*)(pn + C_HQ); N1 = *(const u32x2*)(pn + C_HF); } \
        const f32x4 fx = {bflo(rf.x), bfhi(rf.x), bflo(rf.y), bfhi(rf.y)}, qx = {bflo(rq.x), bfhi(rq.x), bflo(rq.y), bfhi(rq.y)}; \
        f32x4 lfv; \
        _Pragma("unroll") for (int i = 0; i < 4; ++i) { const float e = __expf(fminf(-fx[i], 80.f)), ri_ = frcp(1.f + e); const float f = lb[i] + (1.f - lb[i]) * ri_; kkv[i] = (1.f - lb[i]) * e * ri_; lfv[i] = __logf(f); qv[i] = siluf_(qx[i]); } \
          \
        _Pragma("unroll") for (int i = 0; i < 4; ++i) { float p_ = lfv[i], s_ = lfv[i]; \
            p_ += DPPF(p_, 0x111); p_ += DPPF(p_, 0x112); p_ += DPPF(p_, 0x114); p_ += DPPF(p_, 0x118); \
            s_ += DPPF(s_, 0x101); s_ += DPPF(s_, 0x102); s_ += DPPF(s_, 0x104); s_ += DPPF(s_, 0x108); \
            civ[i] = p_; cmv[i] = s_ - lfv[i]; } } while (0)
#define HG_STAGE_V(c, N0, N1) do { u32x2 ri = N0, rg = N1; PIN2(ri); PIN2(rg); \
        { const int cn_ = (c) + 2 < T / 16 ? (c) + 2 : T / 16 - 1; const bf16* pn = pr0 + (size_t)cn_ * 16 * DIN; N0 = *(const u32x2*)(pn + C_HI); N1 = *(const u32x2*)(pn + C_HG); } \
        const f32x4 ix = {bflo(ri.x), bfhi(ri.x), bflo(ri.y), bfhi(ri.y)}, gx = {bflo(rg.x), bfhi(rg.x), bflo(rg.y), bfhi(rg.y)}; f32x4 vv; LAS bf16* VmT_ = VmTb + ((c) & 1) * 1536; \
        _Pragma("unroll") for (int i = 0; i < 4; ++i) { vv[i] = siluf_(ix[i]); sgn[i] = siluf_(gx[i]); } \
        { const u32x2 vp = pack4(vv); VmT_[(j4 + 0) * 24 + tt] = (bf16)(vp.x & 0xffffu); VmT_[(j4 + 1) * 24 + tt] = (bf16)(vp.x >> 16); VmT_[(j4 + 2) * 24 + tt] = (bf16)(vp.y & 0xffffu); VmT_[(j4 + 3) * 24 + tt] = (bf16)(vp.y >> 16); } } while (0)
#define HG_STAGE_B(c) do { f32x4 qh, kt, kb; \
        _Pragma("unroll") for (int i = 0; i < 4; ++i) { qh[i] = qv[i] * __expf(civ[i]); kt[i] = kkv[i] * __expf(fminf(-civ[i], 80.f)); kb[i] = kkv[i] * __expf(cmv[i]); } \
        *(LAS u32x2*)(Qh + tA * 72 + jA) = pack4(qh); *(LAS u32x2*)(Kt + tA * 72 + jA) = pack4(kt); \
        { const u32x2 kbp = pack4(kb); KbarT[(jA + 0) * 24 + tA] = (bf16)(kbp.x & 0xffffu); KbarT[(jA + 1) * 24 + tA] = (bf16)(kbp.x >> 16); KbarT[(jA + 2) * 24 + tA] = (bf16)(kbp.y & 0xffffu); KbarT[(jA + 3) * 24 + tA] = (bf16)(kbp.y >> 16); } \
        if (tA == 15) { f32x4 gc; _Pragma("unroll") for (int i = 0; i < 4; ++i) gc[i] = __expf(civ[i]); *(LAS f32x4*)(GamC + jA) = gc; } } while (0)
    if (wave < 4) HG_STAGE_A(0, n0a, n1a); else { HG_STAGE_V(0, n0a, n1a); sgc = sgn; }
    PIN2(n0b); PIN2(n1b);
    __syncthreads();
    if (wave < 4) HG_STAGE_B(0);
    __syncthreads();
    PIN2(n0a); PIN2(n1a);
    if (wave < 4) {
#pragma unroll 1
        for (int c = 0; c < T / 16; c += 2) { const int cn = c + 2 < T / 16 ? c + 2 : T / 16 - 1;
            HG_STAGE_A(c + 1, n0b, n1b); LDS_BARRIER(); HG_STAGE_B(c + 1); LDS_BARRIER();
            HG_STAGE_A(cn, n0a, n1a); LDS_BARRIER(); HG_STAGE_B(cn); LDS_BARRIER(); }
    } else {
#define HG_RO(c, cn, N0, N1) do { \
            { const int vt = wave - 4; const f32x4 z4 = {0.f, 0.f, 0.f, 0.f}; f32x4 AT = z4, o = z4; const LAS bf16* VmT_ = VmTb + ((c) & 1) * 1536; \
_Pragma("unroll")               for (int ks = 0; ks < 2; ++ks) AT = MF(*(const LAS bf16x8*)(Kt + r * 72 + ks * 32 + q * 8), *(const LAS bf16x8*)(Qh + r * 72 + ks * 32 + q * 8), AT);    \
_Pragma("unroll")               for (int i = 0; i < 4; ++i) AT[i] = (4 * q + i <= r) ? AT[i] : 0.f; \
              const u32x2 vmB = *(const LAS u32x2*)(VmT_ + (16 * vt + r) * 24 + 4 * q); const bf16x8 bV = cat8(vmB, (u32x2){0u, 0u}); \
_Pragma("unroll")               for (int ks = 0; ks < 2; ++ks) o = MF(cat8(*(const LAS u32x2*)(Qh + r * 72 + 32 * ks + 4 * q), *(const LAS u32x2*)(Qh + r * 72 + 32 * ks + 16 + 4 * q)), pack2(st[2 * ks], st[2 * ks + 1]), o); \
              o = MF(pack_lo(AT), bV, o); \
_Pragma("unroll")               for (int i = 0; i < 4; ++i) Oa[(4 * q + i) * 64 + 16 * vt + r] = o[i]; \
_Pragma("unroll")               for (int kt = 0; kt < 4; ++kt) { const f32x4 g4 = *(const LAS f32x4*)(GamC + 16 * kt + 4 * q); \
                  st[kt] = MF(cat8(*(const LAS u32x2*)(KbarT + (16 * kt + r) * 24 + 4 * q), (u32x2){0u, 0u}), bV, st[kt] * g4); } } \
            LDS_BARRIER(); \
            { const f32x4 o4 = *(const LAS f32x4*)(Oa + tt * 64 + j4); \
              const float ss = row16_sum((o4[0] * o4[0] + o4[1] * o4[1]) + (o4[2] * o4[2] + o4[3] * o4[3])); const float rs = __builtin_amdgcn_rsqf(ss * (1.f / 64.f) + 1e-6f); \
              *(u32x2*)(mix + ((size_t)b * T + (c) * 16 + tt) * D + hd * 64 + j4) = pack4(o4 * rs * nw * sgc); \
              HG_STAGE_V(cn, N0, N1); sgc = sgn; } \
            LDS_BARRIER(); \
    } while (0)
#pragma unroll 1
        for (int c = 0; c < T / 16; c += 2) { const int cn2 = c + 2 < T / 16 ? c + 2 : T / 16 - 1;
            HG_RO(c, c + 1, n0b, n1b); HG_RO(c + 1, cn2, n0a, n1a); }
#undef HG_RO
    }
#undef HG_STAGE_A
#undef HG_STAGE_V
#undef HG_STAGE_B
}

__device__ __forceinline__ f32x4 mma_tile(const LAS bf16* A, int lda, const LAS bf16* Bt, int ldb, int K, int lane) {
    f32x4 acc = {0.f, 0.f, 0.f, 0.f}; const int r = lane & 15, q = lane >> 4;
    for (int k0 = 0; k0 < K; k0 += 32) { const bf16x8 a = *(const LAS bf16x8*)(A + r * lda + k0 + q * 8); const bf16x8 b = *(const LAS bf16x8*)(Bt + r * ldb + k0 + q * 8);
        acc = __builtin_amdgcn_mfma_f32_16x16x32_bf16(a, b, acc, 0, 0, 0); }
    return acc;
}
__device__ __forceinline__ void lds_load_wT(const float* W, int ldw, int n0, int N, int K, LAS bf16* Wt, int ldt, int tid) {
#pragma unroll 2
    for (int idx = tid; idx < K * N; idx += NTHR) { const int k = idx / N, n = idx % N; Wt[n * ldt + k] = (bf16)f2bf(W[(size_t)k * ldw + n0 + n]); }
}

__device__ __forceinline__ void role_lru(const Params& P, int l, int b, int hd, LAS unsigned char* lds, int tid, int lane, int wave) {
    LAS float* XR = (LAS float*)lds; LAS float* LG = XR + 67 * 64; LAS float* XC = LG + 4096; LAS float* RL = XC + 4096; LAS float* GL = RL + 4096;
    LAS bf16* XCb = (LAS bf16*)(GL + 4096); LAS bf16* WaT = XCb + 64 * 72; LAS bf16* WxT = WaT + 64 * 72; LAS float* CWL = (LAS float*)(WxT + 64 * 72);
    const bf16* proj = (const bf16*)(P.ws + WS_PROJ); bf16* mix = (bf16*)(P.ws + WS_MIX);
    const int tt = tid >> 3, c8 = (tid & 7) * 8;
    lds_load_wT(P.in[I_LWA] + (size_t)(l * 4 + hd) * 4096, 64, 0, 64, 64, WaT, 72, tid);
    lds_load_wT(P.in[I_LWX] + (size_t)(l * 4 + hd) * 4096, 64, 0, 64, 64, WxT, 72, tid);
    if (tid < 320) { const int jj = tid >> 6, c = tid & 63; CWL[tid] = (jj < 4) ? P.in[I_LCW][(size_t)l * 4 * 256 + jj * 256 + hd * 64 + c] : P.in[I_LCB][l * 256 + hd * 64 + c]; }
    if (tid < 24) {
#pragma unroll
        for (int i = 0; i < 8; ++i) XR[(tid >> 3) * 64 + c8 + i] = 0.f; }
    float pba[2], pbx[2], pspl[2];
#pragma unroll
    for (int h2 = 0; h2 < 2; ++h2) { const int j = ((wave >> 2) * 2 + h2) * 16 + (lane & 15), c = l * 256 + hd * 64 + j; pba[h2] = P.in[I_LBA][c]; pbx[h2] = P.in[I_LBX][c]; pspl[h2] = log1pf(expf(-P.in[I_LLAM][c])); }
    float hstate = 0.f;
    const bf16* px = proj + ((size_t)b * T + tt) * DIN + C_LX + hd * 64 + c8; const bf16* pgp = proj + ((size_t)b * T + tt) * DIN + C_LG + hd * 64 + c8;
    u32x4 nx = ldg16(px), ngt = ldg16(pgp);
    PIN4(nx); PIN4(ngt);
    __syncthreads();
#pragma unroll 1
    for (int blk = 0; blk < T / 64; ++blk) {
        const int t0 = blk * 64;
        {   float x[8], g[8]; unpack8(nx, x); unpack8(ngt, g);
            { const int tn = (blk + 1 < T / 64) ? t0 + 64 : t0; nx = ldg16(px + (size_t)tn * DIN); ngt = ldg16(pgp + (size_t)tn * DIN); }
#pragma unroll
            for (int i = 0; i < 8; ++i) { XR[(tt + 3) * 64 + c8 + i] = x[i]; LG[tt * 64 + c8 + i] = g[i]; }
        }
        LDS_BARRIER();
        {   float xc[8];
#pragma unroll
            for (int i = 0; i < 8; ++i) { const int c = c8 + i; float a = CWL[256 + c];
#pragma unroll
                for (int jj = 0; jj < 4; ++jj) a += CWL[jj * 64 + c] * XR[(tt + jj) * 64 + c];
                XC[tt * 64 + c] = a; xc[i] = a; }
            u32x4 w; w.x = cvt2(xc[0], xc[1]); w.y = cvt2(xc[2], xc[3]); w.z = cvt2(xc[4], xc[5]); w.w = cvt2(xc[6], xc[7]); *(LAS u32x4*)(XCb + tt * 72 + c8) = w; }
        LDS_BARRIER();
        {   const int tt4 = wave & 3, r = lane & 15, q = lane >> 4;
#pragma unroll
            for (int h2 = 0; h2 < 2; ++h2) { const int nt = (wave >> 2) * 2 + h2, j = nt * 16 + r;
                const f32x4 ar = mma_tile(XCb + tt4 * 16 * 72, 72, WaT + nt * 16 * 72, 72, 64, lane), ag = mma_tile(XCb + tt4 * 16 * 72, 72, WxT + nt * 16 * 72, 72, 64, lane);
#pragma unroll
                for (int i = 0; i < 4; ++i) { const int t = tt4 * 16 + q * 4 + i; const float rr = sigmoidf_(ar[i] + pba[h2]), gi = sigmoidf_(ag[i] + pbx[h2]); const float la = -8.f * rr * pspl[h2];
                    const float e2 = __expf(2.f * la); RL[t * 64 + j] = __expf(la); GL[t * 64 + j] = sqrtf(1.f - e2) * gi * XC[t * 64 + j]; } }
            if (tid < 24) {
#pragma unroll
                for (int i = 0; i < 8; ++i) XR[(tid >> 3) * 64 + c8 + i] = XR[(64 + (tid >> 3)) * 64 + c8 + i]; }
        }
        LDS_BARRIER();
        if (tid < 64) {
#pragma unroll 8
            for (int t = 0; t < 64; ++t) { hstate = RL[t * 64 + tid] * hstate + GL[t * 64 + tid]; XC[t * 64 + tid] = hstate; } }
        LDS_BARRIER();
        {   u32x4 w; float o[8];
#pragma unroll
            for (int i = 0; i < 8; ++i) o[i] = gelu_tanh(LG[tt * 64 + c8 + i]) * XC[tt * 64 + c8 + i];
            w.x = cvt2(o[0], o[1]); w.y = cvt2(o[2], o[3]); w.z = cvt2(o[4], o[5]); w.w = cvt2(o[6], o[7]);
            *(u32x4*)(mix + ((size_t)b * T + t0 + tt) * D + 768 + hd * 64 + c8) = w; }
        LDS_BARRIER();
    }
}

__device__ __forceinline__ void s5_stage_u(const bf16* proj, int b, int g, int t0, LAS unsigned char* UL, int tid) {
#pragma unroll
    for (int rep = 0; rep < 4; ++rep) { const int tk = rep * 256 + (tid >> 1), half = tid & 1; const u32x4 v = ldg16(proj + ((size_t)b * T + t0 + tk) * DIN + C_SU + g * 16 + half * 8);
        const int cl = tk >> 4, s = tk & 15; *(LAS u32x4*)(UL + (cl >> 4) * 8192 + ((s * 16 + (cl & 15)) * 32 + half * 16)) = v; }
}
__device__ __forceinline__ void role_s5(const Params& P, int l, int b, int g, LAS unsigned char* lds, int tid, int lane, int wave) {
    LAS unsigned char* UL = lds; LAS unsigned char* XL = lds + 32768; LAS float* ES = (LAS float*)(lds + 49152);
    const bf16* proj = (const bf16*)(P.ws + WS_PROJ); bf16* yg = (bf16*)(P.ws + WS_YG);
    const unsigned char* sb = P.ws + WS_S5 + (size_t)l * S5_STRIDE;
    const bf16* F3 = (const bf16*)(sb + S5O_F3) + (size_t)g * 98304; const bf16* F1 = (const bf16*)(sb + S5O_F1) + (size_t)g * 32768; const float* A16 = (const float*)(sb + S5O_A16) + (size_t)g * 128;
    float* Hu = (float*)(P.ws + WS_HU) + (size_t)(b * 16 + g) * 512 * 128; float* Xs = (float*)(P.ws + WS_XS) + (size_t)(b * 16 + g) * 512 * 128;
    const int c16 = lane & 15, q = lane >> 4;
    {
        bf16x8 af[8];
#pragma unroll
        for (int ks = 0; ks < 8; ++ks) af[ks] = *(const bf16x8*)(F1 + ((size_t)(wave * 8 + ks) * 64 + lane) * 8);
#pragma unroll 1
        for (int it = 0; it < 8; ++it) {
            s5_stage_u(proj, b, g, it * 1024, UL, tid);
            __syncthreads();
#pragma unroll 1
            for (int ct = 0; ct < 4; ++ct) { f32x4 acc = {0.f, 0.f, 0.f, 0.f};
#pragma unroll
                for (int ks = 0; ks < 8; ++ks) { const bf16x8 bv = *(const LAS bf16x8*)(UL + ct * 8192 + (((2 * ks + (q >> 1)) * 16 + c16) * 32 + (q & 1) * 16)); acc = __builtin_amdgcn_mfma_f32_16x16x32_bf16(af[ks], bv, acc, 0, 0, 0); }
                *(f32x4*)(Hu + (size_t)(it * 64 + ct * 16 + c16) * 128 + 16 * wave + 4 * q) = acc; }
            __syncthreads();
        }
    }
    __threadfence(); __syncthreads();
    {
        const float ar = A16[lane * 2], ai = A16[lane * 2 + 1]; const float* hb = Hu + (size_t)(wave * 64) * 128; float xr = 0.f, xi = 0.f;
#pragma unroll 8
        for (int j = 0; j < 64; ++j) { const float hr = hb[j * 128 + lane], hi = hb[j * 128 + 64 + lane]; const float nr = ar * xr - ai * xi + hr, ni = ar * xi + ai * xr + hi; xr = nr; xi = ni; }
        ES[wave * 128 + lane] = xr; ES[wave * 128 + 64 + lane] = xi;
        __syncthreads();
        float pr = ar, pi = ai;
#pragma unroll
        for (int i = 0; i < 6; ++i) { const float nr = pr * pr - pi * pi, ni = 2.f * pr * pi; pr = nr; pi = ni; }
        float cr = 0.f, ci = 0.f;
        for (int w2 = 0; w2 < wave; ++w2) { const float er = ES[w2 * 128 + lane], ei = ES[w2 * 128 + 64 + lane]; const float nr = pr * cr - pi * ci + er, ni = pr * ci + pi * cr + ei; cr = nr; ci = ni; }
        xr = cr; xi = ci; float* xb = Xs + (size_t)(wave * 64) * 128;
#pragma unroll 8
        for (int j = 0; j < 64; ++j) { const float hr = hb[j * 128 + lane], hi = hb[j * 128 + 64 + lane]; xb[j * 128 + lane] = xr; xb[j * 128 + 64 + lane] = xi; const float nr = ar * xr - ai * xi + hr, ni = ar * xi + ai * xr + hi; xr = nr; xi = ni; }
    }
    __threadfence(); __syncthreads();
    {
        bf16x8 af[2][12];
#pragma unroll
        for (int r2 = 0; r2 < 2; ++r2)
#pragma unroll
            for (int ks = 0; ks < 12; ++ks) af[r2][ks] = *(const bf16x8*)(F3 + ((size_t)((2 * wave + r2) * 12 + ks) * 64 + lane) * 8);
        float dsk[4];
#pragma unroll
        for (int i = 0; i < 4; ++i) dsk[i] = P.in[I_S5D][l * 256 + g * 16 + 4 * q + i];
#pragma unroll 1
        for (int it = 0; it < 8; ++it) {
            s5_stage_u(proj, b, g, it * 1024, UL, tid);
#pragma unroll
            for (int rep = 0; rep < 4; ++rep) { const int cl = rep * 16 + (tid >> 5), n4 = (tid & 31) * 4; const f32x4 x = *(const f32x4*)(Xs + (size_t)(it * 64 + cl) * 128 + n4);
                u32x2 w; w.x = pk2(x.x, x.y); w.y = pk2(x.z, x.w);
                *(LAS u32x2*)(XL + (cl >> 4) * 4096 + ((((n4 >> 5) * 4 + ((n4 >> 3) & 3)) * 16 + (cl & 15)) * 16 + (n4 & 7) * 2)) = w; }
            __syncthreads();
#pragma unroll 1
            for (int ct = 0; ct < 4; ++ct) { f32x4 acc0 = {0.f, 0.f, 0.f, 0.f}, acc1 = {0.f, 0.f, 0.f, 0.f};
#pragma unroll
                for (int ks = 0; ks < 8; ++ks) { const bf16x8 bv = *(const LAS bf16x8*)(UL + ct * 8192 + (((2 * ks + (q >> 1)) * 16 + c16) * 32 + (q & 1) * 16));
                    acc0 = __builtin_amdgcn_mfma_f32_16x16x32_bf16(af[0][ks], bv, acc0, 0, 0, 0); acc1 = __builtin_amdgcn_mfma_f32_16x16x32_bf16(af[1][ks], bv, acc1, 0, 0, 0); }
#pragma unroll
                for (int ks = 0; ks < 4; ++ks) { const bf16x8 bv = *(const LAS bf16x8*)(XL + ct * 4096 + ((ks * 4 + q) * 16 + c16) * 16);
                    acc0 = __builtin_amdgcn_mfma_f32_16x16x32_bf16(af[0][8 + ks], bv, acc0, 0, 0, 0); acc1 = __builtin_amdgcn_mfma_f32_16x16x32_bf16(af[1][8 + ks], bv, acc1, 0, 0, 0); }
#pragma unroll
                for (int r2 = 0; r2 < 2; ++r2) { const int t = 2 * wave + r2; const f32x4 acc = r2 ? acc1 : acc0;
                    const u32x2 uw = *(const LAS u32x2*)(UL + ct * 8192 + ((t * 16 + c16) * 32 + (4 * q) * 2));
                    const float y0 = gelu_tanh(acc[0] + dsk[0] * bflo(uw.x)), y1 = gelu_tanh(acc[1] + dsk[1] * bfhi(uw.x)), y2 = gelu_tanh(acc[2] + dsk[2] * bflo(uw.y)), y3 = gelu_tanh(acc[3] + dsk[3] * bfhi(uw.y));
                    u32x2 o; o.x = pk2(y0, y1); o.y = pk2(y2, y3);
                    *(u32x2*)(yg + ((size_t)b * T + it * 1024 + (ct * 16 + c16) * 16 + t) * 256 + g * 16 + 4 * q) = o; } }
            __syncthreads();
        }
    }
}

__device__ __forceinline__ void rw_load8(const bf16* cur, const bf16* prev, const float* mu, float (&o)[8]) {
    float p[8], q[8]; unpack8(ldg16(cur), p);
    if (prev) unpack8(ldg16(prev), q); else {
#pragma unroll
        for (int i = 0; i < 8; ++i) q[i] = 0.f; }
    const f32x4 m0 = *(const f32x4*)mu, m1 = *(const f32x4*)(mu + 4);
#pragma unroll
    for (int i = 0; i < 4; ++i) { o[i] = p[i] + m0[i] * (q[i] - p[i]); o[4 + i] = p[4 + i] + m1[i] * (q[4 + i] - p[4 + i]); }
}
__device__ __forceinline__ void rw_mix8(const u32x4 c, const u32x4 pv, const LAS float* mu, float (&o)[8]) {
    float p[8], q[8]; unpack8(c, p); unpack8(pv, q);
    const f32x4 m0 = *(const LAS f32x4*)mu, m1 = *(const LAS f32x4*)(mu + 4);
#pragma unroll
    for (int i = 0; i < 4; ++i) { o[i] = p[i] + m0[i] * (q[i] - p[i]); o[4 + i] = p[4 + i] + m1[i] * (q[4 + i] - p[4 + i]); }
}
__device__ __forceinline__ void st8f(LAS float* d, const float (&o)[8]) { *(LAS f32x4*)d = (f32x4){o[0], o[1], o[2], o[3]}; *(LAS f32x4*)(d + 4) = (f32x4){o[4], o[5], o[6], o[7]}; }
__device__ __forceinline__ void st8b(LAS bf16* d, const float (&o)[8]) { u32x4 w; w.x = cvt2(o[0], o[1]); w.y = cvt2(o[2], o[3]); w.z = cvt2(o[4], o[5]); w.w = cvt2(o[6], o[7]); *(LAS u32x4*)d = w; }
constexpr int RW_SLAB = 64, RW_NSLAB = 8, RW_RING = 3, RW_RUN = 8;
constexpr size_t RWB_STRIDE = 18944;
constexpr int RWB_WQ = 0, RWB_BB = 4096, RWB_KB = 6144, RWB_VM = 8192, RWB_GC = 10240, RWB_W2 = 10496, RWB_YL = 12544, RWB_G = 14592, RWB_BON = 16640;
constexpr int CW_TMO = 64, CW_RWP = 16384, CW_RWC = 32768;
static_assert((size_t)32 * RW_RING * RW_SLAB * RWB_STRIDE <= (size_t)128 * MiB, "bundle ring fits the ACT buffer");
__device__ __forceinline__ unsigned char* rw_bundle(const Params& P, int seq, int chunk) { return P.ws + WS_ACT + (size_t)((seq * RW_RING + ((chunk >> 6) % RW_RING)) * RW_SLAB + (chunk & 63)) * RWB_STRIDE; }
#define RLX_AGENT __ATOMIC_RELAXED, __HIP_MEMORY_SCOPE_AGENT
__device__ __forceinline__ void st_wt8(void* p, u32x2 v) { __hip_atomic_store((unsigned long long*)p, (unsigned long long)v.x | ((unsigned long long)v.y << 32), RLX_AGENT); }
__device__ __forceinline__ void wait_ge(unsigned* word, unsigned want, unsigned* tmo) {
    unsigned spins = 0;
    while ((unsigned)__builtin_amdgcn_readfirstlane(__hip_atomic_load(word, RLX_AGENT)) < want) {
        __builtin_amdgcn_s_sleep(2);
        if (++spins > (1u << 20)) { __hip_atomic_store(tmo, 1u, RLX_AGENT); break; }
        if ((spins & 1023u) == 0u && __builtin_amdgcn_readfirstlane(__hip_atomic_load(tmo, RLX_AGENT))) break;
    }
}
__device__ __forceinline__ void rwkv_producer(const Params& P, int l, int hd, int gp, int NPG, LAS unsigned char* lds, int tid, int lane, int wave) {
    unsigned* ctl = (unsigned*)(P.ws + WS_CTL);
    LAS bf16* W2T = (LAS bf16*)lds;
    LAS bf16* A2T = W2T + 64 * 72;
    LAS bf16* G2T = A2T + 64 * 72;
    LAS bf16* V1T = G2T + 64 * 136;
    LAS bf16* V2T = V1T + 32 * 264;
    LAS bf16* TWD = V2T + 64 * 40;
    LAS bf16* ADb = TWD + 16 * 72;
    LAS bf16* SGD = ADb + 16 * 72;
    LAS bf16* VALb = SGD + 16 * 136;
    LAS bf16* VHb = VALb + 16 * 264;
    LAS float* R = (LAS float*)(VHb + 16 * 40); LAS float* K = R + 1024; LAS float* V = K + 1024; LAS float* WL = V + 1024; LAS float* KK = WL + 1024; LAS float* Bb = KK + 1024;
    LAS float* G = Bb + 1024; LAS float* Y = G + 1024; LAS float* RK = Y + 1024  ; LAS float* AL = RK + 16; LAS float* VG = AL + 1024;
    LAS bf16* KKh = TWD; LAS bf16* Rh = KKh + 16 * 72; LAS bf16* Bt = Rh + 16 * 72; LAS bf16* Kt = Bt + 16 * 72; LAS bf16* BbarT = Kt + 16 * 72; LAS bf16* KbarT = BbarT + 64 * 24;
    LAS bf16* VmT = (LAS bf16*)AL; LAS bf16* KKhT = VmT + 64 * 24; LAS bf16* RhT = KKhT + 64 * 24; LAS float* GamC = (LAS float*)(RhT + 64 * 24); LAS bf16* WQ = (LAS bf16*)(GamC + 64); LAS float* MU = (LAS float*)(WQ + 32 * 72); LAS float* PT = MU + 1024;
    const bf16* proj = (const bf16*)(P.ws + WS_PROJ); bf16* mix = (bf16*)(P.ws + WS_MIX); bf16* vf = (bf16*)(P.ws + WS_VF);
    const float* mu_base = P.in[I_RMU] + (size_t)l * 1024;
    lds_load_wT(P.in[I_RW2] + (size_t)l * 64 * 256, 256, hd * 64, 64, 64, W2T, 72, tid);
    lds_load_wT(P.in[I_RA2] + (size_t)l * 64 * 256, 256, hd * 64, 64, 64, A2T, 72, tid);
    lds_load_wT(P.in[I_RG2] + (size_t)l * 128 * 256, 256, hd * 64, 64, 128, G2T, 136, tid);
    if (l > 0) { lds_load_wT(P.in[I_RV1], 32, 0, 32, 256, V1T, 264, tid); lds_load_wT(P.in[I_RV2], 256, hd * 64, 64, 32, V2T, 40, tid); }
    const int tt0 = tid >> 5, l320 = tid & 31;
    for (int i = tid; i < 1024; i += NTHR) MU[i] = mu_base[i];
    if (tid < 64) { const int c = l * 256 + hd * 64 + tid; PT[tid] = P.in[I_RW0][c]; PT[64 + tid] = P.in[I_RA0][c]; PT[128 + tid] = P.in[I_RKK][c]; PT[192 + tid] = P.in[I_RKA][c]; PT[256 + tid] = P.in[I_RRK][c];
        PT[320 + tid] = (l > 0) ? P.in[I_RV0][hd * 64 + tid] : 0.f; PT[384 + tid] = P.in[I_RLNW][c]; PT[448 + tid] = P.in[I_RLNB][c]; }
    const int segA = l320 >> 3, chA = l320 & 7, colA = (segA == 0 ? hd * 64 : segA == 1 ? 256 + hd * 64 : segA == 2 ? 768 : 832) + chA * 8, colB = 896 + (l320 & 15) * 8;
    const bool hasB = l320 < 16, hasC = (l > 0) || (l320 >= 16 && l320 < 24); const int colC = (l > 0) ? 512 + l320 * 8 : 512 + hd * 64 + (l320 & 7) * 8;
    const u32x4 zero4 = {0u, 0u, 0u, 0u};
    __syncthreads();
    const int nun = (NPG == 40) ? (gp < 32 ? 12 : gp < 40 ? 13 : 3) : 0;
#pragma unroll 1
    for (int k = 0; ; ++k) { int u;
        if (NPG == 40) { if (k >= nun) break; u = (gp >= 40) ? 488 + 8 * k + (gp - 40) : (k < 12 ? gp + 40 * k : 480 + (gp - 32)); }
        else { u = gp + k * NPG; if (u >= 512) break; }
    const int slab = u >> 6, b = (u >> 3) & 7, run = u & 7, seq = b * 4 + hd, cfirst = slab * RW_SLAB + run * RW_RUN;
    if (slab >= RW_RING) { if (wave == 0) wait_ge(ctl + CW_RWC + l * 1024 + seq * 16, (unsigned)(slab - RW_RING + 1), ctl + CW_TMO); __syncthreads(); }
    const bf16* rowp = proj + ((size_t)b * T + tt0) * DIN + C_RW; const bf16* vfp = vf + ((size_t)b * T + tt0) * 256 + hd * 64 + l320 * 2;
    u32x4 nAc, nAp, nBc = zero4, nBp = zero4, nCc = zero4, nCp = zero4; unsigned nvf = 0u;
    {   const bf16* rn = rowp + (size_t)(cfirst * 16) * DIN; const bool hp = (cfirst * 16 + tt0) > 0;
        nAc = ldg16(rn + colA); nAp = hp ? ldg16(rn - DIN + colA) : zero4;
        if (hasB) { nBc = ldg16(rn + colB); nBp = hp ? ldg16(rn - DIN + colB) : zero4; }
        if (hasC) { nCc = ldg16(rn + colC); nCp = hp ? ldg16(rn - DIN + colC) : zero4; }
        if (l > 0) nvf = *(const unsigned*)(vfp + (size_t)(cfirst * 16) * 256); }
#pragma unroll 1
    for (int blk = cfirst; blk < cfirst + RW_RUN; ++blk) {
        const int t0 = blk * 16; int tidl = tid; asm volatile("" : "+v"(tidl));
        const int tt = tidl >> 5, l32 = tidl & 31, lane = tidl & 63;
        const u32x4 rAc = nAc, rAp = nAp, rBc = nBc, rBp = nBp, rCc = nCc, rCp = nCp; const unsigned rvf = nvf;
        if (blk + 1 < cfirst + RW_RUN) { const bf16* rn = rowp + (size_t)(t0 + 16) * DIN;
            nAc = ldg16(rn + colA); nAp = ldg16(rn - DIN + colA);
            if (hasB) { nBc = ldg16(rn + colB); nBp = ldg16(rn - DIN + colB); }
            if (hasC) { nCc = ldg16(rn + colC); nCp = ldg16(rn - DIN + colC); }
            if (l > 0) nvf = *(const unsigned*)(vfp + (size_t)(t0 + 16) * 256); }
        unsigned char* bp = rw_bundle(P, seq, blk);
        {   float o[8];
            rw_mix8(rAc, rAp, MU + colA, o);
            if (segA == 0) st8f(R + tt * 64 + chA * 8, o); else if (segA == 1) st8f(K + tt * 64 + chA * 8, o);
            else if (segA == 2) {
#pragma unroll
                for (int i = 0; i < 8; ++i) { const float e = __expf(2.f * o[i]); o[i] = 1.f - 2.f * frcp(e + 1.f); }
                st8b(TWD + tt * 72 + chA * 8, o); }
            else st8b(ADb + tt * 72 + chA * 8, o);
            if (hasB) { rw_mix8(rBc, rBp, MU + colB, o);
#pragma unroll
                for (int i = 0; i < 8; ++i) o[i] = sigmoidf_(o[i]);
                st8b(SGD + tt * 136 + (l32 & 15) * 8, o); }
            if (hasC) { rw_mix8(rCc, rCp, MU + colC, o);
                if (l == 0) st8f(V + tt * 64 + (l32 & 7) * 8, o);
                else { st8b(VALb + tt * 264 + l32 * 8, o); if ((l32 >> 3) == hd) st8f(V + tt * 64 + (l32 & 7) * 8, o); } }
        }
        LDS_BARRIER();
        {   const int r = lane & 15, q = lane >> 4;
            if (wave < 4) { const f32x4 cw_ = mma_tile(TWD, 72, W2T + wave * 16 * 72, 72, 64, lane), ca = mma_tile(ADb, 72, A2T + wave * 16 * 72, 72, 64, lane);
#pragma unroll
                for (int i = 0; i < 4; ++i) { WL[(q * 4 + i) * 64 + wave * 16 + r] = cw_[i]; AL[(q * 4 + i) * 64 + wave * 16 + r] = ca[i]; }
                if (l > 0 && wave < 2) { const f32x4 ch_ = mma_tile(VALb, 264, V1T + wave * 16 * 264, 264, 256, lane);
#pragma unroll
                    for (int i = 0; i < 4; ++i) VHb[(q * 4 + i) * 40 + wave * 16 + r] = (bf16)f2bf(ch_[i]); } }
            else { const int nt = wave - 4; const f32x4 cg = mma_tile(SGD, 136, G2T + nt * 16 * 136, 136, 128, lane);
#pragma unroll
                for (int i = 0; i < 4; ++i) G[(q * 4 + i) * 64 + nt * 16 + r] = cg[i]; }
        }
        LDS_BARRIER();
        if (l > 0) {
            if (wave < 4) { const int r = lane & 15, q = lane >> 4; const f32x4 cv = mma_tile(VHb, 40, V2T + wave * 16 * 40, 40, 32, lane);
#pragma unroll
                for (int i = 0; i < 4; ++i) VG[(q * 4 + i) * 64 + wave * 16 + r] = cv[i]; }
            LDS_BARRIER();
        }
        {   const int j2 = l32 * 2; float ssq = 0.f, rk = 0.f; float kkv[2], av[2], vv2[2];
            const size_t tok = (size_t)b * T + t0 + tt;
#pragma unroll
            for (int i = 0; i < 2; ++i) { const int j = j2 + i, x = tt * 64 + j;
                const float wl = -softplusf_(-(PT[j] + WL[x])) - 0.5f; WL[x] = -__expf(wl);
                const float a = sigmoidf_(PT[64 + j] + AL[x]); av[i] = a;
                const float kr = K[x]; kkv[i] = kr * PT[128 + j]; ssq += kkv[i] * kkv[i];
                const float km = kr * (1.f + (a - 1.f) * PT[192 + j]); K[x] = km;
                float v = V[x];
                if (l > 0) { const float vfv = i ? bfhi(rvf) : bflo(rvf); v = v + (vfv - v) * sigmoidf_(PT[320 + j] + VG[x]); V[x] = v; }
                vv2[i] = v;
                rk += R[x] * km * PT[256 + j]; }
            if (l == 0) *(unsigned*)(vf + tok * 256 + hd * 64 + j2) = cvt2(vv2[0], vv2[1]);
            ssq = half_sum(ssq, lane); rk = half_sum(rk, lane);
            const float inv = frcp(fmaxf(sqrtf(ssq), 1e-12f));
#pragma unroll
            for (int i = 0; i < 2; ++i) { const int x = tt * 64 + j2 + i; const float kn = kkv[i] * inv; KK[x] = kn; Bb[x] = kn * av[i]; }
            if (l32 == 0) RK[tt] = rk;
        }
        LDS_BARRIER();
        {   const int j2 = l32 * 2; float ce0 = 0.f, ce1 = 0.f, ct0 = 0.f, ct1 = 0.f;
#pragma unroll
            for (int s2 = 0; s2 < 16; ++s2) { const f32x2 w2 = *(const LAS f32x2*)(WL + s2 * 64 + j2); if (s2 < tt) { ce0 += w2.x; ce1 += w2.y; } ct0 += w2.x; ct1 += w2.y; }
            const f32x2 wme = *(const LAS f32x2*)(WL + tt * 64 + j2); const float ci0 = ce0 + wme.x, ci1 = ce1 + wme.y;
            const float ex0 = __expf(ce0), ex1 = __expf(ce1), in0 = __expf(ci0), in1 = __expf(ci1), ng0 = __expf(-ci0), ng1 = __expf(-ci1), br0 = __expf(ct0 - ci0), br1 = __expf(ct1 - ci1);
            const int x = tt * 64 + j2; const f32x2 kk2 = *(const LAS f32x2*)(KK + x), r2 = *(const LAS f32x2*)(R + x), b2 = *(const LAS f32x2*)(Bb + x), k2 = *(const LAS f32x2*)(K + x), v2_ = *(const LAS f32x2*)(V + x);
            const unsigned kkh = cvt2(kk2.x * ex0, kk2.y * ex1), rh = cvt2(r2.x * in0, r2.y * in1);
            *(LAS unsigned*)(KKh + tt * 72 + j2) = kkh; *(LAS unsigned*)(Rh + tt * 72 + j2) = rh;
            *(LAS unsigned*)(Bt + tt * 72 + j2) = cvt2(b2.x * ng0, b2.y * ng1); *(LAS unsigned*)(Kt + tt * 72 + j2) = cvt2(k2.x * ng0, k2.y * ng1);
            KKhT[j2 * 24 + tt] = (bf16)(kkh & 0xffffu); KKhT[(j2 + 1) * 24 + tt] = (bf16)(kkh >> 16); RhT[j2 * 24 + tt] = (bf16)(rh & 0xffffu); RhT[(j2 + 1) * 24 + tt] = (bf16)(rh >> 16);
            { const unsigned bb = cvt2(b2.x * br0, b2.y * br1), kb = cvt2(k2.x * br0, k2.y * br1); BbarT[j2 * 24 + tt] = (bf16)(bb & 0xffffu); BbarT[(j2 + 1) * 24 + tt] = (bf16)(bb >> 16); KbarT[j2 * 24 + tt] = (bf16)(kb & 0xffffu); KbarT[(j2 + 1) * 24 + tt] = (bf16)(kb >> 16); }
            { const unsigned vv = cvt2(v2_.x, v2_.y); VmT[j2 * 24 + tt] = (bf16)(vv & 0xffffu); VmT[(j2 + 1) * 24 + tt] = (bf16)(vv >> 16); }
            if (tt == 0) { GamC[j2] = __expf(ct0); GamC[j2 + 1] = __expf(ct1); }
        }
        LDS_BARRIER();
        u32x2 vmB = {0u, 0u};
        {   const int r = lane & 15, q = lane >> 4; const f32x4 z4 = {0.f, 0.f, 0.f, 0.f};
            f32x4 NT = z4, Nn = z4, ArbT = z4;
#pragma unroll
            for (int ks = 0; ks < 2; ++ks) { const bf16x8 fb = *(const LAS bf16x8*)(Bt + r * 72 + ks * 32 + q * 8), fk = *(const LAS bf16x8*)(KKh + r * 72 + ks * 32 + q * 8), fr = *(const LAS bf16x8*)(Rh + r * 72 + ks * 32 + q * 8);
                NT = MF(fb, fk, NT); Nn = MF(fk, fb, Nn); ArbT = MF(fb, fr, ArbT); }
#pragma unroll
            for (int i = 0; i < 4; ++i) { const int rr = 4 * q + i; NT[i] = (rr < r) ? NT[i] : 0.f; Nn[i] = (r < rr) ? Nn[i] : 0.f; ArbT[i] = (rr <= r) ? ArbT[i] : 0.f; }
            const f32x4 N2 = MF(pack_lo(NT), pack_lo(Nn), z4), N2T = MF(pack_lo(Nn), pack_lo(NT), z4);
            const f32x4 N4 = MF(pack_lo(N2T), pack_lo(N2), z4), N4T = MF(pack_lo(N2), pack_lo(N2T), z4);
            const f32x4 N8T = MF(pack_lo(N4), pack_lo(N4T), z4);
            const bf16x8 aN8 = pack_lo(N8T), aN4 = pack_lo(N4T), aN2 = pack_lo(N2T), aN1 = pack_lo(-NT);
            if (wave < 4) {
                const int kt = wave; const u32x2 zb = *(const LAS u32x2*)(KKhT + (16 * kt + r) * 24 + 4 * q);
                f32x4 z = {bflo(zb.x), bfhi(zb.x), bflo(zb.y), bfhi(zb.y)};
                z = MF(aN8, pack_lo(z), z); z = MF(aN4, pack_lo(z), z); z = MF(aN2, pack_lo(z), z); z = MF(aN1, pack_lo(z), z);
                const u32x2 rb = *(const LAS u32x2*)(RhT + (16 * kt + r) * 24 + 4 * q); const f32x4 rc = {bflo(rb.x), bfhi(rb.x), bflo(rb.y), bfhi(rb.y)};
                const f32x4 qe = MF(pack_lo(-ArbT), pack_lo(z), rc);
#pragma unroll
                for (int i = 0; i < 4; ++i) { WQ[(4 * q + i) * 72 + 16 * kt + r] = (bf16)f2bf(z[i]); WQ[(16 + 4 * q + i) * 72 + 16 * kt + r] = (bf16)f2bf(qe[i]); }
            } else {
                const int vt = wave - 4; f32x4 AakT = z4, ArkT = z4;
#pragma unroll
                for (int ks = 0; ks < 2; ++ks) { const bf16x8 fkt = *(const LAS bf16x8*)(Kt + r * 72 + ks * 32 + q * 8), fk = *(const LAS bf16x8*)(KKh + r * 72 + ks * 32 + q * 8), fr = *(const LAS bf16x8*)(Rh + r * 72 + ks * 32 + q * 8);
                    AakT = MF(fkt, fk, AakT); ArkT = MF(fkt, fr, ArkT); }
#pragma unroll
                for (int i = 0; i < 4; ++i) { const int rr = 4 * q + i; AakT[i] = (rr < r) ? AakT[i] : 0.f; ArkT[i] = (rr <= r) ? ArkT[i] : 0.f; }
                vmB = *(const LAS u32x2*)(VmT + (16 * vt + r) * 24 + 4 * q);
                f32x4 z = MF(pack_lo(AakT), cat8(vmB, (u32x2){0u, 0u}), z4);
                z = MF(aN8, pack_lo(z), z); z = MF(aN4, pack_lo(z), z); z = MF(aN2, pack_lo(z), z); z = MF(aN1, pack_lo(z), z);
                const f32x4 yl_ = MF(pack2(ArkT, -ArbT), cat8(vmB, pack4(z)), z4);
                st_wt8(bp + RWB_W2 + (vt * 64 + lane) * 8, pack4(z)); st_wt8(bp + RWB_YL + (vt * 64 + lane) * 8, pack4(yl_));
            }
        }
        LDS_BARRIER();
        {
            { const int row = tidl >> 4, pc = tidl & 15, rr = row & 15, half = row >> 4, ks = pc >> 3, hi = (pc >> 2) & 1, qq = pc & 3;
              st_wt8(bp + RWB_WQ + (((2 * ks + half) * 64 + qq * 16 + rr) * 2 + hi) * 8, *(const LAS u32x2*)(WQ + row * 72 + pc * 4)); }
            for (int idx = tidl; idx < 768; idx += NTHR) { const int arr = idx >> 8, pi = idx & 255, row = pi >> 2, pc = pi & 3; const LAS bf16* src = (arr == 0 ? BbarT : arr == 1 ? KbarT : VmT) + row * 24 + pc * 4;
                const int ln = pc * 16 + (row & 15), t4 = row >> 4;
                st_wt8(bp + (arr < 2 ? RWB_BB + ((t4 * 64 + ln) * 2 + arr) * 8 : RWB_VM + (t4 * 64 + ln) * 8), *(const LAS u32x2*)src); }
            if (tidl < 32) st_wt8(bp + RWB_GC + tidl * 8, *(const LAS u32x2*)(GamC + tidl * 2));
            if (tidl < 256) { const int t = tidl >> 4, v4 = (tidl & 15) * 4; const f32x4 g4 = *(const LAS f32x4*)(G + t * 64 + v4); const f32x4 v4f = *(const LAS f32x4*)(V + t * 64 + v4); const float rkt = RK[t];
                st_wt8(bp + RWB_G + (t * 64 + v4) * 2, pack4(g4)); st_wt8(bp + RWB_BON + (t * 64 + v4) * 2, pack4(v4f * rkt)); }
        }
        LDS_BARRIER();
    }
    asm volatile("s_waitcnt vmcnt(0)" ::: "memory");
    __syncthreads();
    if (tid == 0) __hip_atomic_fetch_add(ctl + CW_RWP + l * 4096 + (seq * 8 + slab) * 16, 1u, RLX_AGENT);
    }
}
struct RwOps { u32x4 w[4]; u32x4 bk[4]; u32x2 vm, w2, yl; f32x4 gc[4]; };
__device__ __forceinline__ void rw_ops_load(RwOps& o, const unsigned char* bp, int vt, int r, int q, int lane) {
#pragma unroll
    for (int f = 0; f < 4; ++f) { o.w[f] = *(const u32x4*)(bp + RWB_WQ + (f * 64 + lane) * 16); o.bk[f] = *(const u32x4*)(bp + RWB_BB + (f * 64 + lane) * 16); o.gc[f] = *(const f32x4*)(bp + RWB_GC + (16 * f + 4 * q) * 4); }
    o.vm = *(const u32x2*)(bp + RWB_VM + (vt * 64 + lane) * 8); o.w2 = *(const u32x2*)(bp + RWB_W2 + (vt * 64 + lane) * 8); o.yl = *(const u32x2*)(bp + RWB_YL + (vt * 64 + lane) * 8);
}
__device__ __forceinline__ void rw_ops_load_lds(RwOps& o, const LAS unsigned char* sp, int vt, int q, int lane) {
#pragma unroll
    for (int f = 0; f < 4; ++f) { o.w[f] = *(const LAS u32x4*)(sp + RWB_WQ + (f * 64 + lane) * 16); o.bk[f] = *(const LAS u32x4*)(sp + RWB_BB + (f * 64 + lane) * 16); o.gc[f] = *(const LAS f32x4*)(sp + RWB_GC + (16 * f + 4 * q) * 4); }
    o.vm = *(const LAS u32x2*)(sp + RWB_VM + (vt * 64 + lane) * 8); o.w2 = *(const LAS u32x2*)(sp + RWB_W2 + (vt * 64 + lane) * 8); o.yl = *(const LAS u32x2*)(sp + RWB_YL + (vt * 64 + lane) * 8);
}
constexpr int RWL_N = 6, RWL_D = 6, RWL_SLOT = 20480;
static_assert(8192 + RWL_N * RWL_SLOT <= 131072, "consumer LDS ring");
__device__ __forceinline__ void rwkv_consumer(const Params& P, int l, int b, int hd, LAS unsigned char* lds, int tid, int lane, int wave) {
    LAS float* Yb = (LAS float*)lds;
    LAS unsigned char* ring = lds + 8192;
    unsigned* ctl = (unsigned*)(P.ws + WS_CTL); const int seq = b * 4 + hd;
    unsigned* prod = ctl + CW_RWP + l * 4096 + seq * 8 * 16; unsigned* cons = ctl + CW_RWC + l * 1024 + seq * 16; unsigned* tmo = ctl + CW_TMO;
    bf16* mix = (bf16*)(P.ws + WS_MIX);
    const int r = lane & 15, q = lane >> 4, vt = wave & 3;
    f32x4 st[4];
#pragma unroll
    for (int i = 0; i < 4; ++i) st[i] = (f32x4){0.f, 0.f, 0.f, 0.f};
    const int ot = (tid >> 4) & 15, ov4 = (tid & 15) * 4;
    f32x4 lnw = *(const f32x4*)(P.in[I_RLNW] + l * 256 + hd * 64 + ov4), lnb = *(const f32x4*)(P.in[I_RLNB] + l * 256 + hd * 64 + ov4);
    if (wave == 0) { wait_ge(prod, (unsigned)RW_RUN, tmo); __builtin_amdgcn_fence(__ATOMIC_ACQUIRE, "agent"); asm volatile("s_waitcnt vmcnt(0)" ::: "memory"); }
    __syncthreads();
    RwOps opA, opB; u32x2 gA = {0u, 0u}, bA = gA, gB = gA, bB = gA;
#define RW_DMA(X, SL) do { const unsigned char* bp_ = rw_bundle(P, seq, (X)); LAS unsigned char* sl_ = ring + (SL) * RWL_SLOT; \
        _Pragma("unroll") for (int rd = 0; rd < 5; ++rd) __builtin_amdgcn_global_load_lds((const unsigned*)(bp_ + (size_t)(rd * 256 + wave * 64 + lane) * 16), (LAS unsigned*)(sl_ + (rd * 256 + wave * 64) * 16), 16, 0, 0); } while (0)
    if (wave < 4) {
#pragma unroll
        for (int x = 0; x < RWL_D; ++x) RW_DMA(x, x); }
    asm volatile("s_waitcnt vmcnt(0)" ::: "memory");
    __syncthreads();
    if (wave >= 4) { rw_ops_load_lds(opA, ring, vt, q, lane); rw_ops_load_lds(opB, ring + RWL_SLOT, vt, q, lane); }
    else { gA = *(const LAS u32x2*)(ring + RWB_G + (ot * 64 + ov4) * 2); bA = *(const LAS u32x2*)(ring + RWB_BON + (ot * 64 + ov4) * 2); PIN4(lnw); PIN4(lnb); }
    u32x2* const dummy = (u32x2*)(P.ws + WS_LG) + tid;
#define RW_OUT(cp, GG, BN, DST) do { \
        const f32x4 y = *(const LAS f32x4*)(Yb + ((cp) & 1) * 1024 + ot * 64 + ov4); \
        const float mean = row16_sum((y[0] + y[1]) + (y[2] + y[3])) * (1.f / 64.f); const f32x4 d = y - mean; \
        const float var = row16_sum((d[0] * d[0] + d[1] * d[1]) + (d[2] * d[2] + d[3] * d[3])) * (1.f / 64.f); const float rs = __builtin_amdgcn_rsqf(var + 64e-5f); \
        const f32x4 o = (d * rs * lnw + lnb + (BN)) * (GG); \
        *(DST) = pack4(o); } while (0)
#define RW_SLABCHK(c) do { if ((((c) + RWL_D) & 63) == 0 && (c) + RWL_D < T / 16) { \
            if (wave == 0) { wait_ge(prod + (((c) + RWL_D) >> 6) * 16, (unsigned)RW_RUN, tmo); __builtin_amdgcn_fence(__ATOMIC_ACQUIRE, "agent"); asm volatile("s_waitcnt vmcnt(0)" ::: "memory"); } \
            __syncthreads(); } } while (0)
#define RW_REC(c, OP) do { RW_SLABCHK(c); \
            f32x4 d1 = {0.f, 0.f, 0.f, 0.f}, d2 = {0.f, 0.f, 0.f, 0.f}; \
            _Pragma("unroll") for (int ks = 0; ks < 2; ++ks) { const bf16x8 bS = pack2(st[2 * ks], st[2 * ks + 1]); d1 = MF(__builtin_bit_cast(bf16x8, OP.w[2 * ks]), bS, d1); d2 = MF(__builtin_bit_cast(bf16x8, OP.w[2 * ks + 1]), bS, d2); } \
            const f32x4 w2f = {bflo(OP.w2.x), bfhi(OP.w2.x), bflo(OP.w2.y), bfhi(OP.w2.y)}, ylf = {bflo(OP.yl.x), bfhi(OP.yl.x), bflo(OP.yl.y), bfhi(OP.yl.y)}; \
            const f32x4 un = -(d1 + w2f), yv = d2 + ylf; \
            LAS float* Y = Yb + ((c) & 1) * 1024; \
            _Pragma("unroll") for (int i = 0; i < 4; ++i) Y[(4 * q + i) * 64 + 16 * vt + r] = yv[i]; \
            const bf16x8 bUV = cat8(pack4(un), OP.vm); \
            _Pragma("unroll") for (int kt = 0; kt < 4; ++kt) st[kt] = MF(__builtin_bit_cast(bf16x8, OP.bk[kt]), bUV, st[kt] * OP.gc[kt]); \
            { const int cl_ = (c) + 2 < T / 16 ? (c) + 2 : T / 16 - 1; rw_ops_load_lds(OP, ring + (cl_ % RWL_N) * RWL_SLOT, vt, q, lane); } \
            LDS_BARRIER(); } while (0)
#define RW_OSTEP(c, GP, BP) do { RW_SLABCHK(c); \
            const f32x4 gg = {bflo(GP.x), bfhi(GP.x), bflo(GP.y), bfhi(GP.y)}, bn = {bflo(BP.x), bfhi(BP.x), bflo(BP.y), bfhi(BP.y)}; \
            { const int cn_ = (c) + 1 < T / 16 ? (c) + 1 : T / 16 - 1; const LAS unsigned char* sp_ = ring + (cn_ % RWL_N) * RWL_SLOT; GP = *(const LAS u32x2*)(sp_ + RWB_G + (ot * 64 + ov4) * 2); BP = *(const LAS u32x2*)(sp_ + RWB_BON + (ot * 64 + ov4) * 2); } \
            u32x2* dst_ = ((c) > 0) ? (u32x2*)(mix + ((size_t)b * T + ((c) - 1) * 16 + ot) * D + 512 + hd * 64 + ov4) : dummy; \
            RW_OUT((c) - 1, gg, bn, dst_); \
              \
            { const int cd_ = (c) + RWL_D < T / 16 ? (c) + RWL_D : T / 16 - 1; RW_DMA(cd_, ((c) + RWL_D) % RWL_N); asm volatile("s_waitcnt vmcnt(18)" ::: "memory"); } \
            LDS_BARRIER(); \
            if (((c) & 63) == 2 && (c) > 2 && tid == 0) { const unsigned cv_ = (unsigned)((c) >> 6);        \
                asm volatile("global_store_dword %0, %1, off sc1" :: "v"(cons), "v"(cv_) : "memory"); } } while (0)
    if (wave >= 4) {
#pragma unroll 1
        for (int c2 = 0; c2 < T / 16; c2 += 2) { RW_REC(c2, opA); RW_REC(c2 + 1, opB); }
    } else {
#pragma unroll 1
        for (int c2 = 0; c2 < T / 16; c2 += 2) { RW_OSTEP(c2, gB, bB); RW_OSTEP(c2 + 1, gA, bA); }
        const f32x4 gg = {bflo(gB.x), bfhi(gB.x), bflo(gB.y), bfhi(gB.y)}, bn = {bflo(bB.x), bfhi(bB.x), bflo(bB.y), bfhi(bB.y)};
        RW_OUT(T / 16 - 1, gg, bn, (u32x2*)(mix + ((size_t)b * T + (T / 16 - 1) * 16 + ot) * D + 512 + hd * 64 + ov4));
    }
#undef RW_SLABCHK
#undef RW_REC
#undef RW_OSTEP
#undef RW_OUT
#undef RW_DMA
    asm volatile("s_waitcnt vmcnt(0)" ::: "memory");
    __syncthreads();
}

__device__ __forceinline__ int lds_add(LAS int* p, int v) { return __hip_atomic_fetch_add(p, v, __ATOMIC_RELAXED, __HIP_MEMORY_SCOPE_WORKGROUP); }
__device__ __forceinline__ void ph_fin(const Params& P, int l, int lane, int wave) {
    const bf16* mix = (const bf16*)(P.ws + WS_MIX); bf16* act = (bf16*)(P.ws + WS_ACT); const float* gain = P.in[I_MGAIN] + (size_t)l * D;
    const int gw = blockIdx.x * NWAVES + wave, NGW = gridDim.x * NWAVES;
    const f32x4* gp = (const f32x4*)(gain + lane * 16); const f32x4 g0 = gp[0], g1 = gp[1], g2 = gp[2], g3 = gp[3];
#pragma unroll 1
    for (int m0 = gw * 4; m0 < NTOK; m0 += NGW * 4) {
        u32x4 ra[4], rb[4];
#pragma unroll
        for (int k = 0; k < 4; ++k) { ra[k] = ldg16(mix + (size_t)(m0 + k) * D + lane * 16); rb[k] = ldg16(mix + (size_t)(m0 + k) * D + lane * 16 + 8); }
#pragma unroll
        for (int k = 0; k < 4; ++k) { float v[16]; { float a[8], b2[8]; unpack8(ra[k], a); unpack8(rb[k], b2);
#pragma unroll
                for (int i = 0; i < 8; ++i) { v[i] = a[i]; v[8 + i] = b2[i]; } }
            float s2 = 0.f;
#pragma unroll
            for (int i = 0; i < 16; ++i) s2 += v[i] * v[i];
            s2 = row16_sum(s2);
            const float rstd = 1.f / sqrtf(s2 * (1.f / 256.f) + 1e-6f); u32x4 w0, w1;
            w0.x = cvt2(v[0] * rstd * g0.x, v[1] * rstd * g0.y); w0.y = cvt2(v[2] * rstd * g0.z, v[3] * rstd * g0.w); w0.z = cvt2(v[4] * rstd * g1.x, v[5] * rstd * g1.y); w0.w = cvt2(v[6] * rstd * g1.z, v[7] * rstd * g1.w);
            w1.x = cvt2(v[8] * rstd * g2.x, v[9] * rstd * g2.y); w1.y = cvt2(v[10] * rstd * g2.z, v[11] * rstd * g2.w); w1.z = cvt2(v[12] * rstd * g3.x, v[13] * rstd * g3.y); w1.w = cvt2(v[14] * rstd * g3.z, v[15] * rstd * g3.w);
            *(u32x4*)(act + (size_t)(m0 + k) * D + lane * 16) = w0; *(u32x4*)(act + (size_t)(m0 + k) * D + lane * 16 + 8) = w1; }
    }
}
__device__ __forceinline__ void ph_route(const Params& P, int l, LAS unsigned char* lds, int tid, int lane, int wave) {
    LAS int* hist = (LAS int*)(lds + LDS_MISC + 256);
    unsigned char* wl = P.ws + WS_W + (size_t)l * WL_STRIDE;
    pg8::StaticOrder S; S.init(NTOK / 256, 1, gridDim.x, blockIdx.x);
    { pg8::Gemm g{(const bf16*)P.out, (const bf16*)(wl + WO_RT), NTOK, 256, D, nullptr, 0, HP}; pg8::EpiLogits E{(float*)(P.ws + WS_LG)};
      pg8::gemm_phase<pg8::EpiLogits, pg8::StaticOrder, true, true>(lds, g, S, E); }
    bf16* act = (bf16*)(P.ws + WS_ACT); int* route = (int*)(P.ws + WS_ROUTE); int* tcnt = (int*)(P.ws + WS_TCNT);
    const float* n2 = P.in[I_NORM2] + (size_t)l * D; const float* cb = P.in[I_MCB] + l * 4; const float* fbias = P.in[I_MFB] + l * 32;
    LAS float* rsl = (LAS float*)lds;
    f32x4 gn[4];
#pragma unroll
    for (int j = 0; j < 4; ++j) gn[j] = *((const f32x4*)n2 + lane + 64 * j);
    for (int ui = 0; ; ++ui) {
    pg8::Unit un; if (!S.next(ui, un)) break;
    const int tile = un.pm;
    if (tid < NEXP) hist[tid] = 0;
    { const int mb = tile * 256 + wave * 32; u32x2 va[4], vb[4];
#define RT_LOAD(V, mm) do { const u32x2* hr_ = (const u32x2*)((const bf16*)P.out + (size_t)(mm) * HP) + lane; _Pragma("unroll") for (int j = 0; j < 4; ++j) V[j] = hr_[64 * j]; } while (0)
#define RT_ROW(V, kk) do { f32x4 v[4]; float s_ = 0.f; \
        _Pragma("unroll") for (int j = 0; j < 4; ++j) { v[j] = (f32x4){bflo(V[j].x), bfhi(V[j].x), bflo(V[j].y), bfhi(V[j].y)}; s_ += (v[j].x * v[j].x + v[j].y * v[j].y) + (v[j].z * v[j].z + v[j].w * v[j].w); } \
        if ((kk) + 2 < 32) RT_LOAD(V, mb + (kk) + 2); \
        const float rstd = 1.f / sqrtf(wave_sum(s_) * (1.f / D) + 1e-6f); if (lane == 0) rsl[wave * 32 + (kk)] = rstd; \
        unsigned* o4 = (unsigned*)((unsigned char*)act + (size_t)(mb + (kk)) * D) + lane; \
        _Pragma("unroll") for (int j = 0; j < 4; ++j) { const f32x4 g = gn[j]; int w8 = 0; w8 = __builtin_amdgcn_cvt_pk_fp8_f32(pg8::sat8(v[j].x * rstd * g.x), pg8::sat8(v[j].y * rstd * g.y), w8, false); w8 = __builtin_amdgcn_cvt_pk_fp8_f32(pg8::sat8(v[j].z * rstd * g.z), pg8::sat8(v[j].w * rstd * g.w), w8, true); o4[64 * j] = (unsigned)w8; } } while (0)
      RT_LOAD(va, mb); RT_LOAD(vb, mb + 1);
#pragma unroll 1
      for (int k = 0; k < 32; k += 2) { RT_ROW(va, k); RT_ROW(vb, k + 1); }
#undef RT_LOAD
#undef RT_ROW
    }
    __syncthreads();
    if (tid < 256) { const int m = tile * 256 + tid; const float rstd = rsl[tid];
        const f32x4* lp = (const f32x4*)((const float*)(P.ws + WS_LG) + (size_t)m * 72); f32x4 q[18];
#pragma unroll
        for (int i = 0; i < 18; ++i) q[i] = lp[i];
        float L[36];
#pragma unroll
        for (int j = 0; j < 36; ++j) L[j] = (q[j >> 2][j & 3] + q[(36 + j) >> 2][(36 + j) & 3]) * rstd + (j < 4 ? cb[j] : fbias[j - 4]);
        const float c0 = L[0], c1 = L[1], c2 = L[2], c3 = L[3];
        int gs = 0; float cm = c0; if (c1 > cm) { cm = c1; gs = 1; } if (c2 > cm) { cm = c2; gs = 2; } if (c3 > cm) { cm = c3; gs = 3; }
        const float pg = 1.f / (expf(c0 - cm) + expf(c1 - cm) + expf(c2 - cm) + expf(c3 - cm));
        float fa[8];
#pragma unroll
        for (int i = 0; i < 8; ++i) fa[i] = (gs == 0) ? L[4 + i] : (gs == 1) ? L[12 + i] : (gs == 2) ? L[20 + i] : L[28 + i];
        int i0 = 0; float m0 = fa[0];
#pragma unroll
        for (int i = 1; i < 8; ++i) if (fa[i] > m0) { m0 = fa[i]; i0 = i; }
        int i1 = (i0 == 0) ? 1 : 0; float m1 = -3.0e38f;
#pragma unroll
        for (int i = 0; i < 8; ++i) if (i != i0 && fa[i] > m1) { m1 = fa[i]; i1 = i; }
        const float e1w = expf(m1 - m0), w0 = pg / (1.f + e1w), w1 = pg * e1w / (1.f + e1w);
        const int e0 = gs * 8 + i0, e1 = gs * 8 + i1;
        typedef int i32x4 __attribute__((ext_vector_type(4)));
        *(i32x4*)(route + (size_t)m * 8) = (i32x4){e0, e1, __builtin_bit_cast(int, w0), __builtin_bit_cast(int, w1)};
        lds_add(&hist[e0], 1); lds_add(&hist[e1], 1); }
    __syncthreads();
    if (tid < NEXP) { tcnt[tile * 32 + tid] = hist[tid]; atomicAdd((unsigned*)(P.ws + WS_CTL) + CW_CNT + l * 64 + tid, (unsigned)hist[tid]); }
    __syncthreads();
    }
}
__device__ __forceinline__ int build_tiles(const Params& P, int l, LAS unsigned char* ldsall, int tid) {
    LAS int* tile_e = (LAS int*)(ldsall + LDS_TILE_E); LAS int* misc = (LAS int*)(ldsall + LDS_MISC);
    LAS int* ntl = (LAS int*)(ldsall + LDS_MISC + 512);
    if (tid < NEXP) { const unsigned* cnt = (const unsigned*)(P.ws + WS_CTL) + CW_CNT + l * 64; const int c = (int)__hip_atomic_load(cnt + tid, __ATOMIC_RELAXED, __HIP_MEMORY_SCOPE_AGENT); ntl[tid] = (c + 255) >> 8; }
    __syncthreads();
    if (tid < NEXP) { int r = 0; for (int e = 0; e < tid; ++e) r += ntl[e];
        const int nt = ntl[tid]; r = r < MAXTILES ? r : MAXTILES; misc[1 + tid] = r * 256;
        for (int q = 0; q < nt && r + q < MAXTILES; ++q) tile_e[r + q] = tid;
        if (tid == NEXP - 1) misc[0] = (r + nt < MAXTILES) ? r + nt : MAXTILES; }
    __syncthreads();
    return misc[0];
}
__device__ __forceinline__ void ph_scatter(const Params& P, int l, LAS unsigned char* ldsall, int tid, int lane, int wave) {
    build_tiles(P, l, ldsall, tid);
    LAS int* misc = (LAS int*)(ldsall + LDS_MISC); LAS int* base = (LAS int*)ldsall; LAS int* EL = base + 32; LAS int* POS = EL + 512; LAS int* part = POS + 512;
    int* route = (int*)(P.ws + WS_ROUTE); const int* tcnt = (const int*)(P.ws + WS_TCNT); int* rowsrc = (int*)(P.ws + WS_TCNT + 65536);
    for (int tile = blockIdx.x; tile < NTOK / 256; tile += gridDim.x) {
        { const int e = tid & 31, q = tid >> 5; int c[16];
#pragma unroll
          for (int i = 0; i < 16; ++i) { const int t2 = q + 16 * i; c[i] = (t2 < tile) ? tcnt[t2 * 32 + e] : 0; }
          int s = 0;
#pragma unroll
          for (int i = 0; i < 16; ++i) s += c[i];
          part[q * 32 + e] = s; }
        int e0 = 0, e1 = 0; const size_t tok = (size_t)tile * 256 + tid;
        if (tid < 256) { e0 = route[tok * 8]; e1 = route[tok * 8 + 1]; EL[tid * 2] = e0; EL[tid * 2 + 1] = e1; }
        __syncthreads();
        if (tid < 32) { int s = misc[1 + tid]; for (int q = 0; q < 16; ++q) s += part[q * 32 + tid]; base[tid] = s; }
        __syncthreads();
        if (tid < 256) { int r0 = 0, r1 = 0;
            for (int i = 0; i < 2 * tid; ++i) { const int e = EL[i]; r0 += (e == e0); r1 += (e == e1); }
            const int p0 = base[e0] + r0, p1 = base[e1] + r1;
            route[tok * 8 + 4] = p0; route[tok * 8 + 5] = p1; rowsrc[p0] = (int)tok; rowsrc[p1] = (int)tok; }
        __syncthreads();
        __syncthreads();
    }
}
__device__ __forceinline__ void cb_load(const Params& P, const unsigned char* ys, int m, int p0, int p1, int lane, u32x2 (&h)[4], unsigned (&a)[4], unsigned (&b2)[4]) {
    const u32x2* hr = (const u32x2*)((const bf16*)P.out + (size_t)m * HP) + lane; const unsigned* y0 = (const unsigned*)(ys + (size_t)p0 * D) + lane; const unsigned* y1 = (const unsigned*)(ys + (size_t)p1 * D) + lane;
#pragma unroll
    for (int j = 0; j < 4; ++j) { h[j] = hr[64 * j]; a[j] = y0[64 * j]; b2[j] = y1[64 * j]; }
}
__device__ __forceinline__ void ph_combine(const Params& P, int l, int lane, int wave) {
    const unsigned char* ys = (const unsigned char*)(P.ws + WS_PROJ); bf16* act = (bf16*)(P.ws + WS_ACT); const int* route = (const int*)(P.ws + WS_ROUTE);
    const float* gain = (l + 1 < NL) ? P.in[I_NORM1] + (size_t)(l + 1) * D : P.in[I_FNW];
    f32x4 gn[4];
#pragma unroll
    for (int j = 0; j < 4; ++j) gn[j] = *((const f32x4*)gain + lane + 64 * j);
    for (int tile = blockIdx.x; tile < NTOK / 256; tile += gridDim.x) {
        const int mb = tile * 256 + wave * 32;
        const int* rp = route + (size_t)(mb + (lane & 31)) * 8; const int rw0 = rp[2], rw1 = rp[3], rp0 = rp[4], rp1 = rp[5];
        u32x2 nh[4]; unsigned na[4], nb[4];
        cb_load(P, ys, mb, __builtin_amdgcn_readlane(rp0, 0), __builtin_amdgcn_readlane(rp1, 0), lane, nh, na, nb);
#pragma unroll 1
        for (int k = 0; k < 32; ++k) {
            const int m = mb + k; f32x4 v[4]; unsigned a[4], b2[4];
#pragma unroll
            for (int j = 0; j < 4; ++j) { v[j] = (f32x4){bflo(nh[j].x), bfhi(nh[j].x), bflo(nh[j].y), bfhi(nh[j].y)}; a[j] = na[j]; b2[j] = nb[j]; }
            const float w0 = __builtin_bit_cast(float, __builtin_amdgcn_readlane(rw0, k)) * 0.0625f, w1 = __builtin_bit_cast(float, __builtin_amdgcn_readlane(rw1, k)) * 0.0625f;
            if (k + 1 < 32) cb_load(P, ys, m + 1, __builtin_amdgcn_readlane(rp0, k + 1), __builtin_amdgcn_readlane(rp1, k + 1), lane, nh, na, nb);
            float s2 = 0.f;
#pragma unroll
            for (int j = 0; j < 4; ++j) { const f32x2 a01 = __builtin_amdgcn_cvt_pk_f32_fp8((int)a[j], false), a23 = __builtin_amdgcn_cvt_pk_f32_fp8((int)a[j], true), b01 = __builtin_amdgcn_cvt_pk_f32_fp8((int)b2[j], false), b23 = __builtin_amdgcn_cvt_pk_f32_fp8((int)b2[j], true);
                v[j].x += w0 * a01[0] + w1 * b01[0]; v[j].y += w0 * a01[1] + w1 * b01[1]; v[j].z += w0 * a23[0] + w1 * b23[0]; v[j].w += w0 * a23[1] + w1 * b23[1];
                s2 += (v[j].x * v[j].x + v[j].y * v[j].y) + (v[j].z * v[j].z + v[j].w * v[j].w); }
            const float rstd = 1.f / sqrtf(wave_sum(s2) * (1.f / D) + 1e-6f);
            f32x4* hr = (f32x4*)(P.out + (size_t)m * D) + lane;
            if (l + 1 < NL) { u32x2* o8 = (u32x2*)(act + (size_t)m * D) + lane; u32x2* hb = (u32x2*)((bf16*)P.out + (size_t)m * HP) + lane;
#pragma unroll
                for (int j = 0; j < 4; ++j) { u32x2 hw; hw.x = cvt2(v[j].x, v[j].y); hw.y = cvt2(v[j].z, v[j].w); hb[64 * j] = hw; u32x2 w; w.x = cvt2(v[j].x * rstd * gn[j].x, v[j].y * rstd * gn[j].y); w.y = cvt2(v[j].z * rstd * gn[j].z, v[j].w * rstd * gn[j].w); o8[64 * j] = w; }
            } else {
#pragma unroll
                for (int j = 0; j < 4; ++j) { f32x4 o; o.x = v[j].x * rstd * gn[j].x; o.y = v[j].y * rstd * gn[j].y; o.z = v[j].z * rstd * gn[j].z; o.w = v[j].w * rstd * gn[j].w; hr[64 * j] = o; }
            }
        }
    }
}

#ifndef MK_ONE_LAUNCH
#define MK_ONE_LAUNCH 1
#endif
constexpr int PH_PER_LAYER = 10, N_PHASES = 1 + NL * PH_PER_LAYER;
#ifndef PH_MASK
#ifdef DBG_NOMOE
#define PH_MASK 0x61f
#else
#define PH_MASK 0x7ff
#endif
#endif
#define PHE(j) (((PH_MASK) >> (j)) & 1)
#ifndef DUP_MASK
#define DUP_MASK 0
#endif
#define NREP(j) ((((DUP_MASK) >> (j)) & 1) ? 2 : 1)
#if MK_ONE_LAUNCH
#define GRID_BAR() xcd_barrier(bar)
#else
#define GRID_BAR() do {} while (0)
#endif
#define IN(k) (lo <= (k) && (k) < hi)
#define SEAM(k) do { if (IN(k) && IN((k) + 1)) GRID_BAR(); } while (0)
#ifndef DUP_ROLE
#define DUP_ROLE 0
#endif
#ifndef DUP_N
#define DUP_N 1
#endif
#define MIXBODY() do { \
            const int u_ = blockIdx.x; \
            if (u_ < 32) rwkv_consumer(P, l, u_ >> 2, u_ & 3, lds, tid, lane, wave); \
            else if (u_ < 64) role_hgrn(P, l, (u_ - 32) >> 2, u_ & 3, lds, tid, lane, wave); \
            else if (u_ < 96) { role_lru(P, l, (u_ - 64) >> 2, u_ & 3, lds, tid, lane, wave); __syncthreads(); rwkv_producer(P, l, u_ & 3, 40 + ((u_ - 64) >> 2), 40, lds, tid, lane, wave); } \
            else { rwkv_producer(P, l, (u_ - 96) & 3, (u_ - 96) >> 2, 40, lds, tid, lane, wave);        \
                   if (u_ < 224) { __syncthreads(); role_s5(P, l, (u_ - 96) >> 4, (u_ - 96) & 15, lds, tid, lane, wave); } } \
} while (0)
template <int l> __device__ __forceinline__ void layer_phases(const Params& P, LAS unsigned char* lds, const XcdBarrier& bar, int tid, int lane, int wave, int lo, int hi) {
        const int pb = 1 + l * PH_PER_LAYER;
        const unsigned char* wl = P.ws + WS_W + (size_t)l * WL_STRIDE;
        if (PHE(0) && IN(pb + 0)) {
            pg8::Gemm g{(const bf16*)(P.ws + WS_ACT), (const bf16*)(wl + WO_IN), NTOK, DIN, D}; pg8::StaticOrder S; S.init(NTOK / 256, DIN / 256, gridDim.x, blockIdx.x);
            pg8::EpiBf16 E{(bf16*)(P.ws + WS_PROJ), DIN};
            pg8::gemm_phase<pg8::EpiBf16, pg8::StaticOrder, true, true>(lds, g, S, E);
        } SEAM(pb + 0);
        if (PHE(1) && IN(pb + 1)) {
            MIXBODY();
            if (NREP(1) == 2) { GRID_BAR(); MIXBODY(); }
        } SEAM(pb + 1);
        if (PHE(2) && IN(pb + 2)) {
            pg8::Gemm g{(const bf16*)(P.ws + WS_YG), (const bf16*)(wl + WO_GLU), NTOK, 512, 256}; pg8::StaticOrder S; S.init(NTOK / 256, 2, gridDim.x, blockIdx.x);
            pg8::EpiGated<1> E{(bf16*)(P.ws + WS_MIX) + 256, D};
            pg8::gemm_phase<pg8::EpiGated<1>, pg8::StaticOrder, true, true>(lds, g, S, E);
        } SEAM(pb + 2);
        if (PHE(3) && IN(pb + 3)) { ph_fin(P, l, lane, wave); } SEAM(pb + 3);
        if (PHE(4) && IN(pb + 4)) {
            pg8::Gemm g{(const bf16*)(P.ws + WS_ACT), (const bf16*)(wl + WO_OUT), NTOK, D, D}; pg8::StaticOrder S; S.init(NTOK / 256, D / 256, gridDim.x, blockIdx.x);
            if (l == 0) { pg8::EpiResB<true> E{(bf16*)P.out, (const void*)P.in[I_X], HP, D}; pg8::gemm_phase<pg8::EpiResB<true>, pg8::StaticOrder, true, true>(lds, g, S, E); }
            else { pg8::EpiResB<false> E{(bf16*)P.out, (const void*)P.out, HP, HP}; pg8::gemm_phase<pg8::EpiResB<false>, pg8::StaticOrder, true, true>(lds, g, S, E); }
        } SEAM(pb + 4);
        if (PHE(5) && IN(pb + 5)) { ph_route(P, l, lds, tid, lane, wave); } SEAM(pb + 5);
        if (PHE(6) && IN(pb + 6)) { ph_scatter(P, l, lds, tid, lane, wave); } SEAM(pb + 6);
        if (PHE(7) && IN(pb + 7)) {
            const int R = build_tiles(P, l, lds, tid);
            pg8::Gemm g{(const bf16*)(P.ws + WS_ACT), (const bf16*)(wl + WO_GU), SROWS, D, D / 2  , (const int*)(P.ws + WS_TCNT + 65536), NTOK}; pg8::StaticOrder S; S.init(R, 4, gridDim.x, blockIdx.x);
            S.tile_e = (const LAS int*)(lds + LDS_TILE_E); S.estride = (size_t)D * D;
            pg8::EpiGatedF8 E{(unsigned char*)(P.ws + WS_MIX), DEXP};
            pg8::gemm_phase<pg8::EpiGatedF8, pg8::StaticOrder, true, true, true, true>(lds, g, S, E);
        } SEAM(pb + 7);
        if (PHE(8) && IN(pb + 8)) {
            const int R = build_tiles(P, l, lds, tid);
            pg8::Gemm g{(const bf16*)(P.ws + WS_MIX), (const bf16*)(wl + WO_DN), SROWS, D, DEXP / 2  }; pg8::StaticOrder S; S.init(R, 4, gridDim.x, blockIdx.x);
            S.tile_e = (const LAS int*)(lds + LDS_TILE_E); S.estride = (size_t)D * DEXP;
            pg8::EpiF8 E{(unsigned char*)(P.ws + WS_PROJ), D, 16.f};
            pg8::gemm_phase<pg8::EpiF8, pg8::StaticOrder, true, true, false, true>(lds, g, S, E);
        } SEAM(pb + 8);
        if (PHE(9) && IN(pb + 9)) { ph_combine(P, l, lane, wave); } SEAM(pb + 9);
    }
__global__ void __launch_bounds__(NTHR, 2) fwd_kernel(Params P) {
    extern __shared__ __attribute__((aligned(16))) unsigned char lds_raw[];
    LAS unsigned char* lds = (LAS unsigned char*)lds_raw;
    const int tid = threadIdx.x, lane = tid & 63, wave = __builtin_amdgcn_readfirstlane(tid >> 6);
    if (tid < 16) ((LAS unsigned*)(lds + LDSCTL_OFF))[tid] = 0u;
    __syncthreads();
#if MK_ONE_LAUNCH
    XcdBarrier bar = xcd_barrier_post((unsigned*)(P.ws + WS_CTL) + CW_BAR, (volatile LAS unsigned*)(lds + LDSCTL_OFF));
#else
    XcdBarrier bar; bar.bar = nullptr; bar.x = 0; bar.st = nullptr;
#endif
    const int lo = P.ph_lo, hi = P.ph_hi;
    if (PHE(10) && IN(0)) { ph_prologue(P, lds, tid, lane, wave); } SEAM(0);
    layer_phases<0>(P, lds, bar, tid, lane, wave, lo, hi);
    layer_phases<1>(P, lds, bar, tid, lane, wave, lo, hi);
}
#undef IN
#undef SEAM

extern "C" void kernel_launch(void* const* d_in, const int* in_sizes, int n_in, void* d_out, int out_size, void* d_ws, size_t ws_size, hipStream_t stream) {
    static int grid = 0;
    if (grid == 0) {
        if (n_in != 46 || out_size != NTOK * D || ws_size < WS_END) { fprintf(stderr, "kernel_launch: unexpected sizes n_in %d out %d ws %zu\n", n_in, out_size, ws_size); grid = -1; return; }
        int dev = 0, cus = 0;
        if (hipGetDevice(&dev) != hipSuccess || hipDeviceGetAttribute(&cus, hipDeviceAttributeMultiprocessorCount, dev) != hipSuccess) { grid = -1; return; }
        if (hipFuncSetAttribute((const void*)fwd_kernel, hipFuncAttributeMaxDynamicSharedMemorySize, LDS_BYTES) != hipSuccess) { grid = -1; return; }
        int per_cu = 0;
        if (hipOccupancyMaxActiveBlocksPerMultiprocessor(&per_cu, (const void*)fwd_kernel, NTHR, LDS_BYTES) != hipSuccess || per_cu < 1) { fprintf(stderr, "kernel_launch: occupancy query says %d\n", per_cu); }
        (void)hipGetLastError();
        (void)cus; grid = 256;
    }
    if (grid < 0) return;
    if (hipMemsetAsync((char*)d_ws + WS_CTL, 0, CTL_ZERO_BYTES, stream) != hipSuccess) return;
    Params p; memset(&p, 0, sizeof(p));
    for (int i = 0; i < 46; ++i) p.in[i] = (const float*)d_in[i];
    p.out = (float*)d_out; p.ws = (unsigned char*)d_ws;
#if MK_ONE_LAUNCH
    p.ph_lo = 0; p.ph_hi = N_PHASES;
    hipLaunchKernelGGL(fwd_kernel, dim3(grid), dim3(NTHR), LDS_BYTES, stream, p);
#else
    for (int k = 0; k < N_PHASES; ++k) { p.ph_lo = k; p.ph_hi = k + 1; hipLaunchKernelGGL(fwd_kernel, dim3(grid), dim3(NTHR), LDS_BYTES, stream, p); }
#endif
}
```

```cpp
#include <hip/hip_runtime.h>
#include <cstdio>
#include <cstdint>
#include <cstring>

#define LAS __attribute__((address_space(3)))
#define GAS __attribute__((address_space(1)))

namespace pg8 {
#define PG8_LAS __attribute__((address_space(3)))
typedef unsigned short bf16_t;
typedef short bf16x8 __attribute__((ext_vector_type(8)));
typedef float f32x4 __attribute__((ext_vector_type(4)));
typedef unsigned u32x4 __attribute__((ext_vector_type(4)));
typedef int v8i __attribute__((ext_vector_type(8)));
constexpr int BM = 256, BK = 64, HALF = 128, HTB = HALF * BK * 2  , STAGE_BYTES = 8 * HTB, NXCD = 8, WGM = 8;

__host__ __device__ __forceinline__ int lds_byte(int r, int c) { const int st = (r >> 4) * 2 + (c >> 5), rr = r & 15, cc = c & 31, ob = rr * 64 + cc * 2; return st * 1024 + (ob ^ (((ob >> 9) & 1) << 5)); }
__host__ __device__ __forceinline__ void stage_rc(int b, int& R, int& C) { const int st = b / 1024, sb = b % 1024, swz = sb ^ (((sb >> 9) & 1) << 5); R = (st >> 1) * 16 + swz / 64; C = (st & 1) * 32 + (swz % 64) / 2; }
__host__ __device__ __forceinline__ int perm32(int rho) { const int n = rho >> 4, i = rho & 15; return 8 * (i >> 2) + 4 * n + (i & 3); }

struct Unit { int pm, pn; };
struct Gemm { const bf16_t* A; const bf16_t* Bt; int M, N, K; const int* rowsrc; int nsrc; int lda; };

struct StaticOrder {
    int nM, nN, nwg, G, c; const PG8_LAS int* tile_e; size_t estride;
    __device__ void init(int nM_, int nN_, int G_, int c_) { nM = nM_; nN = nN_; nwg = nM * nN; G = G_; c = c_; tile_e = nullptr; estride = 0; }
    __device__ bool next(int i, Unit& u) const {
        const long L = (long)i * G + c; if (L >= nwg) return false;
        int wgid = (int)L; { const int q = nwg / NXCD, r = nwg % NXCD, xcd = wgid % NXCD, off = wgid / NXCD; wgid = (xcd < r ? xcd * (q + 1) : r * (q + 1) + (xcd - r) * q) + off; }
        const int nig = WGM * nN, gid = wgid / nig, fm = gid * WGM, gsz = (nM - fm) < WGM ? (nM - fm) : WGM;
        u.pm = fm + ((wgid % nig) % gsz); u.pn = (wgid % nig) / gsz; return true;
    }
    __device__ __forceinline__ size_t boff(const Unit& u, size_t tstep) const { return (size_t)u.pn * tstep + (tile_e ? (size_t)tile_e[u.pm] * estride : (size_t)0); }
    __device__ __forceinline__ void a_ready(const Unit&) const {}
    __device__ __forceinline__ void done(const Unit&) const {}
};

struct OwnOrder {
    int pm, nN;
    __device__ bool next(int i, Unit& u) const { if (i >= nN) return false; u.pm = pm; u.pn = i; return true; }
    __device__ __forceinline__ size_t boff(const Unit& u, size_t tstep) const { return (size_t)u.pn * tstep; }
    __device__ __forceinline__ void a_ready(const Unit&) const {}
    __device__ __forceinline__ void done(const Unit&) const {}
};
__device__ __forceinline__ unsigned cvt_pk_bf16(float lo, float hi) { unsigned r; asm volatile("v_cvt_pk_bf16_f32 %0, %1, %2" : "=v"(r) : "v"(lo), "v"(hi)); return r; }

__device__ __forceinline__ float sat8(float x) { return __builtin_amdgcn_fmed3f(x, -448.f, 448.f); }
struct EpiBf16 {
    static constexpr bool PERM = true, AFTER_DRAIN = false;
    bf16_t* O; int ldc;
    __device__ __forceinline__ void operator()(const f32x4 (&acc)[2][2][4][2], const Unit& u, int wr, int wc, int fr, int fq) const {
        const int row0 = u.pm * BM + wr * 64 + fr, col0 = u.pn * BM + wc * 32 + 8 * fq;
#pragma unroll
        for (int ai = 0; ai < 2; ++ai)
#pragma unroll
            for (int m = 0; m < 4; ++m) { bf16_t* rowp = O + (size_t)(row0 + ai * HALF + m * 16) * ldc + col0;
#pragma unroll
                for (int bj = 0; bj < 2; ++bj) { const f32x4 v0 = acc[ai][bj][m][0], v1 = acc[ai][bj][m][1];
                    u32x4 w; w.x = cvt_pk_bf16(v0[0], v0[1]); w.y = cvt_pk_bf16(v0[2], v0[3]); w.z = cvt_pk_bf16(v1[0], v1[1]); w.w = cvt_pk_bf16(v1[2], v1[3]);
                    *(u32x4*)(rowp + bj * HALF) = w; } }
    }
};
struct EpiLogits {
    static constexpr bool PERM = true, AFTER_DRAIN = false;
    float* O;
    __device__ __forceinline__ void operator()(const f32x4 (&acc)[2][2][4][2], const Unit& u, int wr, int wc, int fr, int fq) const {
        const int row0 = u.pm * BM + wr * 64 + fr, col0 = wc * 32 + 8 * fq;
        if (col0 < 72) {
#pragma unroll
            for (int ai = 0; ai < 2; ++ai)
#pragma unroll
                for (int m = 0; m < 4; ++m) { float* rowp = O + (size_t)(row0 + ai * HALF + m * 16) * 72 + col0; *(f32x4*)rowp = acc[ai][0][m][0]; *(f32x4*)(rowp + 4) = acc[ai][0][m][1]; }
        }
    }
};
template <int MODE> struct EpiGated {
    static constexpr bool PERM = true, AFTER_DRAIN = false;
    bf16_t* O; int ldc;
    __device__ __forceinline__ void operator()(const f32x4 (&acc)[2][2][4][2], const Unit& u, int wr, int wc, int fr, int fq) const {
        const int row0 = u.pm * BM + wr * 64 + fr, col0 = u.pn * HALF + wc * 32 + 8 * fq;
#pragma unroll
        for (int ai = 0; ai < 2; ++ai)
#pragma unroll
            for (int m = 0; m < 4; ++m) { bf16_t* rowp = O + (size_t)(row0 + ai * HALF + m * 16) * ldc + col0;
                float o[8];
#pragma unroll
                for (int n = 0; n < 2; ++n)
#pragma unroll
                    for (int j = 0; j < 4; ++j) { const float a = acc[ai][0][m][n][j], b = acc[ai][1][m][n][j];
                        o[n * 4 + j] = (MODE == 0) ? (a / (1.f + __expf(-a))) * b : a / (1.f + __expf(-b)); }
                u32x4 w; w.x = cvt_pk_bf16(o[0], o[1]); w.y = cvt_pk_bf16(o[2], o[3]); w.z = cvt_pk_bf16(o[4], o[5]); w.w = cvt_pk_bf16(o[6], o[7]);
                *(u32x4*)rowp = w; }
    }
};
template <bool RF32> struct EpiResB {
    static constexpr bool PERM = true, AFTER_DRAIN = false;
    bf16_t* C; const void* R; int ldc, ldr;
    __device__ __forceinline__ void operator()(const f32x4 (&acc)[2][2][4][2], const Unit& u, int wr, int wc, int fr, int fq) const {
        const int row0 = u.pm * BM + wr * 64 + fr, col0 = u.pn * BM + wc * 32 + 8 * fq;
#pragma unroll
        for (int ai = 0; ai < 2; ++ai)
#pragma unroll
            for (int m = 0; m < 4; ++m) { const size_t row = (size_t)(row0 + ai * HALF + m * 16);
#pragma unroll
                for (int bj = 0; bj < 2; ++bj) { float r[8];
                    if constexpr (RF32) { const f32x4 a = *(const f32x4*)((const float*)R + row * ldr + col0 + bj * HALF), b = *(const f32x4*)((const float*)R + row * ldr + col0 + bj * HALF + 4);
                        r[0] = a[0]; r[1] = a[1]; r[2] = a[2]; r[3] = a[3]; r[4] = b[0]; r[5] = b[1]; r[6] = b[2]; r[7] = b[3]; }
                    else { const u32x4 w = *(const u32x4*)((const bf16_t*)R + row * ldr + col0 + bj * HALF);
                        r[0] = __builtin_bit_cast(float, w.x << 16); r[1] = __builtin_bit_cast(float, w.x & 0xffff0000u); r[2] = __builtin_bit_cast(float, w.y << 16); r[3] = __builtin_bit_cast(float, w.y & 0xffff0000u);
                        r[4] = __builtin_bit_cast(float, w.z << 16); r[5] = __builtin_bit_cast(float, w.z & 0xffff0000u); r[6] = __builtin_bit_cast(float, w.w << 16); r[7] = __builtin_bit_cast(float, w.w & 0xffff0000u); }
                    const f32x4 v0 = acc[ai][bj][m][0], v1 = acc[ai][bj][m][1];
                    u32x4 o; o.x = cvt_pk_bf16(v0[0] + r[0], v0[1] + r[1]); o.y = cvt_pk_bf16(v0[2] + r[2], v0[3] + r[3]); o.z = cvt_pk_bf16(v1[0] + r[4], v1[1] + r[5]); o.w = cvt_pk_bf16(v1[2] + r[6], v1[3] + r[7]);
                    *(u32x4*)(C + row * ldc + col0 + bj * HALF) = o; } }
    }
};
struct EpiGatedF8 {
    static constexpr bool PERM = true, AFTER_DRAIN = false;
    unsigned char* O; int ldc;
    __device__ __forceinline__ void operator()(const f32x4 (&acc)[2][2][4][2], const Unit& u, int wr, int wc, int fr, int fq) const {
        const int row0 = u.pm * BM + wr * 64 + fr, col0 = u.pn * HALF + wc * 32 + 8 * fq;
#pragma unroll
        for (int ai = 0; ai < 2; ++ai)
#pragma unroll
            for (int m = 0; m < 4; ++m) { unsigned char* rowp = O + (size_t)(row0 + ai * HALF + m * 16) * ldc + col0;
                float o[8];
#pragma unroll
                for (int n = 0; n < 2; ++n)
#pragma unroll
                    for (int j = 0; j < 4; ++j) { const float a = acc[ai][0][m][n][j], b = acc[ai][1][m][n][j]; o[n * 4 + j] = sat8((a / (1.f + __expf(-a))) * b); }
                int w0 = 0, w1 = 0;
                w0 = __builtin_amdgcn_cvt_pk_fp8_f32(o[0], o[1], w0, false); w0 = __builtin_amdgcn_cvt_pk_fp8_f32(o[2], o[3], w0, true);
                w1 = __builtin_amdgcn_cvt_pk_fp8_f32(o[4], o[5], w1, false); w1 = __builtin_amdgcn_cvt_pk_fp8_f32(o[6], o[7], w1, true);
                unsigned long long pk = (unsigned long long)(unsigned)w0 | ((unsigned long long)(unsigned)w1 << 32); *(unsigned long long*)rowp = pk; }
    }
};
struct EpiF8 {
    static constexpr bool PERM = true, AFTER_DRAIN = false;
    unsigned char* O; int ldc; float sc;
    __device__ __forceinline__ void operator()(const f32x4 (&acc)[2][2][4][2], const Unit& u, int wr, int wc, int fr, int fq) const {
        const int row0 = u.pm * BM + wr * 64 + fr, col0 = u.pn * BM + wc * 32 + 8 * fq;
#pragma unroll
        for (int ai = 0; ai < 2; ++ai)
#pragma unroll
            for (int m = 0; m < 4; ++m) { unsigned char* rowp = O + (size_t)(row0 + ai * HALF + m * 16) * ldc + col0;
#pragma unroll
                for (int bj = 0; bj < 2; ++bj) { const f32x4 v0 = acc[ai][bj][m][0] * sc, v1 = acc[ai][bj][m][1] * sc; int w0 = 0, w1 = 0;
                    w0 = __builtin_amdgcn_cvt_pk_fp8_f32(sat8(v0[0]), sat8(v0[1]), w0, false); w0 = __builtin_amdgcn_cvt_pk_fp8_f32(sat8(v0[2]), sat8(v0[3]), w0, true);
                    w1 = __builtin_amdgcn_cvt_pk_fp8_f32(sat8(v1[0]), sat8(v1[1]), w1, false); w1 = __builtin_amdgcn_cvt_pk_fp8_f32(sat8(v1[2]), sat8(v1[3]), w1, true);
                    *(unsigned long long*)(rowp + bj * HALF) = (unsigned long long)(unsigned)w0 | ((unsigned long long)(unsigned)w1 << 32); } }
    }
};
struct EpiResF32 {
    static constexpr bool PERM = false, AFTER_DRAIN = false;
    float* C; const float* R; int ldc;
    __device__ __forceinline__ void operator()(const f32x4 (&acc)[2][2][4][2], const Unit& u, int wr, int wc, int fr, int fq) const {
        const int row0 = u.pm * BM + wr * 64 + fr, col0 = u.pn * BM + wc * 32 + 4 * fq;
#pragma unroll
        for (int ai = 0; ai < 2; ++ai)
#pragma unroll
            for (int m = 0; m < 4; ++m) { const size_t ro = (size_t)(row0 + ai * HALF + m * 16) * ldc + col0;
#pragma unroll
                for (int bj = 0; bj < 2; ++bj)
#pragma unroll
                    for (int n = 0; n < 2; ++n) { const f32x4 r = *(const f32x4*)(R + ro + bj * HALF + n * 16); *(f32x4*)(C + ro + bj * HALF + n * 16) = acc[ai][bj][m][n] + r; } }
    }
};


template <class Epi, class Sched, bool ALIGN_EPI = false, bool SP2 = false, bool GATH = false, bool F8 = false>
__device__ __forceinline__ void gemm_phase(PG8_LAS unsigned char* lds, const Gemm g, const Sched& S, const Epi& E) {
    static_assert(!GATH || SP2, "the gathered-A variant exists for the SP2 loop only");
    const int tid = threadIdx.x, wid = __builtin_amdgcn_readfirstlane(tid >> 6), lane = tid & 63, wr = wid >> 2, wc = wid & 3, fr = lane & 15, fq = lane >> 4;
    const int K = g.K, nt = K / BK, ldA = g.lda ? g.lda : K;
    unsigned voffA[2], voffB[2];
#pragma unroll
    for (int i = 0; i < 2; ++i) { int R, C; stage_rc(tid * 16 + i * 8192, R, C); const int Rb = Epi::PERM ? ((R & ~31) + perm32(R & 31)) : R;
        voffA[i] = (unsigned)(R * ldA + C) * 2u; voffB[i] = (unsigned)(Rb * K + C) * 2u; }
    const size_t kstep = (size_t)(BK * 2);
    const size_t hstep = (size_t)HALF * K * 2;
    const size_t tstep = 2 * hstep;
    const size_t hstepA = (size_t)HALF * ldA * 2, tstepA = 2 * hstepA;
    const unsigned ldsw = (unsigned)wid * 1024u;
    const int aoff = lds_byte(wr * 64 + fr, fq * 8), boff = lds_byte(wc * 32 + fr, fq * 8);
#define PG8_SA(b, h) (((b) * 2 + (h)) * HTB)
#define PG8_SB(b, h) ((4 + (b) * 2 + (h)) * HTB)
#define PG8_STAGE(bufoff, gbase, voff) do { _Pragma("unroll") for (int _i = 0; _i < 2; ++_i) \
        __builtin_amdgcn_global_load_lds((const unsigned*)((const char*)(gbase) + (voff)[_i]), (PG8_LAS unsigned*)(lds + (bufoff) + ldsw + _i * 8192), 16, 0, 0); } while (0)
#define PG8_STAGE_G(bufoff, gbase, v0, v1) do { \
        __builtin_amdgcn_global_load_lds((const unsigned*)((const char*)(gbase) + (v0)), (PG8_LAS unsigned*)(lds + (bufoff) + ldsw), 16, 0, 0); \
        __builtin_amdgcn_global_load_lds((const unsigned*)((const char*)(gbase) + (v1)), (PG8_LAS unsigned*)(lds + (bufoff) + ldsw + 8192), 16, 0, 0); } while (0)
#define PG8_LDA(dst, b, h) do { if constexpr (F8) { _Pragma("unroll") for (int m = 0; m < 4; ++m) { const u32x4 lo_ = *(const PG8_LAS u32x4*)(lds + PG8_SA(b, h) + aoff + m * 2048), hi_ = *(const PG8_LAS u32x4*)(lds + PG8_SA(b, h) + aoff + 1024 + m * 2048); \
            dst##8[m] = (v8i){(int)lo_.x, (int)lo_.y, (int)lo_.z, (int)lo_.w, (int)hi_.x, (int)hi_.y, (int)hi_.z, (int)hi_.w}; } } \
        else { _Pragma("unroll") for (int m = 0; m < 4; ++m) _Pragma("unroll") for (int k = 0; k < 2; ++k) dst[m][k] = *(const PG8_LAS bf16x8*)(lds + PG8_SA(b, h) + aoff + m * 2048 + k * 1024); } } while (0)
#define PG8_LDB(dst, b, h) do { if constexpr (F8) { _Pragma("unroll") for (int n = 0; n < 2; ++n) { const u32x4 lo_ = *(const PG8_LAS u32x4*)(lds + PG8_SB(b, h) + boff + n * 2048), hi_ = *(const PG8_LAS u32x4*)(lds + PG8_SB(b, h) + boff + 1024 + n * 2048); \
            dst##8[n] = (v8i){(int)lo_.x, (int)lo_.y, (int)lo_.z, (int)lo_.w, (int)hi_.x, (int)hi_.y, (int)hi_.z, (int)hi_.w}; } } \
        else { _Pragma("unroll") for (int n = 0; n < 2; ++n) _Pragma("unroll") for (int k = 0; k < 2; ++k) dst[n][k] = *(const PG8_LAS bf16x8*)(lds + PG8_SB(b, h) + boff + n * 2048 + k * 1024); } } while (0)
#define PG8_MMA(ai, bj, At, Bt) do { __builtin_amdgcn_s_setprio(1); \
        if constexpr (F8) { _Pragma("unroll") for (int m = 0; m < 4; ++m) _Pragma("unroll") for (int n = 0; n < 2; ++n) \
            asm volatile("v_mfma_scale_f32_16x16x128_f8f6f4 %0, %1, %2, %0, %3, %4 op_sel_hi:[0,0,0]" : "+v"(acc[ai][bj][m][n]) : "v"(Bt##8[n]), "v"(At##8[m]), "v"(sc8_), "v"(sc8_)); } \
        else { _Pragma("unroll") for (int m = 0; m < 4; ++m) _Pragma("unroll") for (int n = 0; n < 2; ++n) _Pragma("unroll") for (int k = 0; k < 2; ++k) \
            acc[ai][bj][m][n] = __builtin_amdgcn_mfma_f32_16x16x32_bf16(Bt[n][k], At[m][k], acc[ai][bj][m][n], 0, 0, 0); } \
        __builtin_amdgcn_s_setprio(0); } while (0)
#define PG8_WAIT_V(n) asm volatile("s_waitcnt vmcnt(" #n ")" ::: "memory")
#define PG8_WAIT_L(n) asm volatile("s_waitcnt lgkmcnt(" #n ")" ::: "memory")
#define PG8_BAR __builtin_amdgcn_s_barrier()
#define PG8_SCHED __builtin_amdgcn_sched_barrier(0)
#define PG8_SCHED8 do { if constexpr (F8) __builtin_amdgcn_sched_barrier(0); } while (0)
    Unit cur, nxt; int ui = 0;
    if (!S.next(0, cur)) return;
    unsigned gc[2][2] = {{0u, 0u}, {0u, 0u}}, gn[2][2] = {{0u, 0u}, {0u, 0u}};
    int gR[2] = {0, 0}, gC[2] = {0, 0};
    if constexpr (GATH) {
#pragma unroll
        for (int i = 0; i < 2; ++i) stage_rc(tid * 16 + i * 8192, gR[i], gC[i]);
#pragma unroll
        for (int h = 0; h < 2; ++h)
#pragma unroll
            for (int i = 0; i < 2; ++i) { unsigned src = (unsigned)g.rowsrc[cur.pm * BM + h * HALF + gR[i]]; src = src < (unsigned)g.nsrc ? src : (unsigned)(g.nsrc - 1); gc[h][i] = (src * (unsigned)K + (unsigned)gC[i]) * 2u; }
    }
    f32x4 acc[2][2][4][2];
#pragma unroll
    for (int a = 0; a < 2; ++a)
#pragma unroll
        for (int b = 0; b < 2; ++b)
#pragma unroll
            for (int m = 0; m < 4; ++m)
#pragma unroll
                for (int n = 0; n < 2; ++n) acc[a][b][m][n] = (f32x4){0.f, 0.f, 0.f, 0.f};
    const int sc8_ = 0x7c7c7c7c;
    bf16x8 At[4][2], B0[2][2], B1[2][2]; v8i At8[4], B08[2], B18[2];
    const char* cA = GATH ? (const char*)g.A : (const char*)g.A + (size_t)cur.pm * tstepA; const char* cB = (const char*)g.Bt + S.boff(cur, tstep);
    S.a_ready(cur);
    if constexpr (SP2) {
        PG8_STAGE(PG8_SB(0, 0), cB, voffB); PG8_STAGE(PG8_SB(0, 1), cB + hstep, voffB);
        if constexpr (GATH) { PG8_STAGE_G(PG8_SA(0, 0), cA, gc[0][0], gc[0][1]); PG8_STAGE_G(PG8_SA(0, 1), cA, gc[1][0], gc[1][1]); } else { PG8_STAGE(PG8_SA(0, 0), cA, voffA); PG8_STAGE(PG8_SA(0, 1), cA + hstepA, voffA); }
        if (wr == 1) PG8_BAR;
        PG8_WAIT_V(2); PG8_BAR;
        PG8_STAGE(PG8_SB(1, 0), cB + kstep, voffB); if constexpr (GATH) PG8_STAGE_G(PG8_SA(1, 0), cA + kstep, gc[0][0], gc[0][1]); else PG8_STAGE(PG8_SA(1, 0), cA + kstep, voffA); PG8_STAGE(PG8_SB(1, 1), cB + hstep + kstep, voffB);
        PG8_WAIT_V(6); PG8_BAR;
    } else {
        PG8_STAGE(PG8_SB(0, 0), cB, voffB); PG8_STAGE(PG8_SA(0, 0), cA, voffA); PG8_STAGE(PG8_SB(0, 1), cB + hstep, voffB); PG8_STAGE(PG8_SA(0, 1), cA + hstepA, voffA);
        if (wr == 1) PG8_BAR;
        PG8_WAIT_V(4); PG8_BAR;
        PG8_STAGE(PG8_SB(1, 0), cB + kstep, voffB); PG8_STAGE(PG8_SA(1, 0), cA + kstep, voffA); PG8_STAGE(PG8_SB(1, 1), cB + hstep + kstep, voffB);
        PG8_WAIT_V(6); PG8_BAR;
    }
    for (;;) {
        const bool has_next = S.next(ui + 1, nxt);
        const char* nA = GATH ? cA : (has_next ? (const char*)g.A + (size_t)nxt.pm * tstepA : cA); const char* nB = has_next ? (const char*)g.Bt + S.boff(nxt, tstep) : cB;
        if constexpr (GATH) {
#pragma unroll
            for (int h = 0; h < 2; ++h)
#pragma unroll
                for (int i = 0; i < 2; ++i) { gn[h][i] = gc[h][i];
                    if (has_next) { unsigned src = (unsigned)g.rowsrc[nxt.pm * BM + h * HALF + gR[i]]; src = src < (unsigned)g.nsrc ? src : (unsigned)(g.nsrc - 1); gn[h][i] = (src * (unsigned)K + (unsigned)gC[i]) * 2u; } }
        }
#pragma nounroll
        for (int t = 0; t < nt; t += 2) {
            const bool last = (t == nt - 2);
            const char* a1 = cA + (size_t)(t + 1) * kstep;
            const char* a2 = last ? nA : cA + (size_t)(t + 2) * kstep; const char* b2 = last ? nB : cB + (size_t)(t + 2) * kstep;
            const char* a3 = a2 + kstep; const char* b3 = b2 + kstep;
            if (last && has_next) S.a_ready(nxt);
            if constexpr (SP2) {
            PG8_LDB(B0, 0, 0); PG8_LDB(B1, 0, 1); PG8_SCHED; PG8_LDA(At, 0, 0); if constexpr (GATH) PG8_STAGE_G(PG8_SA(1, 1), a1, gc[1][0], gc[1][1]); else PG8_STAGE(PG8_SA(1, 1), a1 + hstepA, voffA);
            PG8_WAIT_V(8); PG8_WAIT_L(0); PG8_BAR; PG8_SCHED8; PG8_MMA(0, 0, At, B0); PG8_MMA(0, 1, At, B1); PG8_SCHED8; PG8_BAR; PG8_SCHED;
            PG8_LDA(At, 0, 1); PG8_STAGE(PG8_SB(0, 0), b2, voffB); PG8_STAGE(PG8_SB(0, 1), b2 + hstep, voffB); if constexpr (GATH) PG8_STAGE_G(PG8_SA(0, 0), a2, last ? gn[0][0] : gc[0][0], last ? gn[0][1] : gc[0][1]); else PG8_STAGE(PG8_SA(0, 0), a2, voffA);
            PG8_WAIT_V(8); PG8_WAIT_L(0); PG8_BAR; PG8_SCHED8; PG8_MMA(1, 0, At, B0); PG8_MMA(1, 1, At, B1); PG8_SCHED8; PG8_BAR; PG8_SCHED;
            PG8_LDB(B0, 1, 0); PG8_LDB(B1, 1, 1); PG8_SCHED; PG8_LDA(At, 1, 0); if constexpr (GATH) PG8_STAGE_G(PG8_SA(0, 1), a2, last ? gn[1][0] : gc[1][0], last ? gn[1][1] : gc[1][1]); else PG8_STAGE(PG8_SA(0, 1), a2 + hstepA, voffA);
            PG8_WAIT_V(8); PG8_WAIT_L(0); PG8_BAR; PG8_SCHED8; PG8_MMA(0, 0, At, B0); PG8_MMA(0, 1, At, B1); PG8_SCHED8; PG8_BAR; PG8_SCHED;
            PG8_LDA(At, 1, 1); PG8_STAGE(PG8_SB(1, 0), b3, voffB); PG8_STAGE(PG8_SB(1, 1), b3 + hstep, voffB); if constexpr (GATH) PG8_STAGE_G(PG8_SA(1, 0), a3, last ? gn[0][0] : gc[0][0], last ? gn[0][1] : gc[0][1]); else PG8_STAGE(PG8_SA(1, 0), a3, voffA);
            PG8_WAIT_V(8); PG8_WAIT_L(0); PG8_BAR; PG8_SCHED8; PG8_MMA(1, 0, At, B0); PG8_MMA(1, 1, At, B1); PG8_SCHED8; PG8_BAR; PG8_SCHED;
            } else {
            PG8_LDB(B0, 0, 0); PG8_SCHED; PG8_LDA(At, 0, 0); PG8_STAGE(PG8_SA(1, 1), a1 + hstepA, voffA);
            PG8_WAIT_L(8); PG8_BAR; PG8_WAIT_L(0); PG8_MMA(0, 0, At, B0); PG8_BAR; PG8_SCHED;
            PG8_LDB(B1, 0, 1); PG8_STAGE(PG8_SB(0, 0), b2, voffB);
            PG8_BAR; PG8_WAIT_L(0); PG8_MMA(0, 1, At, B1); PG8_BAR;
            PG8_LDA(At, 0, 1); PG8_STAGE(PG8_SA(0, 0), a2, voffA);
            PG8_BAR; PG8_WAIT_L(0); PG8_MMA(1, 0, At, B0); PG8_BAR; PG8_SCHED;
            PG8_STAGE(PG8_SB(0, 1), b2 + hstep, voffB);
            PG8_WAIT_V(6); PG8_BAR; PG8_MMA(1, 1, At, B1); PG8_BAR;
            PG8_LDB(B0, 1, 0); PG8_SCHED; PG8_LDA(At, 1, 0); PG8_STAGE(PG8_SA(0, 1), a2 + hstepA, voffA);
            PG8_WAIT_L(8); PG8_BAR; PG8_WAIT_L(0); PG8_MMA(0, 0, At, B0); PG8_BAR; PG8_SCHED;
            PG8_LDB(B1, 1, 1); PG8_STAGE(PG8_SB(1, 0), b3, voffB);
            PG8_BAR; PG8_WAIT_L(0); PG8_MMA(0, 1, At, B1); PG8_BAR;
            PG8_LDA(At, 1, 1); PG8_STAGE(PG8_SA(1, 0), a3, voffA);
            PG8_BAR; PG8_WAIT_L(0); PG8_MMA(1, 0, At, B0); PG8_BAR; PG8_SCHED;
            PG8_STAGE(PG8_SB(1, 1), b3 + hstep, voffB);
            PG8_WAIT_V(6); PG8_BAR; PG8_MMA(1, 1, At, B1); PG8_BAR;
            }
        }
        if constexpr (F8) asm volatile("s_nop 15\n\ts_nop 15" ::: "memory");
        if constexpr (ALIGN_EPI) { if (wr == 0) PG8_BAR; }
        if constexpr (!Epi::AFTER_DRAIN) { E(acc, cur, wr, wc, fr, fq); S.done(cur); }
        if (!has_next) break;
#pragma unroll
        for (int a = 0; a < 2; ++a)
#pragma unroll
            for (int b = 0; b < 2; ++b)
#pragma unroll
                for (int m = 0; m < 4; ++m)
#pragma unroll
                    for (int n = 0; n < 2; ++n) acc[a][b][m][n] = (f32x4){0.f, 0.f, 0.f, 0.f};
        cur = nxt; cA = nA; cB = nB; ++ui;
        if constexpr (GATH) {
#pragma unroll
            for (int h = 0; h < 2; ++h)
#pragma unroll
                for (int i = 0; i < 2; ++i) gc[h][i] = gn[h][i]; }
        if constexpr (ALIGN_EPI) { if (wr == 1) PG8_BAR; }
    }
    PG8_WAIT_V(0);
    if constexpr (!ALIGN_EPI) { if (wr == 0) PG8_BAR; }
    PG8_BAR;
    if constexpr (Epi::AFTER_DRAIN) { E.fused(acc, cur, wr, wc, fr, fq, lds, wid, lane); S.done(cur); }
#undef PG8_SA
#undef PG8_SB
#undef PG8_STAGE
#undef PG8_STAGE_G
#undef PG8_LDA
#undef PG8_LDB
#undef PG8_MMA
#undef PG8_WAIT_V
#undef PG8_WAIT_L
#undef PG8_BAR
#undef PG8_SCHED
#undef PG8_SCHED8
}
}


constexpr int NB = 8, T = 8192, D = 1024, NTOK = NB * T, DIN = 2816, NL = 2, GW = 256;
constexpr int NWAVES = 8, NTHR = 512;
constexpr int HP = 2048;
constexpr int NEXP = 32, DEXP = 512;
constexpr int MAXTILES = (2 * NTOK) / 256 + NEXP;
constexpr int SROWS = MAXTILES * 256;
constexpr int C_HQ = 0, C_HF = 256, C_HI = 512, C_HG = 768, C_SU = 1024, C_RW = 1280, C_LG = 2304, C_LX = 2560;

constexpr size_t MiB = 1u << 20;
constexpr size_t WS_CTL = 0, CTL_ZERO_BYTES = 1 * MiB;
constexpr size_t WL_STRIDE = 105 * MiB;
constexpr size_t WO_IN = 0, WO_OUT = 6 * MiB, WO_GLU = 8 * MiB, WO_GU = 9 * MiB, WO_DN = 73 * MiB, WO_RT = 8 * MiB + 512 * 1024;
constexpr size_t WS_W = 1 * MiB;
constexpr size_t S5_STRIDE = 9 * MiB;
constexpr size_t S5O_F3 = 0, S5O_F1 = 4 * MiB, S5O_A16 = 8 * MiB;
constexpr size_t WS_S5 = 211 * MiB;
constexpr size_t WS_ACT = 229 * MiB;
constexpr size_t WS_PROJ = 357 * MiB;
constexpr size_t WS_MIX = 709 * MiB;
constexpr size_t WS_YG = WS_MIX + 128 * MiB;
constexpr size_t WS_VF = 869 * MiB;
constexpr size_t WS_HU = 901 * MiB;
constexpr size_t WS_XS = 933 * MiB;
constexpr size_t WS_ROUTE = 965 * MiB;
constexpr size_t WS_TCNT = 967 * MiB;
constexpr size_t WS_LG = 968 * MiB;
constexpr size_t WS_END = 986 * MiB;
static_assert(WS_PROJ + (size_t)NTOK * DIN * 2 <= WS_MIX && WS_PROJ + (size_t)SROWS * D * 2 <= WS_MIX, "proj region");
static_assert(WS_MIX + (size_t)SROWS * DEXP * 2 <= WS_VF, "mix region");
constexpr int CW_BAR = 4096;
constexpr int CW_CNT = 8192;
constexpr int CW_CUR = 8192 + 256;

constexpr int RING_BYTES = 131072;
constexpr int LDSCTL_OFF = RING_BYTES;
constexpr int LDS_TILE_E = LDSCTL_OFF + 64;
constexpr int LDS_MISC = LDS_TILE_E + MAXTILES * 4;
constexpr int LDS_BYTES = 147456;
static_assert(LDS_MISC + 1024 <= LDS_BYTES, "LDS map");

typedef unsigned short bf16;
typedef float f32x4 __attribute__((ext_vector_type(4)));
typedef float f32x2 __attribute__((ext_vector_type(2)));
typedef unsigned u32x4 __attribute__((ext_vector_type(4)));
typedef unsigned u32x2 __attribute__((ext_vector_type(2)));
typedef short bf16x8 __attribute__((ext_vector_type(8)));

typedef __bf16 hwbf2 __attribute__((ext_vector_type(2)));
__device__ __forceinline__ unsigned cvt2(float lo, float hi) { const f32x2 v = {lo, hi}; return __builtin_bit_cast(unsigned, __builtin_convertvector(v, hwbf2)); }
__device__ __forceinline__ unsigned pk2(float lo, float hi) { return cvt2(lo, hi); }
__device__ __forceinline__ unsigned f2bf(float f) { return cvt2(f, 0.f) & 0xffffu; }
__device__ __forceinline__ float bf2f(unsigned b) { return __builtin_bit_cast(float, b << 16); }
__device__ __forceinline__ float bflo(unsigned w) { return __builtin_bit_cast(float, w << 16); }
__device__ __forceinline__ float bfhi(unsigned w) { return __builtin_bit_cast(float, w & 0xffff0000u); }
__device__ __forceinline__ void unpack8(const u32x4 w, float (&o)[8]) { o[0] = bflo(w.x); o[1] = bfhi(w.x); o[2] = bflo(w.y); o[3] = bfhi(w.y); o[4] = bflo(w.z); o[5] = bfhi(w.z); o[6] = bflo(w.w); o[7] = bfhi(w.w); }
__device__ __forceinline__ float frcp(float x) { return __builtin_amdgcn_rcpf(x); }
__device__ __forceinline__ float sigmoidf_(float x) { return frcp(1.f + __expf(-x)); }
__device__ __forceinline__ float siluf_(float x) { return x * frcp(1.f + __expf(-x)); }
__device__ __forceinline__ float softplusf_(float x) { return x > 15.f ? x : __logf(1.f + __expf(x)); }
__device__ __forceinline__ float gelu_tanh(float x) { const float u = 0.7978845608028654f * (x + 0.044715f * x * x * x); return x * frcp(1.f + __expf(-2.f * u)); }
#define DPPF(v, ctrl) __builtin_bit_cast(float, __builtin_amdgcn_update_dpp(0, __builtin_bit_cast(int, (v)), (ctrl), 0xf, 0xf, true))
__device__ __forceinline__ float row16_sum(float v) {
    v += DPPF(v, 0xB1);
    v += DPPF(v, 0x4E);
    v += DPPF(v, 0x141);
    v += DPPF(v, 0x140);
    return v;
}
__device__ __forceinline__ float wave_sum(float v) {
    v = row16_sum(v);
    return (__builtin_bit_cast(float, __builtin_amdgcn_readlane(__builtin_bit_cast(int, v), 0)) + __builtin_bit_cast(float, __builtin_amdgcn_readlane(__builtin_bit_cast(int, v), 16)))
         + (__builtin_bit_cast(float, __builtin_amdgcn_readlane(__builtin_bit_cast(int, v), 32)) + __builtin_bit_cast(float, __builtin_amdgcn_readlane(__builtin_bit_cast(int, v), 48)));
}
__device__ __forceinline__ float half_sum(float v, int lane) {
    v = row16_sum(v);
    const float a = __builtin_bit_cast(float, __builtin_amdgcn_readlane(__builtin_bit_cast(int, v), 0)) + __builtin_bit_cast(float, __builtin_amdgcn_readlane(__builtin_bit_cast(int, v), 16));
    const float b = __builtin_bit_cast(float, __builtin_amdgcn_readlane(__builtin_bit_cast(int, v), 32)) + __builtin_bit_cast(float, __builtin_amdgcn_readlane(__builtin_bit_cast(int, v), 48));
    return (lane & 32) ? b : a;
}
#define PIN1(a) asm volatile("" : "+v"(a))
#define PIN2(v) asm volatile("" : "+v"((v).x), "+v"((v).y))
#define PIN4(v) asm volatile("" : "+v"((v).x), "+v"((v).y), "+v"((v).z), "+v"((v).w))
#define LDS_WAIT() asm volatile("s_waitcnt lgkmcnt(0)" ::: "memory")
#define LDS_BARRIER() do { asm volatile("s_waitcnt lgkmcnt(0)" ::: "memory"); __builtin_amdgcn_s_barrier(); asm volatile("" ::: "memory"); } while (0)


#define XB_TMO      128
#define XB_XCNT(j)  (256  + 64 * (j))
#define XB_XSUB(j)  (1280 + 64 * (j))
#define XB_XGEN(j)  (2304 + 64 * (j))
#define XB_TOP      3328
#define XB_TOPGEN   3392
#define XCD_BAR_WORDS 3456
#define XB_SPIN_CAP (1u << 18)

__device__ __forceinline__ unsigned xb_ld(unsigned* p)              { return __hip_atomic_load(p, __ATOMIC_RELAXED, __HIP_MEMORY_SCOPE_AGENT); }
__device__ __forceinline__ unsigned xb_add(unsigned* p, unsigned v) { return __hip_atomic_fetch_add(p, v, __ATOMIC_RELAXED, __HIP_MEMORY_SCOPE_AGENT); }
__device__ __forceinline__ unsigned xb_xcc_id() { return (unsigned)__builtin_amdgcn_s_getreg((3 << 11) | 20) & 0xFu; }
#define XB_SPIN(cond, bar) do { unsigned _sp = 0; while (cond) { __builtin_amdgcn_s_sleep(1); \
    if ((++_sp & 255u) == 0u) { if (xb_ld(&(bar)[XB_TMO])) break; if (_sp > XB_SPIN_CAP) { atomicAdd(&(bar)[XB_TMO], 1u); break; } } } } while (0)

struct XcdBarrier {
    unsigned* bar; unsigned x;
    volatile LAS unsigned* st;
};

__device__ __forceinline__ XcdBarrier xcd_barrier_post(unsigned* bar, volatile LAS unsigned* st) {
    XcdBarrier b; b.bar = bar; b.x = xb_xcc_id(); b.st = st;
    if (threadIdx.x == 0) (void)xb_add(&bar[XB_XCNT(b.x)], 1u);
    return b;
}
__device__ __forceinline__ void xcd_barrier_complete(unsigned* bar, unsigned x, unsigned& nloc, unsigned& nx) {
    const unsigned G = gridDim.x * gridDim.y * gridDim.z;
    unsigned sum, cnt, mine, sp = 0u;
    for (;;) {
        sum = 0u; cnt = 0u; mine = 0u;
#pragma unroll
        for (unsigned j = 0; j < 16; ++j) { const unsigned c = xb_ld(&bar[XB_XCNT(j)]); sum += c; cnt += (c > 0u) ? 1u : 0u; mine = (j == x) ? c : mine; }
        if (sum == G) break;
        __builtin_amdgcn_s_sleep(1);
        if ((++sp & 255u) == 0u) { if (xb_ld(&bar[XB_TMO])) break; if (sp > XB_SPIN_CAP) { atomicAdd(&bar[XB_TMO], 1u); break; } }
    }
    nloc = mine > 0u ? mine : 1u; nx = cnt > 0u ? cnt : 1u;
}

__device__ __forceinline__ void xcd_barrier(const XcdBarrier& b) {
    asm volatile("s_waitcnt vmcnt(0)" ::: "memory");
    __syncthreads();
    if (threadIdx.x == 0) {
        unsigned* bar = b.bar;
        __builtin_amdgcn_s_waitcnt(0);
        unsigned nloc = b.st[0], nx = b.st[1];
        if (nloc == 0u) { xcd_barrier_complete(bar, b.x, nloc, nx); b.st[0] = nloc; b.st[1] = nx; }
        const unsigned old = xb_add(&bar[XB_XSUB(b.x)], 1u);
        const unsigned gen = old / nloc;
        if (old + 1u == (gen + 1u) * nloc) {
            __builtin_amdgcn_fence(__ATOMIC_RELEASE, "agent");
            asm volatile("s_waitcnt vmcnt(0)" ::: "memory");
            const unsigned og = xb_add(&bar[XB_TOP], 1u);
            const unsigned tg = og / nx;
            if (og + 1u == (tg + 1u) * nx) xb_add(&bar[XB_TOPGEN], 1u);
            else XB_SPIN(xb_ld(&bar[XB_TOPGEN]) == tg, bar);
            __builtin_amdgcn_fence(__ATOMIC_ACQUIRE, "agent");
            xb_add(&bar[XB_XGEN(b.x)], 1u);
            asm volatile("s_waitcnt vmcnt(0)" ::: "memory");
        } else {
            XB_SPIN(xb_ld(&bar[XB_XGEN(b.x)]) == gen, bar);
            __builtin_amdgcn_fence(__ATOMIC_ACQUIRE, "agent");
            asm volatile("s_waitcnt vmcnt(0)" ::: "memory");
        }
    }
    __syncthreads();
}


struct Params { const float* in[46]; float* out; unsigned char* ws; int ph_lo, ph_hi; };
enum { I_X = 0, I_NORM1, I_WIN, I_HLB, I_HNW, I_S5LR, I_S5LI, I_S5DT, I_S5BR, I_S5BI, I_S5CR, I_S5CI, I_S5D, I_S5GLU, I_RMU, I_RW0, I_RW2, I_RA0, I_RA2, I_RG2,
       I_RKK, I_RKA, I_RRK, I_RV0, I_RV1, I_RV2, I_RLNW, I_RLNB, I_LCW, I_LCB, I_LWA, I_LBA, I_LWX, I_LBX, I_LLAM, I_MGAIN, I_WOUT, I_NORM2, I_MCW, I_MCB, I_MFW, I_MFB,
       I_MWG, I_MWU, I_MWD, I_FNW };

__device__ __forceinline__ void transpose_item(const float* W, int ldw, int k0, int n0, bf16* dst, int K, LAS float* scr, int lane) {
#pragma unroll 8
    for (int i = 0; i < 32; ++i) { const int kk = 2 * i + (lane >> 5); scr[kk * 33 + (lane & 31)] = W[(size_t)(k0 + kk) * ldw + n0 + (lane & 31)]; }
    LDS_WAIT(); asm volatile("" ::: "memory");
    const int c = lane & 7;
#pragma unroll
    for (int j = 0; j < 4; ++j) { const int n = (lane >> 3) + 8 * j; const LAS float* s = scr + (8 * c) * 33 + n;
        u32x4 o; o.x = pk2(s[0 * 33], s[1 * 33]); o.y = pk2(s[2 * 33], s[3 * 33]); o.z = pk2(s[4 * 33], s[5 * 33]); o.w = pk2(s[6 * 33], s[7 * 33]);
        *(u32x4*)(dst + (size_t)n * K + k0 + 8 * c) = o; }
    LDS_WAIT(); asm volatile("" ::: "memory");
}
__device__ __forceinline__ void transpose_item_f8(const float* W, int ldw, int k0, int n0, unsigned char* dst, int Kb, float sc, LAS float* scr, int lane) {
#pragma unroll 8
    for (int i = 0; i < 32; ++i) { const int kk = 2 * i + (lane >> 5); scr[kk * 33 + (lane & 31)] = W[(size_t)(k0 + kk) * ldw + n0 + (lane & 31)]; }
    LDS_WAIT(); asm volatile("" ::: "memory");
    const int c = lane & 7;
#pragma unroll
    for (int j = 0; j < 4; ++j) { const int n = (lane >> 3) + 8 * j; const LAS float* p = scr + (8 * c) * 33 + n; int w0 = 0, w1 = 0;
        w0 = __builtin_amdgcn_cvt_pk_fp8_f32(p[0 * 33] * sc, p[1 * 33] * sc, w0, false); w0 = __builtin_amdgcn_cvt_pk_fp8_f32(p[2 * 33] * sc, p[3 * 33] * sc, w0, true);
        w1 = __builtin_amdgcn_cvt_pk_fp8_f32(p[4 * 33] * sc, p[5 * 33] * sc, w1, false); w1 = __builtin_amdgcn_cvt_pk_fp8_f32(p[6 * 33] * sc, p[7 * 33] * sc, w1, true);
        *(unsigned long long*)(dst + (size_t)n * Kb + k0 + 8 * c) = (unsigned long long)(unsigned)w0 | ((unsigned long long)(unsigned)w1 << 32); }
    LDS_WAIT(); asm volatile("" ::: "memory");
}
constexpr int IT_IN = 16 * 88, IT_OUT = 16 * 32, IT_GLU = 4 * 16, IT_EXP = 32 * 256, IT_LAYER = IT_IN + IT_OUT + IT_GLU + 3 * IT_EXP;
__device__ __forceinline__ void prologue_item(const Params& P, int it, LAS float* scr, int lane) {
    const int l = it / IT_LAYER; int r = it % IT_LAYER;
    bf16* wl = (bf16*)(P.ws + WS_W + (size_t)l * WL_STRIDE);
    if (r < IT_IN) { const int kb = r / 88, nb = r % 88; transpose_item(P.in[I_WIN] + (size_t)l * D * DIN, DIN, 64 * kb, 32 * nb, (bf16*)((unsigned char*)wl + WO_IN) + (size_t)(32 * nb) * D, D, scr, lane); return; } r -= IT_IN;
    if (r < IT_OUT) { const int kb = r / 32, nb = r % 32; transpose_item(P.in[I_WOUT] + (size_t)l * D * D, D, 64 * kb, 32 * nb, (bf16*)((unsigned char*)wl + WO_OUT) + (size_t)(32 * nb) * D, D, scr, lane); return; } r -= IT_OUT;
    if (r < IT_GLU) { const int kb = r / 16, nb = r % 16, n0 = 32 * nb, nn = n0 & 255, drow = (nn >> 7) * 256 + (nn & 127) + ((n0 >> 8) ? 128 : 0);
        transpose_item(P.in[I_S5GLU] + (size_t)l * 256 * 512, 512, 64 * kb, n0, (bf16*)((unsigned char*)wl + WO_GLU) + (size_t)drow * 256, 256, scr, lane); return; } r -= IT_GLU;
    if (r < 2 * IT_EXP) { const int up = r / IT_EXP; r %= IT_EXP; const int e = r >> 8, q = r & 255, kb = q >> 4, nb = q & 15, n0 = 32 * nb, drow = (n0 >> 7) * 256 + (n0 & 127) + (up ? 128 : 0);
        transpose_item_f8(P.in[up ? I_MWU : I_MWG] + (size_t)(l * NEXP + e) * D * DEXP, DEXP, 64 * kb, n0, (unsigned char*)wl + WO_GU + (size_t)e * D * D + (size_t)drow * D, D, 64.f, scr, lane); return; } r -= 2 * IT_EXP;
    { const int e = r >> 8, q = r & 255, kb = q >> 5, nb = q & 31;
      transpose_item_f8(P.in[I_MWD] + (size_t)(l * NEXP + e) * DEXP * D, D, 64 * kb, 32 * nb, (unsigned char*)wl + WO_DN + (size_t)e * D * DEXP + (size_t)(32 * nb) * DEXP, DEXP, 64.f, scr, lane); }
}
__device__ __forceinline__ void rms_store_bf16(const f32x4 (&v)[4], const float* gain, bf16* orow, int lane) {
    float s = 0.f;
#pragma unroll
    for (int j = 0; j < 4; ++j) s += (v[j].x * v[j].x + v[j].y * v[j].y) + (v[j].z * v[j].z + v[j].w * v[j].w);
    const float rstd = 1.f / sqrtf(wave_sum(s) * (1.f / D) + 1e-6f);
    u32x2* o8 = (u32x2*)orow + lane;
#pragma unroll
    for (int j = 0; j < 4; ++j) { const f32x4 g = *((const f32x4*)gain + lane + 64 * j); u32x2 w; w.x = pk2(v[j].x * rstd * g.x, v[j].y * rstd * g.y); w.y = pk2(v[j].z * rstd * g.z, v[j].w * rstd * g.w); o8[64 * j] = w; }
}
__device__ __forceinline__ void s5_pow(float lr, float li, double dt, int j, float& ar, float& ai) {
    const double m = exp((double)lr * dt * (double)j); double ang = (double)li * dt * (double)j; ang -= 6.283185307179586 * rint(ang * 0.15915494309189535);
    ar = (float)(m * cos(ang)); ai = (float)(m * sin(ang));
}
__device__ __forceinline__ void s5_consts_unit(const Params& P, int l, int g, LAS unsigned char* lds, int tid) {
    LAS float* PW = (LAS float*)lds;
    LAS float* BBr = PW + 64 * 17 * 2;
    LAS float* BBi = BBr + 1024;
    LAS float* Cr = BBi + 1024;
    LAS float* Ci = Cr + 1024;
    LAS float* KT = Ci + 1024;
    const int lg = l * 16 + g;
    const double dt = exp((double)P.in[I_S5DT][lg]);
    const float* lrp = P.in[I_S5LR] + (size_t)lg * 64; const float* lip = P.in[I_S5LI] + (size_t)lg * 64;
    for (int idx = tid; idx < 64 * 17; idx += NTHR) { const int p = idx / 17, j = idx % 17; float ar, ai; s5_pow(lrp[p], lip[p], dt, j, ar, ai); PW[idx * 2] = ar; PW[idx * 2 + 1] = ai; }
    for (int idx = tid; idx < 1024; idx += NTHR) { const int p = idx >> 4, c = idx & 15; const float lr = lrp[p], li = lip[p]; float ar, ai; s5_pow(lr, li, dt, 1, ar, ai);
        const float den = lr * lr + li * li, kr = ((ar - 1.f) * lr + ai * li) / den, ki = (ai * lr - (ar - 1.f) * li) / den;
        const float br = P.in[I_S5BR][((size_t)lg * 64 + p) * 16 + c], bi = P.in[I_S5BI][((size_t)lg * 64 + p) * 16 + c];
        BBr[idx] = kr * br - ki * bi; BBi[idx] = kr * bi + ki * br;
        Cr[idx] = P.in[I_S5CR][(size_t)lg * 1024 + idx]; Ci[idx] = P.in[I_S5CI][(size_t)lg * 1024 + idx]; }
    __syncthreads();
    for (int idx = tid; idx < 4096; idx += NTHR) { const int j = idx >> 8, c = (idx >> 4) & 15, cp = idx & 15; float acc = 0.f;
        for (int p = 0; p < 64; ++p) { const float ar = PW[(p * 17 + j) * 2], ai = PW[(p * 17 + j) * 2 + 1], br = BBr[p * 16 + cp], bi = BBi[p * 16 + cp], cr = Cr[c * 64 + p], ci = Ci[c * 64 + p];
            const float zr = ar * br - ai * bi, zi = ar * bi + ai * br; acc += cr * zr - ci * zi; }
        KT[idx] = acc; }
    __syncthreads();
    unsigned char* sb = P.ws + WS_S5 + (size_t)l * S5_STRIDE;
    bf16* F3 = (bf16*)(sb + S5O_F3) + (size_t)g * 98304; bf16* F1 = (bf16*)(sb + S5O_F1) + (size_t)g * 32768; float* A16 = (float*)(sb + S5O_A16) + (size_t)g * 128;
    for (int idx = tid; idx < 98304; idx += NTHR) { const int j = idx & 7, ln = (idx >> 3) & 63, fk = idx >> 9, ks = fk % 12, rt = fk / 12; const int row = 16 * rt + (ln & 15), k = 32 * ks + 8 * (ln >> 4) + j, t = row >> 4, c = row & 15; float val;
        if (k < 256) { const int s2 = k >> 4, cp = k & 15; val = (s2 <= t) ? KT[((t - s2) * 16 + c) * 16 + cp] : 0.f; }
        else { const int n = k - 256, p = n & 63; const float ar = PW[(p * 17 + t + 1) * 2], ai = PW[(p * 17 + t + 1) * 2 + 1], cr = Cr[c * 64 + p], ci = Ci[c * 64 + p]; val = (n < 64) ? (cr * ar - ci * ai) : -(cr * ai + ci * ar); }
        F3[idx] = (bf16)f2bf(val); }
    for (int idx = tid; idx < 32768; idx += NTHR) { const int j = idx & 7, ln = (idx >> 3) & 63, fk = idx >> 9, ks = fk & 7, rt = fk >> 3; const int n = 16 * rt + (ln & 15), k = 32 * ks + 8 * (ln >> 4) + j, p = n & 63, s2 = k >> 4, cp = k & 15;
        const float ar = PW[(p * 17 + 15 - s2) * 2], ai = PW[(p * 17 + 15 - s2) * 2 + 1], br = BBr[p * 16 + cp], bi = BBi[p * 16 + cp];
        F1[idx] = (bf16)f2bf((n < 64) ? (ar * br - ai * bi) : (ar * bi + ai * br)); }
    if (tid < 64) { A16[tid * 2] = PW[(tid * 17 + 16) * 2]; A16[tid * 2 + 1] = PW[(tid * 17 + 16) * 2 + 1]; }
    __syncthreads();
}
__device__ __forceinline__ void ph_prologue(const Params& P, LAS unsigned char* lds, int tid, int lane, int wave) {
    for (int u = blockIdx.x; u < NL * 16; u += gridDim.x) s5_consts_unit(P, u >> 4, u & 15, lds, tid);
    LAS float* scr = (LAS float*)(lds + wave * 16384);
    const int gw = blockIdx.x * NWAVES + wave, NGW = gridDim.x * NWAVES;
    for (int it = gw; it < NL * IT_LAYER; it += NGW) prologue_item(P, it, scr, lane);
    for (int idx = blockIdx.x * NTHR + tid; idx < NL * 256 * 1024; idx += gridDim.x * NTHR) { const int l = idx >> 18, n = (idx >> 10) & 255, k = idx & 1023; float val = 0.f;
        if (n < 72) { const int j = n % 36; const float w = (j < 4) ? P.in[I_MCW][((size_t)l * D + k) * 4 + j] : P.in[I_MFW][(((size_t)l * 4 + ((j - 4) >> 3)) * D + k) * 8 + ((j - 4) & 7)]; val = w * P.in[I_NORM2][(size_t)l * D + k]; }
        const unsigned hi = f2bf(val); const float rem = val - __builtin_bit_cast(float, hi << 16);
        ((bf16*)(P.ws + WS_W + (size_t)l * WL_STRIDE + WO_RT))[(size_t)n * D + k] = (bf16)((n >= 36) ? f2bf(rem) : hi); }
    bf16* act = (bf16*)(P.ws + WS_ACT);
    for (int m = gw; m < NTOK; m += NGW) {
        const f32x4* xr = (const f32x4*)(P.in[I_X] + (size_t)m * D) + lane; f32x4 v[4];
#pragma unroll
        for (int j = 0; j < 4; ++j) v[j] = xr[64 * j];
        rms_store_bf16(v, P.in[I_NORM1], act + (size_t)m * D, lane);
    }
}


__device__ __forceinline__ u32x4 ldg16(const bf16* p) { return *(const u32x4*)p; }

#define MF(a, b, c) __builtin_amdgcn_mfma_f32_16x16x32_bf16((a), (b), (c), 0, 0, 0)
__device__ __forceinline__ u32x2 pack4(const f32x4 d) { u32x2 w; w.x = cvt2(d[0], d[1]); w.y = cvt2(d[2], d[3]); return w; }
__device__ __forceinline__ bf16x8 cat8(const u32x2 lo, const u32x2 hi) { u32x4 w; w.x = lo.x; w.y = lo.y; w.z = hi.x; w.w = hi.y; return __builtin_bit_cast(bf16x8, w); }
__device__ __forceinline__ bf16x8 pack_lo(const f32x4 d) { return cat8(pack4(d), (u32x2){0u, 0u}); }
__device__ __forceinline__ bf16x8 pack2(const f32x4 a, const f32x4 b) { return cat8(pack4(a), pack4(b)); }

__device__ __forceinline__ void role_hgrn(const Params& P, int l, int b, int hd, LAS unsigned char* lds, int tid, int lane, int wave) {
    LAS float* LF = (LAS float*)lds; LAS float* Oa = LF + 1024; LAS float* GamC = Oa + 1024;
    LAS bf16* Qh = (LAS bf16*)(GamC + 64); LAS bf16* Kt = Qh + 16 * 72; LAS bf16* KbarT = Kt + 16 * 72; LAS bf16* VmTb = KbarT + 64 * 24;
    const bf16* proj = (const bf16*)(P.ws + WS_PROJ); bf16* mix = (bf16*)(P.ws + WS_MIX);
    const int tl = tid & 255, tt = tl >> 4, j4 = (tl & 15) * 4, r = lane & 15, q = lane >> 4;
    const int tA = (wave < 4) ? (lane & 15) : tt, jA = (wave < 4) ? 16 * wave + 4 * (lane >> 4) : j4;
    f32x4 lb = {0.f, 0.f, 0.f, 0.f};
    if (l > 0) {
#pragma unroll
        for (int i = 0; i < 4; ++i) { const int c = hd * 64 + jA + i; lb[i] = 1.f / (1.f + expf(P.in[I_HLB][c] - P.in[I_HLB][256 + c])); } }
    const f32x4 nw = *(const f32x4*)(P.in[I_HNW] + l * 256 + hd * 64 + j4);
    f32x4 st[4];
#pragma unroll
    for (int i = 0; i < 4; ++i) st[i] = (f32x4){0.f, 0.f, 0.f, 0.f};
    const bf16* pr0 = proj + ((size_t)b * T + tA) * DIN + hd * 64 + jA;
    u32x2 n0a, n1a, n0b, n1b; f32x4 qv = lb, kkv = lb, civ = lb, cmv = lb, sgc = lb, sgn = lb;
    { const int o0 = (wave < 4) ? C_HQ : C_HI, o1 = (wave < 4) ? C_HF : C_HG;
      n0a = *(const u32x2*)(pr0 + o0); n1a = *(const u32x2*)(pr0 + o1); n0b = *(const u32x2*)(pr0 + (size_t)16 * DIN + o0); n1b = *(const u32x2*)(pr0 + (size_t)16 * DIN + o1); }
#define HG_STAGE_A(c, N0, N1) do { u32x2 rq = N0, rf = N1; PIN2(rq); PIN2(rf); \
        { const int cn_ = (c) + 2 < T / 16 ? (c) + 2 : T / 16 - 1; const bf16* pn = pr0 + (size_t)cn_ * 16 * DIN; N0 = *(const u32x2*)(pn + C_HQ); N1 = *(const u32x2*)(pn + C_HF); } \
        const f32x4 fx = {bflo(rf.x), bfhi(rf.x), bflo(rf.y), bfhi(rf.y)}, qx = {bflo(rq.x), bfhi(rq.x), bflo(rq.y), bfhi(rq.y)}; \
        f32x4 lfv; \
        _Pragma("unroll") for (int i = 0; i < 4; ++i) { const float e = __expf(fminf(-fx[i], 80.f)), ri_ = frcp(1.f + e); const float f = lb[i] + (1.f - lb[i]) * ri_; kkv[i] = (1.f - lb[i]) * e * ri_; lfv[i] = __logf(f); qv[i] = siluf_(qx[i]); } \
          \
        _Pragma("unroll") for (int i = 0; i < 4; ++i) { float p_ = lfv[i], s_ = lfv[i]; \
            p_ += DPPF(p_, 0x111); p_ += DPPF(p_, 0x112); p_ += DPPF(p_, 0x114); p_ += DPPF(p_, 0x118); \
            s_ += DPPF(s_, 0x101); s_ += DPPF(s_, 0x102); s_ += DPPF(s_, 0x104); s_ += DPPF(s_, 0x108); \
            civ[i] = p_; cmv[i] = s_ - lfv[i]; } } while (0)
#define HG_STAGE_V(c, N0, N1) do { u32x2 ri = N0, rg = N1; PIN2(ri); PIN2(rg); \
        { const int cn_ = (c) + 2 < T / 16 ? (c) + 2 : T / 16 - 1; const bf16* pn = pr0 + (size_t)cn_ * 16 * DIN; N0 = *(const u32x2*)(pn + C_HI); N1 = *(const u32x2*)(pn + C_HG); } \
        const f32x4 ix = {bflo(ri.x), bfhi(ri.x), bflo(ri.y), bfhi(ri.y)}, gx = {bflo(rg.x), bfhi(rg.x), bflo(rg.y), bfhi(rg.y)}; f32x4 vv; LAS bf16* VmT_ = VmTb + ((c) & 1) * 1536; \
        _Pragma("unroll") for (int i = 0; i < 4; ++i) { vv[i] = siluf_(ix[i]); sgn[i] = siluf_(gx[i]); } \
        { const u32x2 vp = pack4(vv); VmT_[(j4 + 0) * 24 + tt] = (bf16)(vp.x & 0xffffu); VmT_[(j4 + 1) * 24 + tt] = (bf16)(vp.x >> 16); VmT_[(j4 + 2) * 24 + tt] = (bf16)(vp.y & 0xffffu); VmT_[(j4 + 3) * 24 + tt] = (bf16)(vp.y >> 16); } } while (0)
#define HG_STAGE_B(c) do { f32x4 qh, kt, kb; \
        _Pragma("unroll") for (int i = 0; i < 4; ++i) { qh[i] = qv[i] * __expf(civ[i]); kt[i] = kkv[i] * __expf(fminf(-civ[i], 80.f)); kb[i] = kkv[i] * __expf(cmv[i]); } \
        *(LAS u32x2*)(Qh + tA * 72 + jA) = pack4(qh); *(LAS u32x2*)(Kt + tA * 72 + jA) = pack4(kt); \
        { const u32x2 kbp = pack4(kb); KbarT[(jA + 0) * 24 + tA] = (bf16)(kbp.x & 0xffffu); KbarT[(jA + 1) * 24 + tA] = (bf16)(kbp.x >> 16); KbarT[(jA + 2) * 24 + tA] = (bf16)(kbp.y & 0xffffu); KbarT[(jA + 3) * 24 + tA] = (bf16)(kbp.y >> 16); } \
        if (tA == 15) { f32x4 gc; _Pragma("unroll") for (int i = 0; i < 4; ++i) gc[i] = __expf(civ[i]); *(LAS f32x4*)(GamC + jA) = gc; } } while (0)
    if (wave < 4) HG_STAGE_A(0, n0a, n1a); else { HG_STAGE_V(0, n0a, n1a); sgc = sgn; }
    PIN2(n0b); PIN2(n1b);
    __syncthreads();
    if (wave < 4) HG_STAGE_B(0);
    __syncthreads();
    PIN2(n0a); PIN2(n1a);
    if (wave < 4) {
#pragma unroll 1
        for (int c = 0; c < T / 16; c += 2) { const int cn = c + 2 < T / 16 ? c + 2 : T / 16 - 1;
            HG_STAGE_A(c + 1, n0b, n1b); LDS_BARRIER(); HG_STAGE_B(c + 1); LDS_BARRIER();
            HG_STAGE_A(cn, n0a, n1a); LDS_BARRIER(); HG_STAGE_B(cn); LDS_BARRIER(); }
    } else {
#define HG_RO(c, cn, N0, N1) do { \
            { const int vt = wave - 4; const f32x4 z4 = {0.f, 0.f, 0.f, 0.f}; f32x4 AT = z4, o = z4; const LAS bf16* VmT_ = VmTb + ((c) & 1) * 1536; \
_Pragma("unroll")               for (int ks = 0; ks < 2; ++ks) AT = MF(*(const LAS bf16x8*)(Kt + r * 72 + ks * 32 + q * 8), *(const LAS bf16x8*)(Qh + r * 72 + ks * 32 + q * 8), AT);    \
_Pragma("unroll")               for (int i = 0; i < 4; ++i) AT[i] = (4 * q + i <= r) ? AT[i] : 0.f; \
              const u32x2 vmB = *(const LAS u32x2*)(VmT_ + (16 * vt + r) * 24 + 4 * q); const bf16x8 bV = cat8(vmB, (u32x2){0u, 0u}); \
_Pragma("unroll")               for (int ks = 0; ks < 2; ++ks) o = MF(cat8(*(const LAS u32x2*)(Qh + r * 72 + 32 * ks + 4 * q), *(const LAS u32x2*)(Qh + r * 72 + 32 * ks + 16 + 4 * q)), pack2(st[2 * ks], st[2 * ks + 1]), o); \
              o = MF(pack_lo(AT), bV, o); \
_Pragma("unroll")               for (int i = 0; i < 4; ++i) Oa[(4 * q + i) * 64 + 16 * vt + r] = o[i]; \
_Pragma("unroll")               for (int kt = 0; kt < 4; ++kt) { const f32x4 g4 = *(const LAS f32x4*)(GamC + 16 * kt + 4 * q); \
                  st[kt] = MF(cat8(*(const LAS u32x2*)(KbarT + (16 * kt + r) * 24 + 4 * q), (u32x2){0u, 0u}), bV, st[kt] * g4); } } \
            LDS_BARRIER(); \
            { const f32x4 o4 = *(const LAS f32x4*)(Oa + tt * 64 + j4); \
              const float ss = row16_sum((o4[0] * o4[0] + o4[1] * o4[1]) + (o4[2] * o4[2] + o4[3] * o4[3])); const float rs = __builtin_amdgcn_rsqf(ss * (1.f / 64.f) + 1e-6f); \
              *(u32x2*)(mix + ((size_t)b * T + (c) * 16 + tt) * D + hd * 64 + j4) = pack4(o4 * rs * nw * sgc); \
              HG_STAGE_V(cn, N0, N1); sgc = sgn; } \
            LDS_BARRIER(); \
    } while (0)
#pragma unroll 1
        for (int c = 0; c < T / 16; c += 2) { const int cn2 = c + 2 < T / 16 ? c + 2 : T / 16 - 1;
            HG_RO(c, c + 1, n0b, n1b); HG_RO(c + 1, cn2, n0a, n1a); }
#undef HG_RO
    }
#undef HG_STAGE_A
#undef HG_STAGE_V
#undef HG_STAGE_B
}

__device__ __forceinline__ f32x4 mma_tile(const LAS bf16* A, int lda, const LAS bf16* Bt, int ldb, int K, int lane) {
    f32x4 acc = {0.f, 0.f, 0.f, 0.f}; const int r = lane & 15, q = lane >> 4;
    for (int k0 = 0; k0 < K; k0 += 32) { const bf16x8 a = *(const LAS bf16x8*)(A + r * lda + k0 + q * 8); const bf16x8 b = *(const LAS bf16x8*)(Bt + r * ldb + k0 + q * 8);
        acc = __builtin_amdgcn_mfma_f32_16x16x32_bf16(a, b, acc, 0, 0, 0); }
    return acc;
}
__device__ __forceinline__ void lds_load_wT(const float* W, int ldw, int n0, int N, int K, LAS bf16* Wt, int ldt, int tid) {
#pragma unroll 2
    for (int idx = tid; idx < K * N; idx += NTHR) { const int k = idx / N, n = idx % N; Wt[n * ldt + k] = (bf16)f2bf(W[(size_t)k * ldw + n0 + n]); }
}

__device__ __forceinline__ void role_lru(const Params& P, int l, int b, int hd, LAS unsigned char* lds, int tid, int lane, int wave) {
    LAS float* XR = (LAS float*)lds; LAS float* LG = XR + 67 * 64; LAS float* XC = LG + 4096; LAS float* RL = XC + 4096; LAS float* GL = RL + 4096;
    LAS bf16* XCb = (LAS bf16*)(GL + 4096); LAS bf16* WaT = XCb + 64 * 72; LAS bf16* WxT = WaT + 64 * 72; LAS float* CWL = (LAS float*)(WxT + 64 * 72);
    const bf16* proj = (const bf16*)(P.ws + WS_PROJ); bf16* mix = (bf16*)(P.ws + WS_MIX);
    const int tt = tid >> 3, c8 = (tid & 7) * 8;
    lds_load_wT(P.in[I_LWA] + (size_t)(l * 4 + hd) * 4096, 64, 0, 64, 64, WaT, 72, tid);
    lds_load_wT(P.in[I_LWX] + (size_t)(l * 4 + hd) * 4096, 64, 0, 64, 64, WxT, 72, tid);
    if (tid < 320) { const int jj = tid >> 6, c = tid & 63; CWL[tid] = (jj < 4) ? P.in[I_LCW][(size_t)l * 4 * 256 + jj * 256 + hd * 64 + c] : P.in[I_LCB][l * 256 + hd * 64 + c]; }
    if (tid < 24) {
#pragma unroll
        for (int i = 0; i < 8; ++i) XR[(tid >> 3) * 64 + c8 + i] = 0.f; }
    float pba[2], pbx[2], pspl[2];
#pragma unroll
    for (int h2 = 0; h2 < 2; ++h2) { const int j = ((wave >> 2) * 2 + h2) * 16 + (lane & 15), c = l * 256 + hd * 64 + j; pba[h2] = P.in[I_LBA][c]; pbx[h2] = P.in[I_LBX][c]; pspl[h2] = log1pf(expf(-P.in[I_LLAM][c])); }
    float hstate = 0.f;
    const bf16* px = proj + ((size_t)b * T + tt) * DIN + C_LX + hd * 64 + c8; const bf16* pgp = proj + ((size_t)b * T + tt) * DIN + C_LG + hd * 64 + c8;
    u32x4 nx = ldg16(px), ngt = ldg16(pgp);
    PIN4(nx); PIN4(ngt);
    __syncthreads();
#pragma unroll 1
    for (int blk = 0; blk < T / 64; ++blk) {
        const int t0 = blk * 64;
        {   float x[8], g[8]; unpack8(nx, x); unpack8(ngt, g);
            { const int tn = (blk + 1 < T / 64) ? t0 + 64 : t0; nx = ldg16(px + (size_t)tn * DIN); ngt = ldg16(pgp + (size_t)tn * DIN); }
#pragma unroll
            for (int i = 0; i < 8; ++i) { XR[(tt + 3) * 64 + c8 + i] = x[i]; LG[tt * 64 + c8 + i] = g[i]; }
        }
        LDS_BARRIER();
        {   float xc[8];
#pragma unroll
            for (int i = 0; i < 8; ++i) { const int c = c8 + i; float a = CWL[256 + c];
#pragma unroll
                for (int jj = 0; jj < 4; ++jj) a += CWL[jj * 64 + c] * XR[(tt + jj) * 64 + c];
                XC[tt * 64 + c] = a; xc[i] = a; }
            u32x4 w; w.x = cvt2(xc[0], xc[1]); w.y = cvt2(xc[2], xc[3]); w.z = cvt2(xc[4], xc[5]); w.w = cvt2(xc[6], xc[7]); *(LAS u32x4*)(XCb + tt * 72 + c8) = w; }
        LDS_BARRIER();
        {   const int tt4 = wave & 3, r = lane & 15, q = lane >> 4;
#pragma unroll
            for (int h2 = 0; h2 < 2; ++h2) { const int nt = (wave >> 2) * 2 + h2, j = nt * 16 + r;
                const f32x4 ar = mma_tile(XCb + tt4 * 16 * 72, 72, WaT + nt * 16 * 72, 72, 64, lane), ag = mma_tile(XCb + tt4 * 16 * 72, 72, WxT + nt * 16 * 72, 72, 64, lane);
#pragma unroll
                for (int i = 0; i < 4; ++i) { const int t = tt4 * 16 + q * 4 + i; const float rr = sigmoidf_(ar[i] + pba[h2]), gi = sigmoidf_(ag[i] + pbx[h2]); const float la = -8.f * rr * pspl[h2];
                    const float e2 = __expf(2.f * la); RL[t * 64 + j] = __expf(la); GL[t * 64 + j] = sqrtf(1.f - e2) * gi * XC[t * 64 + j]; } }
            if (tid < 24) {
#pragma unroll
                for (int i = 0; i < 8; ++i) XR[(tid >> 3) * 64 + c8 + i] = XR[(64 + (tid >> 3)) * 64 + c8 + i]; }
        }
        LDS_BARRIER();
        if (tid < 64) {
#pragma unroll 8
            for (int t = 0; t < 64; ++t) { hstate = RL[t * 64 + tid] * hstate + GL[t * 64 + tid]; XC[t * 64 + tid] = hstate; } }
        LDS_BARRIER();
        {   u32x4 w; float o[8];
#pragma unroll
            for (int i = 0; i < 8; ++i) o[i] = gelu_tanh(LG[tt * 64 + c8 + i]) * XC[tt * 64 + c8 + i];
            w.x = cvt2(o[0], o[1]); w.y = cvt2(o[2], o[3]); w.z = cvt2(o[4], o[5]); w.w = cvt2(o[6], o[7]);
            *(u32x4*)(mix + ((size_t)b * T + t0 + tt) * D + 768 + hd * 64 + c8) = w; }
        LDS_BARRIER();
    }
}

__device__ __forceinline__ void s5_stage_u(const bf16* proj, int b, int g, int t0, LAS unsigned char* UL, int tid) {
#pragma unroll
    for (int rep = 0; rep < 4; ++rep) { const int tk = rep * 256 + (tid >> 1), half = tid & 1; const u32x4 v = ldg16(proj + ((size_t)b * T + t0 + tk) * DIN + C_SU + g * 16 + half * 8);
        const int cl = tk >> 4, s = tk & 15; *(LAS u32x4*)(UL + (cl >> 4) * 8192 + ((s * 16 + (cl & 15)) * 32 + half * 16)) = v; }
}
__device__ __forceinline__ void role_s5(const Params& P, int l, int b, int g, LAS unsigned char* lds, int tid, int lane, int wave) {
    LAS unsigned char* UL = lds; LAS unsigned char* XL = lds + 32768; LAS float* ES = (LAS float*)(lds + 49152);
    const bf16* proj = (const bf16*)(P.ws + WS_PROJ); bf16* yg = (bf16*)(P.ws + WS_YG);
    const unsigned char* sb = P.ws + WS_S5 + (size_t)l * S5_STRIDE;
    const bf16* F3 = (const bf16*)(sb + S5O_F3) + (size_t)g * 98304; const bf16* F1 = (const bf16*)(sb + S5O_F1) + (size_t)g * 32768; const float* A16 = (const float*)(sb + S5O_A16) + (size_t)g * 128;
    float* Hu = (float*)(P.ws + WS_HU) + (size_t)(b * 16 + g) * 512 * 128; float* Xs = (float*)(P.ws + WS_XS) + (size_t)(b * 16 + g) * 512 * 128;
    const int c16 = lane & 15, q = lane >> 4;
    {
        bf16x8 af[8];
#pragma unroll
        for (int ks = 0; ks < 8; ++ks) af[ks] = *(const bf16x8*)(F1 + ((size_t)(wave * 8 + ks) * 64 + lane) * 8);
#pragma unroll 1
        for (int it = 0; it < 8; ++it) {
            s5_stage_u(proj, b, g, it * 1024, UL, tid);
            __syncthreads();
#pragma unroll 1
            for (int ct = 0; ct < 4; ++ct) { f32x4 acc = {0.f, 0.f, 0.f, 0.f};
#pragma unroll
                for (int ks = 0; ks < 8; ++ks) { const bf16x8 bv = *(const LAS bf16x8*)(UL + ct * 8192 + (((2 * ks + (q >> 1)) * 16 + c16) * 32 + (q & 1) * 16)); acc = __builtin_amdgcn_mfma_f32_16x16x32_bf16(af[ks], bv, acc, 0, 0, 0); }
                *(f32x4*)(Hu + (size_t)(it * 64 + ct * 16 + c16) * 128 + 16 * wave + 4 * q) = acc; }
            __syncthreads();
        }
    }
    __threadfence(); __syncthreads();
    {
        const float ar = A16[lane * 2], ai = A16[lane * 2 + 1]; const float* hb = Hu + (size_t)(wave * 64) * 128; float xr = 0.f, xi = 0.f;
#pragma unroll 8
        for (int j = 0; j < 64; ++j) { const float hr = hb[j * 128 + lane], hi = hb[j * 128 + 64 + lane]; const float nr = ar * xr - ai * xi + hr, ni = ar * xi + ai * xr + hi; xr = nr; xi = ni; }
        ES[wave * 128 + lane] = xr; ES[wave * 128 + 64 + lane] = xi;
        __syncthreads();
        float pr = ar, pi = ai;
#pragma unroll
        for (int i = 0; i < 6; ++i) { const float nr = pr * pr - pi * pi, ni = 2.f * pr * pi; pr = nr; pi = ni; }
        float cr = 0.f, ci = 0.f;
        for (int w2 = 0; w2 < wave; ++w2) { const float er = ES[w2 * 128 + lane], ei = ES[w2 * 128 + 64 + lane]; const float nr = pr * cr - pi * ci + er, ni = pr * ci + pi * cr + ei; cr = nr; ci = ni; }
        xr = cr; xi = ci; float* xb = Xs + (size_t)(wave * 64) * 128;
#pragma unroll 8
        for (int j = 0; j < 64; ++j) { const float hr = hb[j * 128 + lane], hi = hb[j * 128 + 64 + lane]; xb[j * 128 + lane] = xr; xb[j * 128 + 64 + lane] = xi; const float nr = ar * xr - ai * xi + hr, ni = ar * xi + ai * xr + hi; xr = nr; xi = ni; }
    }
    __threadfence(); __syncthreads();
    {
        bf16x8 af[2][12];
#pragma unroll
        for (int r2 = 0; r2 < 2; ++r2)
#pragma unroll
            for (int ks = 0; ks < 12; ++ks) af[r2][ks] = *(const bf16x8*)(F3 + ((size_t)((2 * wave + r2) * 12 + ks) * 64 + lane) * 8);
        float dsk[4];
#pragma unroll
        for (int i = 0; i < 4; ++i) dsk[i] = P.in[I_S5D][l * 256 + g * 16 + 4 * q + i];
#pragma unroll 1
        for (int it = 0; it < 8; ++it) {
            s5_stage_u(proj, b, g, it * 1024, UL, tid);
#pragma unroll
            for (int rep = 0; rep < 4; ++rep) { const int cl = rep * 16 + (tid >> 5), n4 = (tid & 31) * 4; const f32x4 x = *(const f32x4*)(Xs + (size_t)(it * 64 + cl) * 128 + n4);
                u32x2 w; w.x = pk2(x.x, x.y); w.y = pk2(x.z, x.w);
                *(LAS u32x2*)(XL + (cl >> 4) * 4096 + ((((n4 >> 5) * 4 + ((n4 >> 3) & 3)) * 16 + (cl & 15)) * 16 + (n4 & 7) * 2)) = w; }
            __syncthreads();
#pragma unroll 1
            for (int ct = 0; ct < 4; ++ct) { f32x4 acc0 = {0.f, 0.f, 0.f, 0.f}, acc1 = {0.f, 0.f, 0.f, 0.f};
#pragma unroll
                for (int ks = 0; ks < 8; ++ks) { const bf16x8 bv = *(const LAS bf16x8*)(UL + ct * 8192 + (((2 * ks + (q >> 1)) * 16 + c16) * 32 + (q & 1) * 16));
                    acc0 = __builtin_amdgcn_mfma_f32_16x16x32_bf16(af[0][ks], bv, acc0, 0, 0, 0); acc1 = __builtin_amdgcn_mfma_f32_16x16x32_bf16(af[1][ks], bv, acc1, 0, 0, 0); }
#pragma unroll
                for (int ks = 0; ks < 4; ++ks) { const bf16x8 bv = *(const LAS bf16x8*)(XL + ct * 4096 + ((ks * 4 + q) * 16 + c16) * 16);
                    acc0 = __builtin_amdgcn_mfma_f32_16x16x32_bf16(af[0][8 + ks], bv, acc0, 0, 0, 0); acc1 = __builtin_amdgcn_mfma_f32_16x16x32_bf16(af[1][8 + ks], bv, acc1, 0, 0, 0); }
#pragma unroll
                for (int r2 = 0; r2 < 2; ++r2) { const int t = 2 * wave + r2; const f32x4 acc = r2 ? acc1 : acc0;
                    const u32x2 uw = *(const LAS u32x2*)(UL + ct * 8192 + ((t * 16 + c16) * 32 + (4 * q) * 2));
                    const float y0 = gelu_tanh(acc[0] + dsk[0] * bflo(uw.x)), y1 = gelu_tanh(acc[1] + dsk[1] * bfhi(uw.x)), y2 = gelu_tanh(acc[2] + dsk[2] * bflo(uw.y)), y3 = gelu_tanh(acc[3] + dsk[3] * bfhi(uw.y));
                    u32x2 o; o.x = pk2(y0, y1); o.y = pk2(y2, y3);
                    *(u32x2*)(yg + ((size_t)b * T + it * 1024 + (ct * 16 + c16) * 16 + t) * 256 + g * 16 + 4 * q) = o; } }
            __syncthreads();
        }
    }
}

__device__ __forceinline__ void rw_load8(const bf16* cur, const bf16* prev, const float* mu, float (&o)[8]) {
    float p[8], q[8]; unpack8(ldg16(cur), p);
    if (prev) unpack8(ldg16(prev), q); else {
#pragma unroll
        for (int i = 0; i < 8; ++i) q[i] = 0.f; }
    const f32x4 m0 = *(const f32x4*)mu, m1 = *(const f32x4*)(mu + 4);
#pragma unroll
    for (int i = 0; i < 4; ++i) { o[i] = p[i] + m0[i] * (q[i] - p[i]); o[4 + i] = p[4 + i] + m1[i] * (q[4 + i] - p[4 + i]); }
}
__device__ __forceinline__ void rw_mix8(const u32x4 c, const u32x4 pv, const LAS float* mu, float (&o)[8]) {
    float p[8], q[8]; unpack8(c, p); unpack8(pv, q);
    const f32x4 m0 = *(const LAS f32x4*)mu, m1 = *(const LAS f32x4*)(mu + 4);
#pragma unroll
    for (int i = 0; i < 4; ++i) { o[i] = p[i] + m0[i] * (q[i] - p[i]); o[4 + i] = p[4 + i] + m1[i] * (q[4 + i] - p[4 + i]); }
}
__device__ __forceinline__ void st8f(LAS float* d, const float (&o)[8]) { *(LAS f32x4*)d = (f32x4){o[0], o[1], o[2], o[3]}; *(LAS f32x4*)(d + 4) = (f32x4){o[4], o[5], o[6], o[7]}; }
__device__ __forceinline__ void st8b(LAS bf16* d, const float (&o)[8]) { u32x4 w; w.x = cvt2(o[0], o[1]); w.y = cvt2(o[2], o[3]); w.z = cvt2(o[4], o[5]); w.w = cvt2(o[6], o[7]); *(LAS u32x4*)d = w; }
constexpr int RW_SLAB = 64, RW_NSLAB = 8, RW_RING = 3, RW_RUN = 8;
constexpr size_t RWB_STRIDE = 18944;
constexpr int RWB_WQ = 0, RWB_BB = 4096, RWB_KB = 6144, RWB_VM = 8192, RWB_GC = 10240, RWB_W2 = 10496, RWB_YL = 12544, RWB_G = 14592, RWB_BON = 16640;
constexpr int CW_TMO = 64, CW_RWP = 16384, CW_RWC = 32768;
static_assert((size_t)32 * RW_RING * RW_SLAB * RWB_STRIDE <= (size_t)128 * MiB, "bundle ring fits the ACT buffer");
__device__ __forceinline__ unsigned char* rw_bundle(const Params& P, int seq, int chunk) { return P.ws + WS_ACT + (size_t)((seq * RW_RING + ((chunk >> 6) % RW_RING)) * RW_SLAB + (chunk & 63)) * RWB_STRIDE; }
#define RLX_AGENT __ATOMIC_RELAXED, __HIP_MEMORY_SCOPE_AGENT
__device__ __forceinline__ void st_wt8(void* p, u32x2 v) { __hip_atomic_store((unsigned long long*)p, (unsigned long long)v.x | ((unsigned long long)v.y << 32), RLX_AGENT); }
__device__ __forceinline__ void wait_ge(unsigned* word, unsigned want, unsigned* tmo) {
    unsigned spins = 0;
    while ((unsigned)__builtin_amdgcn_readfirstlane(__hip_atomic_load(word, RLX_AGENT)) < want) {
        __builtin_amdgcn_s_sleep(2);
        if (++spins > (1u << 20)) { __hip_atomic_store(tmo, 1u, RLX_AGENT); break; }
        if ((spins & 1023u) == 0u && __builtin_amdgcn_readfirstlane(__hip_atomic_load(tmo, RLX_AGENT))) break;
    }
}
__device__ __forceinline__ void rwkv_producer(const Params& P, int l, int hd, int gp, int NPG, LAS unsigned char* lds, int tid, int lane, int wave) {
    unsigned* ctl = (unsigned*)(P.ws + WS_CTL);
    LAS bf16* W2T = (LAS bf16*)lds;
    LAS bf16* A2T = W2T + 64 * 72;
    LAS bf16* G2T = A2T + 64 * 72;
    LAS bf16* V1T = G2T + 64 * 136;
    LAS bf16* V2T = V1T + 32 * 264;
    LAS bf16* TWD = V2T + 64 * 40;
    LAS bf16* ADb = TWD + 16 * 72;
    LAS bf16* SGD = ADb + 16 * 72;
    LAS bf16* VALb = SGD + 16 * 136;
    LAS bf16* VHb = VALb + 16 * 264;
    LAS float* R = (LAS float*)(VHb + 16 * 40); LAS float* K = R + 1024; LAS float* V = K + 1024; LAS float* WL = V + 1024; LAS float* KK = WL + 1024; LAS float* Bb = KK + 1024;
    LAS float* G = Bb + 1024; LAS float* Y = G + 1024; LAS float* RK = Y + 1024  ; LAS float* AL = RK + 16; LAS float* VG = AL + 1024;
    LAS bf16* KKh = TWD; LAS bf16* Rh = KKh + 16 * 72; LAS bf16* Bt = Rh + 16 * 72; LAS bf16* Kt = Bt + 16 * 72; LAS bf16* BbarT = Kt + 16 * 72; LAS bf16* KbarT = BbarT + 64 * 24;
    LAS bf16* VmT = (LAS bf16*)AL; LAS bf16* KKhT = VmT + 64 * 24; LAS bf16* RhT = KKhT + 64 * 24; LAS float* GamC = (LAS float*)(RhT + 64 * 24); LAS bf16* WQ = (LAS bf16*)(GamC + 64); LAS float* MU = (LAS float*)(WQ + 32 * 72); LAS float* PT = MU + 1024;
    const bf16* proj = (const bf16*)(P.ws + WS_PROJ); bf16* mix = (bf16*)(P.ws + WS_MIX); bf16* vf = (bf16*)(P.ws + WS_VF);
    const float* mu_base = P.in[I_RMU] + (size_t)l * 1024;
    lds_load_wT(P.in[I_RW2] + (size_t)l * 64 * 256, 256, hd * 64, 64, 64, W2T, 72, tid);
    lds_load_wT(P.in[I_RA2] + (size_t)l * 64 * 256, 256, hd * 64, 64, 64, A2T, 72, tid);
    lds_load_wT(P.in[I_RG2] + (size_t)l * 128 * 256, 256, hd * 64, 64, 128, G2T, 136, tid);
    if (l > 0) { lds_load_wT(P.in[I_RV1], 32, 0, 32, 256, V1T, 264, tid); lds_load_wT(P.in[I_RV2], 256, hd * 64, 64, 32, V2T, 40, tid); }
    const int tt0 = tid >> 5, l320 = tid & 31;
    for (int i = tid; i < 1024; i += NTHR) MU[i] = mu_base[i];
    if (tid < 64) { const int c = l * 256 + hd * 64 + tid; PT[tid] = P.in[I_RW0][c]; PT[64 + tid] = P.in[I_RA0][c]; PT[128 + tid] = P.in[I_RKK][c]; PT[192 + tid] = P.in[I_RKA][c]; PT[256 + tid] = P.in[I_RRK][c];
        PT[320 + tid] = (l > 0) ? P.in[I_RV0][hd * 64 + tid] : 0.f; PT[384 + tid] = P.in[I_RLNW][c]; PT[448 + tid] = P.in[I_RLNB][c]; }
    const int segA = l320 >> 3, chA = l320 & 7, colA = (segA == 0 ? hd * 64 : segA == 1 ? 256 + hd * 64 : segA == 2 ? 768 : 832) + chA * 8, colB = 896 + (l320 & 15) * 8;
    const bool hasB = l320 < 16, hasC = (l > 0) || (l320 >= 16 && l320 < 24); const int colC = (l > 0) ? 512 + l320 * 8 : 512 + hd * 64 + (l320 & 7) * 8;
    const u32x4 zero4 = {0u, 0u, 0u, 0u};
    __syncthreads();
    const int nun = (NPG == 40) ? (gp < 32 ? 12 : gp < 40 ? 13 : 3) : 0;
#pragma unroll 1
    for (int k = 0; ; ++k) { int u;
        if (NPG == 40) { if (k >= nun) break; u = (gp >= 40) ? 488 + 8 * k + (gp - 40) : (k < 12 ? gp + 40 * k : 480 + (gp - 32)); }
        else { u = gp + k * NPG; if (u >= 512) break; }
    const int slab = u >> 6, b = (u >> 3) & 7, run = u & 7, seq = b * 4 + hd, cfirst = slab * RW_SLAB + run * RW_RUN;
    if (slab >= RW_RING) { if (wave == 0) wait_ge(ctl + CW_RWC + l * 1024 + seq * 16, (unsigned)(slab - RW_RING + 1), ctl + CW_TMO); __syncthreads(); }
    const bf16* rowp = proj + ((size_t)b * T + tt0) * DIN + C_RW; const bf16* vfp = vf + ((size_t)b * T + tt0) * 256 + hd * 64 + l320 * 2;
    u32x4 nAc, nAp, nBc = zero4, nBp = zero4, nCc = zero4, nCp = zero4; unsigned nvf = 0u;
    {   const bf16* rn = rowp + (size_t)(cfirst * 16) * DIN; const bool hp = (cfirst * 16 + tt0) > 0;
        nAc = ldg16(rn + colA); nAp = hp ? ldg16(rn - DIN + colA) : zero4;
        if (hasB) { nBc = ldg16(rn + colB); nBp = hp ? ldg16(rn - DIN + colB) : zero4; }
        if (hasC) { nCc = ldg16(rn + colC); nCp = hp ? ldg16(rn - DIN + colC) : zero4; }
        if (l > 0) nvf = *(const unsigned*)(vfp + (size_t)(cfirst * 16) * 256); }
#pragma unroll 1
    for (int blk = cfirst; blk < cfirst + RW_RUN; ++blk) {
        const int t0 = blk * 16; int tidl = tid; asm volatile("" : "+v"(tidl));
        const int tt = tidl >> 5, l32 = tidl & 31, lane = tidl & 63;
        const u32x4 rAc = nAc, rAp = nAp, rBc = nBc, rBp = nBp, rCc = nCc, rCp = nCp; const unsigned rvf = nvf;
        if (blk + 1 < cfirst + RW_RUN) { const bf16* rn = rowp + (size_t)(t0 + 16) * DIN;
            nAc = ldg16(rn + colA); nAp = ldg16(rn - DIN + colA);
            if (hasB) { nBc = ldg16(rn + colB); nBp = ldg16(rn - DIN + colB); }
            if (hasC) { nCc = ldg16(rn + colC); nCp = ldg16(rn - DIN + colC); }
            if (l > 0) nvf = *(const unsigned*)(vfp + (size_t)(t0 + 16) * 256); }
        unsigned char* bp = rw_bundle(P, seq, blk);
        {   float o[8];
            rw_mix8(rAc, rAp, MU + colA, o);
            if (segA == 0) st8f(R + tt * 64 + chA * 8, o); else if (segA == 1) st8f(K + tt * 64 + chA * 8, o);
            else if (segA == 2) {
#pragma unroll
                for (int i = 0; i < 8; ++i) { const float e = __expf(2.f * o[i]); o[i] = 1.f - 2.f * frcp(e + 1.f); }
                st8b(TWD + tt * 72 + chA * 8, o); }
            else st8b(ADb + tt * 72 + chA * 8, o);
            if (hasB) { rw_mix8(rBc, rBp, MU + colB, o);
#pragma unroll
                for (int i = 0; i < 8; ++i) o[i] = sigmoidf_(o[i]);
                st8b(SGD + tt * 136 + (l32 & 15) * 8, o); }
            if (hasC) { rw_mix8(rCc, rCp, MU + colC, o);
                if (l == 0) st8f(V + tt * 64 + (l32 & 7) * 8, o);
                else { st8b(VALb + tt * 264 + l32 * 8, o); if ((l32 >> 3) == hd) st8f(V + tt * 64 + (l32 & 7) * 8, o); } }
        }
        LDS_BARRIER();
        {   const int r = lane & 15, q = lane >> 4;
            if (wave < 4) { const f32x4 cw_ = mma_tile(TWD, 72, W2T + wave * 16 * 72, 72, 64, lane), ca = mma_tile(ADb, 72, A2T + wave * 16 * 72, 72, 64, lane);
#pragma unroll
                for (int i = 0; i < 4; ++i) { WL[(q * 4 + i) * 64 + wave * 16 + r] = cw_[i]; AL[(q * 4 + i) * 64 + wave * 16 + r] = ca[i]; }
                if (l > 0 && wave < 2) { const f32x4 ch_ = mma_tile(VALb, 264, V1T + wave * 16 * 264, 264, 256, lane);
#pragma unroll
                    for (int i = 0; i < 4; ++i) VHb[(q * 4 + i) * 40 + wave * 16 + r] = (bf16)f2bf(ch_[i]); } }
            else { const int nt = wave - 4; const f32x4 cg = mma_tile(SGD, 136, G2T + nt * 16 * 136, 136, 128, lane);
#pragma unroll
                for (int i = 0; i < 4; ++i) G[(q * 4 + i) * 64 + nt * 16 + r] = cg[i]; }
        }
        LDS_BARRIER();
        if (l > 0) {
            if (wave < 4) { const int r = lane & 15, q = lane >> 4; const f32x4 cv = mma_tile(VHb, 40, V2T + wave * 16 * 40, 40, 32, lane);
#pragma unroll
                for (int i = 0; i < 4; ++i) VG[(q * 4 + i) * 64 + wave * 16 + r] = cv[i]; }
            LDS_BARRIER();
        }
        {   const int j2 = l32 * 2; float ssq = 0.f, rk = 0.f; float kkv[2], av[2], vv2[2];
            const size_t tok = (size_t)b * T + t0 + tt;
#pragma unroll
            for (int i = 0; i < 2; ++i) { const int j = j2 + i, x = tt * 64 + j;
                const float wl = -softplusf_(-(PT[j] + WL[x])) - 0.5f; WL[x] = -__expf(wl);
                const float a = sigmoidf_(PT[64 + j] + AL[x]); av[i] = a;
                const float kr = K[x]; kkv[i] = kr * PT[128 + j]; ssq += kkv[i] * kkv[i];
                const float km = kr * (1.f + (a - 1.f) * PT[192 + j]); K[x] = km;
                float v = V[x];
                if (l > 0) { const float vfv = i ? bfhi(rvf) : bflo(rvf); v = v + (vfv - v) * sigmoidf_(PT[320 + j] + VG[x]); V[x] = v; }
                vv2[i] = v;
                rk += R[x] * km * PT[256 + j]; }
            if (l == 0) *(unsigned*)(vf + tok * 256 + hd * 64 + j2) = cvt2(vv2[0], vv2[1]);
            ssq = half_sum(ssq, lane); rk = half_sum(rk, lane);
            const float inv = frcp(fmaxf(sqrtf(ssq), 1e-12f));
#pragma unroll
            for (int i = 0; i < 2; ++i) { const int x = tt * 64 + j2 + i; const float kn = kkv[i] * inv; KK[x] = kn; Bb[x] = kn * av[i]; }
            if (l32 == 0) RK[tt] = rk;
        }
        LDS_BARRIER();
        {   const int j2 = l32 * 2; float ce0 = 0.f, ce1 = 0.f, ct0 = 0.f, ct1 = 0.f;
#pragma unroll
            for (int s2 = 0; s2 < 16; ++s2) { const f32x2 w2 = *(const LAS f32x2*)(WL + s2 * 64 + j2); if (s2 < tt) { ce0 += w2.x; ce1 += w2.y; } ct0 += w2.x; ct1 += w2.y; }
            const f32x2 wme = *(const LAS f32x2*)(WL + tt * 64 + j2); const float ci0 = ce0 + wme.x, ci1 = ce1 + wme.y;
            const float ex0 = __expf(ce0), ex1 = __expf(ce1), in0 = __expf(ci0), in1 = __expf(ci1), ng0 = __expf(-ci0), ng1 = __expf(-ci1), br0 = __expf(ct0 - ci0), br1 = __expf(ct1 - ci1);
            const int x = tt * 64 + j2; const f32x2 kk2 = *(const LAS f32x2*)(KK + x), r2 = *(const LAS f32x2*)(R + x), b2 = *(const LAS f32x2*)(Bb + x), k2 = *(const LAS f32x2*)(K + x), v2_ = *(const LAS f32x2*)(V + x);
            const unsigned kkh = cvt2(kk2.x * ex0, kk2.y * ex1), rh = cvt2(r2.x * in0, r2.y * in1);
            *(LAS unsigned*)(KKh + tt * 72 + j2) = kkh; *(LAS unsigned*)(Rh + tt * 72 + j2) = rh;
            *(LAS unsigned*)(Bt + tt * 72 + j2) = cvt2(b2.x * ng0, b2.y * ng1); *(LAS unsigned*)(Kt + tt * 72 + j2) = cvt2(k2.x * ng0, k2.y * ng1);
            KKhT[j2 * 24 + tt] = (bf16)(kkh & 0xffffu); KKhT[(j2 + 1) * 24 + tt] = (bf16)(kkh >> 16); RhT[j2 * 24 + tt] = (bf16)(rh & 0xffffu); RhT[(j2 + 1) * 24 + tt] = (bf16)(rh >> 16);
            { const unsigned bb = cvt2(b2.x * br0, b2.y * br1), kb = cvt2(k2.x * br0, k2.y * br1); BbarT[j2 * 24 + tt] = (bf16)(bb & 0xffffu); BbarT[(j2 + 1) * 24 + tt] = (bf16)(bb >> 16); KbarT[j2 * 24 + tt] = (bf16)(kb & 0xffffu); KbarT[(j2 + 1) * 24 + tt] = (bf16)(kb >> 16); }
            { const unsigned vv = cvt2(v2_.x, v2_.y); VmT[j2 * 24 + tt] = (bf16)(vv & 0xffffu); VmT[(j2 + 1) * 24 + tt] = (bf16)(vv >> 16); }
            if (tt == 0) { GamC[j2] = __expf(ct0); GamC[j2 + 1] = __expf(ct1); }
        }
        LDS_BARRIER();
        u32x2 vmB = {0u, 0u};
        {   const int r = lane & 15, q = lane >> 4; const f32x4 z4 = {0.f, 0.f, 0.f, 0.f};
            f32x4 NT = z4, Nn = z4, ArbT = z4;
#pragma unroll
            for (int ks = 0; ks < 2; ++ks) { const bf16x8 fb = *(const LAS bf16x8*)(Bt + r * 72 + ks * 32 + q * 8), fk = *(const LAS bf16x8*)(KKh + r * 72 + ks * 32 + q * 8), fr = *(const LAS bf16x8*)(Rh + r * 72 + ks * 32 + q * 8);
                NT = MF(fb, fk, NT); Nn = MF(fk, fb, Nn); ArbT = MF(fb, fr, ArbT); }
#pragma unroll
            for (int i = 0; i < 4; ++i) { const int rr = 4 * q + i; NT[i] = (rr < r) ? NT[i] : 0.f; Nn[i] = (r < rr) ? Nn[i] : 0.f; ArbT[i] = (rr <= r) ? ArbT[i] : 0.f; }
            const f32x4 N2 = MF(pack_lo(NT), pack_lo(Nn), z4), N2T = MF(pack_lo(Nn), pack_lo(NT), z4);
            const f32x4 N4 = MF(pack_lo(N2T), pack_lo(N2), z4), N4T = MF(pack_lo(N2), pack_lo(N2T), z4);
            const f32x4 N8T = MF(pack_lo(N4), pack_lo(N4T), z4);
            const bf16x8 aN8 = pack_lo(N8T), aN4 = pack_lo(N4T), aN2 = pack_lo(N2T), aN1 = pack_lo(-NT);
            if (wave < 4) {
                const int kt = wave; const u32x2 zb = *(const LAS u32x2*)(KKhT + (16 * kt + r) * 24 + 4 * q);
                f32x4 z = {bflo(zb.x), bfhi(zb.x), bflo(zb.y), bfhi(zb.y)};
                z = MF(aN8, pack_lo(z), z); z = MF(aN4, pack_lo(z), z); z = MF(aN2, pack_lo(z), z); z = MF(aN1, pack_lo(z), z);
                const u32x2 rb = *(const LAS u32x2*)(RhT + (16 * kt + r) * 24 + 4 * q); const f32x4 rc = {bflo(rb.x), bfhi(rb.x), bflo(rb.y), bfhi(rb.y)};
                const f32x4 qe = MF(pack_lo(-ArbT), pack_lo(z), rc);
#pragma unroll
                for (int i = 0; i < 4; ++i) { WQ[(4 * q + i) * 72 + 16 * kt + r] = (bf16)f2bf(z[i]); WQ[(16 + 4 * q + i) * 72 + 16 * kt + r] = (bf16)f2bf(qe[i]); }
            } else {
                const int vt = wave - 4; f32x4 AakT = z4, ArkT = z4;
#pragma unroll
                for (int ks = 0; ks < 2; ++ks) { const bf16x8 fkt = *(const LAS bf16x8*)(Kt + r * 72 + ks * 32 + q * 8), fk = *(const LAS bf16x8*)(KKh + r * 72 + ks * 32 + q * 8), fr = *(const LAS bf16x8*)(Rh + r * 72 + ks * 32 + q * 8);
                    AakT = MF(fkt, fk, AakT); ArkT = MF(fkt, fr, ArkT); }
#pragma unroll
                for (int i = 0; i < 4; ++i) { const int rr = 4 * q + i; AakT[i] = (rr < r) ? AakT[i] : 0.f; ArkT[i] = (rr <= r) ? ArkT[i] : 0.f; }
                vmB = *(const LAS u32x2*)(VmT + (16 * vt + r) * 24 + 4 * q);
                f32x4 z = MF(pack_lo(AakT), cat8(vmB, (u32x2){0u, 0u}), z4);
                z = MF(aN8, pack_lo(z), z); z = MF(aN4, pack_lo(z), z); z = MF(aN2, pack_lo(z), z); z = MF(aN1, pack_lo(z), z);
                const f32x4 yl_ = MF(pack2(ArkT, -ArbT), cat8(vmB, pack4(z)), z4);
                st_wt8(bp + RWB_W2 + (vt * 64 + lane) * 8, pack4(z)); st_wt8(bp + RWB_YL + (vt * 64 + lane) * 8, pack4(yl_));
            }
        }
        LDS_BARRIER();
        {
            { const int row = tidl >> 4, pc = tidl & 15, rr = row & 15, half = row >> 4, ks = pc >> 3, hi = (pc >> 2) & 1, qq = pc & 3;
              st_wt8(bp + RWB_WQ + (((2 * ks + half) * 64 + qq * 16 + rr) * 2 + hi) * 8, *(const LAS u32x2*)(WQ + row * 72 + pc * 4)); }
            for (int idx = tidl; idx < 768; idx += NTHR) { const int arr = idx >> 8, pi = idx & 255, row = pi >> 2, pc = pi & 3; const LAS bf16* src = (arr == 0 ? BbarT : arr == 1 ? KbarT : VmT) + row * 24 + pc * 4;
                const int ln = pc * 16 + (row & 15), t4 = row >> 4;
                st_wt8(bp + (arr < 2 ? RWB_BB + ((t4 * 64 + ln) * 2 + arr) * 8 : RWB_VM + (t4 * 64 + ln) * 8), *(const LAS u32x2*)src); }
            if (tidl < 32) st_wt8(bp + RWB_GC + tidl * 8, *(const LAS u32x2*)(GamC + tidl * 2));
            if (tidl < 256) { const int t = tidl >> 4, v4 = (tidl & 15) * 4; const f32x4 g4 = *(const LAS f32x4*)(G + t * 64 + v4); const f32x4 v4f = *(const LAS f32x4*)(V + t * 64 + v4); const float rkt = RK[t];
                st_wt8(bp + RWB_G + (t * 64 + v4) * 2, pack4(g4)); st_wt8(bp + RWB_BON + (t * 64 + v4) * 2, pack4(v4f * rkt)); }
        }
        LDS_BARRIER();
    }
    asm volatile("s_waitcnt vmcnt(0)" ::: "memory");
    __syncthreads();
    if (tid == 0) __hip_atomic_fetch_add(ctl + CW_RWP + l * 4096 + (seq * 8 + slab) * 16, 1u, RLX_AGENT);
    }
}
struct RwOps { u32x4 w[4]; u32x4 bk[4]; u32x2 vm, w2, yl; f32x4 gc[4]; };
__device__ __forceinline__ void rw_ops_load(RwOps& o, const unsigned char* bp, int vt, int r, int q, int lane) {
#pragma unroll
    for (int f = 0; f < 4; ++f) { o.w[f] = *(const u32x4*)(bp + RWB_WQ + (f * 64 + lane) * 16); o.bk[f] = *(const u32x4*)(bp + RWB_BB + (f * 64 + lane) * 16); o.gc[f] = *(const f32x4*)(bp + RWB_GC + (16 * f + 4 * q) * 4); }
    o.vm = *(const u32x2*)(bp + RWB_VM + (vt * 64 + lane) * 8); o.w2 = *(const u32x2*)(bp + RWB_W2 + (vt * 64 + lane) * 8); o.yl = *(const u32x2*)(bp + RWB_YL + (vt * 64 + lane) * 8);
}
__device__ __forceinline__ void rw_ops_load_lds(RwOps& o, const LAS unsigned char* sp, int vt, int q, int lane) {
#pragma unroll
    for (int f = 0; f < 4; ++f) { o.w[f] = *(const LAS u32x4*)(sp + RWB_WQ + (f * 64 + lane) * 16); o.bk[f] = *(const LAS u32x4*)(sp + RWB_BB + (f * 64 + lane) * 16); o.gc[f] = *(const LAS f32x4*)(sp + RWB_GC + (16 * f + 4 * q) * 4); }
    o.vm = *(const LAS u32x2*)(sp + RWB_VM + (vt * 64 + lane) * 8); o.w2 = *(const LAS u32x2*)(sp + RWB_W2 + (vt * 64 + lane) * 8); o.yl = *(const LAS u32x2*)(sp + RWB_YL + (vt * 64 + lane) * 8);
}
constexpr int RWL_N = 6, RWL_D = 5, RWL_SLOT = 20480;
static_assert(8192 + RWL_N * RWL_SLOT <= 131072, "consumer LDS ring");
__device__ __forceinline__ void rwkv_consumer(const Params& P, int l, int b, int hd, LAS unsigned char* lds, int tid, int lane, int wave) {
    LAS float* Yb = (LAS float*)lds;
    LAS unsigned char* ring = lds + 8192;
    unsigned* ctl = (unsigned*)(P.ws + WS_CTL); const int seq = b * 4 + hd;
    unsigned* prod = ctl + CW_RWP + l * 4096 + seq * 8 * 16; unsigned* cons = ctl + CW_RWC + l * 1024 + seq * 16; unsigned* tmo = ctl + CW_TMO;
    bf16* mix = (bf16*)(P.ws + WS_MIX);
    const int r = lane & 15, q = lane >> 4, vt = wave & 3;
    f32x4 st[4];
#pragma unroll
    for (int i = 0; i < 4; ++i) st[i] = (f32x4){0.f, 0.f, 0.f, 0.f};
    const int ot = (tid >> 4) & 15, ov4 = (tid & 15) * 4;
    f32x4 lnw = *(const f32x4*)(P.in[I_RLNW] + l * 256 + hd * 64 + ov4), lnb = *(const f32x4*)(P.in[I_RLNB] + l * 256 + hd * 64 + ov4);
    if (wave == 0) { wait_ge(prod, (unsigned)RW_RUN, tmo); __builtin_amdgcn_fence(__ATOMIC_ACQUIRE, "agent"); asm volatile("s_waitcnt vmcnt(0)" ::: "memory"); }
    __syncthreads();
#define RW_DMA(X, SL) do { const unsigned char* bp_ = rw_bundle(P, seq, (X)); LAS unsigned char* sl_ = ring + (SL) * RWL_SLOT; \
        _Pragma("unroll") for (int rd = 0; rd < 5; ++rd) __builtin_amdgcn_global_load_lds((const unsigned*)(bp_ + (size_t)(rd * 256 + wave * 64 + lane) * 16), (LAS unsigned*)(sl_ + (rd * 256 + wave * 64) * 16), 16, 0, 0); } while (0)
    if (wave < 4) {
#pragma unroll
        for (int x = 0; x < RWL_D; ++x) RW_DMA(x, x); }
    asm volatile("s_waitcnt vmcnt(0)" ::: "memory");
    __syncthreads();
    if (wave < 4) { PIN4(lnw); PIN4(lnb); }
    u32x2* const dummy = (u32x2*)(P.ws + WS_LG) + tid;
#define RW_OUT(cp, GG, BN, DST) do { \
        const f32x4 y = *(const LAS f32x4*)(Yb + ((cp) & 1) * 1024 + ot * 64 + ov4); \
        const float mean = row16_sum((y[0] + y[1]) + (y[2] + y[3])) * (1.f / 64.f); const f32x4 d = y - mean; \
        const float var = row16_sum((d[0] * d[0] + d[1] * d[1]) + (d[2] * d[2] + d[3] * d[3])) * (1.f / 64.f); const float rs = __builtin_amdgcn_rsqf(var + 64e-5f); \
        const f32x4 o = (d * rs * lnw + lnb + (BN)) * (GG); \
        *(DST) = pack4(o); } while (0)
#define RW_SLABCHK(c) do { if ((((c) + RWL_D) & 63) == 0 && (c) + RWL_D < T / 16) { \
            if (wave == 0) { wait_ge(prod + (((c) + RWL_D) >> 6) * 16, (unsigned)RW_RUN, tmo); __builtin_amdgcn_fence(__ATOMIC_ACQUIRE, "agent"); asm volatile("s_waitcnt vmcnt(0)" ::: "memory"); } \
            __syncthreads(); } } while (0)
#define RW_REC(c) do { RW_SLABCHK(c); RwOps OP; rw_ops_load_lds(OP, ring + ((c) % RWL_N) * RWL_SLOT, vt, q, lane); \
            f32x4 d1 = {0.f, 0.f, 0.f, 0.f}, d2 = {0.f, 0.f, 0.f, 0.f}; \
            _Pragma("unroll") for (int ks = 0; ks < 2; ++ks) { const bf16x8 bS = pack2(st[2 * ks], st[2 * ks + 1]); d1 = MF(__builtin_bit_cast(bf16x8, OP.w[2 * ks]), bS, d1); d2 = MF(__builtin_bit_cast(bf16x8, OP.w[2 * ks + 1]), bS, d2); } \
            const f32x4 w2f = {bflo(OP.w2.x), bfhi(OP.w2.x), bflo(OP.w2.y), bfhi(OP.w2.y)}, ylf = {bflo(OP.yl.x), bfhi(OP.yl.x), bflo(OP.yl.y), bfhi(OP.yl.y)}; \
            const f32x4 un = -(d1 + w2f), yv = d2 + ylf; \
            LAS float* Y = Yb + ((c) & 1) * 1024; \
            _Pragma("unroll") for (int i = 0; i < 4; ++i) Y[(4 * q + i) * 64 + 16 * vt + r] = yv[i]; \
            const bf16x8 bUV = cat8(pack4(un), OP.vm); \
            _Pragma("unroll") for (int kt = 0; kt < 4; ++kt) st[kt] = MF(__builtin_bit_cast(bf16x8, OP.bk[kt]), bUV, st[kt] * OP.gc[kt]); \
            LDS_BARRIER(); } while (0)
#define RW_OSTEP(c) do { RW_SLABCHK(c); \
            const LAS unsigned char* sp_ = ring + (((c) > 0 ? (c) - 1 : 0) % RWL_N) * RWL_SLOT;        \
            const u32x2 gp_ = *(const LAS u32x2*)(sp_ + RWB_G + (ot * 64 + ov4) * 2), bp2_ = *(const LAS u32x2*)(sp_ + RWB_BON + (ot * 64 + ov4) * 2); \
            const f32x4 gg = {bflo(gp_.x), bfhi(gp_.x), bflo(gp_.y), bfhi(gp_.y)}, bn = {bflo(bp2_.x), bfhi(bp2_.x), bflo(bp2_.y), bfhi(bp2_.y)}; \
            u32x2* dst_ = ((c) > 0) ? (u32x2*)(mix + ((size_t)b * T + ((c) - 1) * 16 + ot) * D + 512 + hd * 64 + ov4) : dummy; \
            RW_OUT((c) - 1, gg, bn, dst_); \
            asm volatile("s_waitcnt lgkmcnt(0)" ::: "memory");        \
              \
            { const int cd_ = (c) + RWL_D < T / 16 ? (c) + RWL_D : T / 16 - 1; RW_DMA(cd_, ((c) + RWL_D) % RWL_N); asm volatile("s_waitcnt vmcnt(24)" ::: "memory"); } \
            LDS_BARRIER(); \
            if (((c) & 63) == 2 && (c) > 2 && tid == 0) { const unsigned cv_ = (unsigned)((c) >> 6);        \
                asm volatile("global_store_dword %0, %1, off sc1" :: "v"(cons), "v"(cv_) : "memory"); } } while (0)
    if (wave >= 4) {
#pragma unroll 1
        for (int c2 = 0; c2 < T / 16; c2 += 2) { RW_REC(c2); RW_REC(c2 + 1); }
    } else {
#pragma unroll 1
        for (int c2 = 0; c2 < T / 16; c2 += 2) { RW_OSTEP(c2); RW_OSTEP(c2 + 1); }
        const LAS unsigned char* sp_ = ring + ((T / 16 - 1) % RWL_N) * RWL_SLOT; const u32x2 gp_ = *(const LAS u32x2*)(sp_ + RWB_G + (ot * 64 + ov4) * 2), bp2_ = *(const LAS u32x2*)(sp_ + RWB_BON + (ot * 64 + ov4) * 2);
        const f32x4 gg = {bflo(gp_.x), bfhi(gp_.x), bflo(gp_.y), bfhi(gp_.y)}, bn = {bflo(bp2_.x), bfhi(bp2_.x), bflo(bp2_.y), bfhi(bp2_.y)};
        RW_OUT(T / 16 - 1, gg, bn, (u32x2*)(mix + ((size_t)b * T + (T / 16 - 1) * 16 + ot) * D + 512 + hd * 64 + ov4));
    }
#undef RW_SLABCHK
#undef RW_REC
#undef RW_OSTEP
#undef RW_OUT
#undef RW_DMA
    asm volatile("s_waitcnt vmcnt(0)" ::: "memory");
    __syncthreads();
}

__device__ __forceinline__ int lds_add(LAS int* p, int v) { return __hip_atomic_fetch_add(p, v, __ATOMIC_RELAXED, __HIP_MEMORY_SCOPE_WORKGROUP); }
__device__ __forceinline__ void ph_fin(const Params& P, int l, int lane, int wave, int mfirst, int mstep, int mend) {
    const bf16* mix = (const bf16*)(P.ws + WS_MIX); bf16* act = (bf16*)(P.ws + WS_ACT); const float* gain = P.in[I_MGAIN] + (size_t)l * D;
    const int gw = blockIdx.x * NWAVES + wave, NGW = gridDim.x * NWAVES;
    const f32x4* gp = (const f32x4*)(gain + lane * 16); const f32x4 g0 = gp[0], g1 = gp[1], g2 = gp[2], g3 = gp[3];
#pragma unroll 1
    for (int m0 = mfirst; m0 < mend; m0 += mstep) {
        u32x4 ra[4], rb[4];
#pragma unroll
        for (int k = 0; k < 4; ++k) { ra[k] = ldg16(mix + (size_t)(m0 + k) * D + lane * 16); rb[k] = ldg16(mix + (size_t)(m0 + k) * D + lane * 16 + 8); }
#pragma unroll
        for (int k = 0; k < 4; ++k) { float v[16]; { float a[8], b2[8]; unpack8(ra[k], a); unpack8(rb[k], b2);
#pragma unroll
                for (int i = 0; i < 8; ++i) { v[i] = a[i]; v[8 + i] = b2[i]; } }
            float s2 = 0.f;
#pragma unroll
            for (int i = 0; i < 16; ++i) s2 += v[i] * v[i];
            s2 = row16_sum(s2);
            const float rstd = 1.f / sqrtf(s2 * (1.f / 256.f) + 1e-6f); u32x4 w0, w1;
            w0.x = cvt2(v[0] * rstd * g0.x, v[1] * rstd * g0.y); w0.y = cvt2(v[2] * rstd * g0.z, v[3] * rstd * g0.w); w0.z = cvt2(v[4] * rstd * g1.x, v[5] * rstd * g1.y); w0.w = cvt2(v[6] * rstd * g1.z, v[7] * rstd * g1.w);
            w1.x = cvt2(v[8] * rstd * g2.x, v[9] * rstd * g2.y); w1.y = cvt2(v[10] * rstd * g2.z, v[11] * rstd * g2.w); w1.z = cvt2(v[12] * rstd * g3.x, v[13] * rstd * g3.y); w1.w = cvt2(v[14] * rstd * g3.z, v[15] * rstd * g3.w);
            *(u32x4*)(act + (size_t)(m0 + k) * D + lane * 16) = w0; *(u32x4*)(act + (size_t)(m0 + k) * D + lane * 16 + 8) = w1; }
    }
}
__device__ __forceinline__ void ph_route(const Params& P, int l, LAS unsigned char* lds, int tid, int lane, int wave) {
    LAS int* hist = (LAS int*)(lds + LDS_MISC + 256);
    unsigned char* wl = P.ws + WS_W + (size_t)l * WL_STRIDE;
    pg8::StaticOrder S; S.init(NTOK / 256, 1, gridDim.x, blockIdx.x);
    { pg8::Gemm g{(const bf16*)P.out, (const bf16*)(wl + WO_RT), NTOK, 256, D, nullptr, 0, HP}; pg8::EpiLogits E{(float*)(P.ws + WS_LG)};
      pg8::gemm_phase<pg8::EpiLogits, pg8::StaticOrder, true, true>(lds, g, S, E); }
    bf16* act = (bf16*)(P.ws + WS_ACT); int* route = (int*)(P.ws + WS_ROUTE); int* tcnt = (int*)(P.ws + WS_TCNT);
    const float* n2 = P.in[I_NORM2] + (size_t)l * D; const float* cb = P.in[I_MCB] + l * 4; const float* fbias = P.in[I_MFB] + l * 32;
    LAS float* rsl = (LAS float*)lds;
    f32x4 gn[4];
#pragma unroll
    for (int j = 0; j < 4; ++j) gn[j] = *((const f32x4*)n2 + lane + 64 * j);
    for (int ui = 0; ; ++ui) {
    pg8::Unit un; if (!S.next(ui, un)) break;
    const int tile = un.pm;
    if (tid < NEXP) hist[tid] = 0;
    { const int mb = tile * 256 + wave * 32; u32x2 va[4], vb[4];
#define RT_LOAD(V, mm) do { const u32x2* hr_ = (const u32x2*)((const bf16*)P.out + (size_t)(mm) * HP) + lane; _Pragma("unroll") for (int j = 0; j < 4; ++j) V[j] = hr_[64 * j]; } while (0)
#define RT_ROW(V, kk) do { f32x4 v[4]; float s_ = 0.f; \
        _Pragma("unroll") for (int j = 0; j < 4; ++j) { v[j] = (f32x4){bflo(V[j].x), bfhi(V[j].x), bflo(V[j].y), bfhi(V[j].y)}; s_ += (v[j].x * v[j].x + v[j].y * v[j].y) + (v[j].z * v[j].z + v[j].w * v[j].w); } \
        if ((kk) + 2 < 32) RT_LOAD(V, mb + (kk) + 2); \
        const float rstd = 1.f / sqrtf(wave_sum(s_) * (1.f / D) + 1e-6f); if (lane == 0) rsl[wave * 32 + (kk)] = rstd; \
        unsigned* o4 = (unsigned*)((unsigned char*)act + (size_t)(mb + (kk)) * D) + lane; \
        _Pragma("unroll") for (int j = 0; j < 4; ++j) { const f32x4 g = gn[j]; int w8 = 0; w8 = __builtin_amdgcn_cvt_pk_fp8_f32(pg8::sat8(v[j].x * rstd * g.x), pg8::sat8(v[j].y * rstd * g.y), w8, false); w8 = __builtin_amdgcn_cvt_pk_fp8_f32(pg8::sat8(v[j].z * rstd * g.z), pg8::sat8(v[j].w * rstd * g.w), w8, true); o4[64 * j] = (unsigned)w8; } } while (0)
      RT_LOAD(va, mb); RT_LOAD(vb, mb + 1);
#pragma unroll 1
      for (int k = 0; k < 32; k += 2) { RT_ROW(va, k); RT_ROW(vb, k + 1); }
#undef RT_LOAD
#undef RT_ROW
    }
    __syncthreads();
    if (tid < 256) { const int m = tile * 256 + tid; const float rstd = rsl[tid];
        const f32x4* lp = (const f32x4*)((const float*)(P.ws + WS_LG) + (size_t)m * 72); f32x4 q[18];
#pragma unroll
        for (int i = 0; i < 18; ++i) q[i] = lp[i];
        float L[36];
#pragma unroll
        for (int j = 0; j < 36; ++j) L[j] = (q[j >> 2][j & 3] + q[(36 + j) >> 2][(36 + j) & 3]) * rstd + (j < 4 ? cb[j] : fbias[j - 4]);
        const float c0 = L[0], c1 = L[1], c2 = L[2], c3 = L[3];
        int gs = 0; float cm = c0; if (c1 > cm) { cm = c1; gs = 1; } if (c2 > cm) { cm = c2; gs = 2; } if (c3 > cm) { cm = c3; gs = 3; }
        const float pg = 1.f / (expf(c0 - cm) + expf(c1 - cm) + expf(c2 - cm) + expf(c3 - cm));
        float fa[8];
#pragma unroll
        for (int i = 0; i < 8; ++i) fa[i] = (gs == 0) ? L[4 + i] : (gs == 1) ? L[12 + i] : (gs == 2) ? L[20 + i] : L[28 + i];
        int i0 = 0; float m0 = fa[0];
#pragma unroll
        for (int i = 1; i < 8; ++i) if (fa[i] > m0) { m0 = fa[i]; i0 = i; }
        int i1 = (i0 == 0) ? 1 : 0; float m1 = -3.0e38f;
#pragma unroll
        for (int i = 0; i < 8; ++i) if (i != i0 && fa[i] > m1) { m1 = fa[i]; i1 = i; }
        const float e1w = expf(m1 - m0), w0 = pg / (1.f + e1w), w1 = pg * e1w / (1.f + e1w);
        const int e0 = gs * 8 + i0, e1 = gs * 8 + i1;
        typedef int i32x4 __attribute__((ext_vector_type(4)));
        *(i32x4*)(route + (size_t)m * 8) = (i32x4){e0, e1, __builtin_bit_cast(int, w0), __builtin_bit_cast(int, w1)};
        lds_add(&hist[e0], 1); lds_add(&hist[e1], 1); }
    __syncthreads();
    if (tid < NEXP) { tcnt[tile * 32 + tid] = hist[tid]; atomicAdd((unsigned*)(P.ws + WS_CTL) + CW_CNT + l * 64 + tid, (unsigned)hist[tid]); }
    __syncthreads();
    }
}
__device__ __forceinline__ int build_tiles(const Params& P, int l, LAS unsigned char* ldsall, int tid) {
    LAS int* tile_e = (LAS int*)(ldsall + LDS_TILE_E); LAS int* misc = (LAS int*)(ldsall + LDS_MISC);
    LAS int* ntl = (LAS int*)(ldsall + LDS_MISC + 512);
    if (tid < NEXP) { const unsigned* cnt = (const unsigned*)(P.ws + WS_CTL) + CW_CNT + l * 64; const int c = (int)__hip_atomic_load(cnt + tid, __ATOMIC_RELAXED, __HIP_MEMORY_SCOPE_AGENT); ntl[tid] = (c + 255) >> 8; }
    __syncthreads();
    if (tid < NEXP) { int r = 0; for (int e = 0; e < tid; ++e) r += ntl[e];
        const int nt = ntl[tid]; r = r < MAXTILES ? r : MAXTILES; misc[1 + tid] = r * 256;
        for (int q = 0; q < nt && r + q < MAXTILES; ++q) tile_e[r + q] = tid;
        if (tid == NEXP - 1) misc[0] = (r + nt < MAXTILES) ? r + nt : MAXTILES; }
    __syncthreads();
    return misc[0];
}
__device__ __forceinline__ void ph_scatter(const Params& P, int l, LAS unsigned char* ldsall, int tid, int lane, int wave) {
    build_tiles(P, l, ldsall, tid);
    LAS int* misc = (LAS int*)(ldsall + LDS_MISC); LAS int* base = (LAS int*)ldsall; LAS int* EL = base + 32; LAS int* POS = EL + 512; LAS int* part = POS + 512;
    int* route = (int*)(P.ws + WS_ROUTE); const int* tcnt = (const int*)(P.ws + WS_TCNT); int* rowsrc = (int*)(P.ws + WS_TCNT + 65536);
    for (int tile = blockIdx.x; tile < NTOK / 256; tile += gridDim.x) {
        { const int e = tid & 31, q = tid >> 5; int c[16];
#pragma unroll
          for (int i = 0; i < 16; ++i) { const int t2 = q + 16 * i; c[i] = (t2 < tile) ? tcnt[t2 * 32 + e] : 0; }
          int s = 0;
#pragma unroll
          for (int i = 0; i < 16; ++i) s += c[i];
          part[q * 32 + e] = s; }
        int e0 = 0, e1 = 0; const size_t tok = (size_t)tile * 256 + tid;
        if (tid < 256) { e0 = route[tok * 8]; e1 = route[tok * 8 + 1]; EL[tid * 2] = e0; EL[tid * 2 + 1] = e1; }
        __syncthreads();
        if (tid < 32) { int s = misc[1 + tid]; for (int q = 0; q < 16; ++q) s += part[q * 32 + tid]; base[tid] = s; }
        __syncthreads();
        if (tid < 256) { int r0 = 0, r1 = 0;
            for (int i = 0; i < 2 * tid; ++i) { const int e = EL[i]; r0 += (e == e0); r1 += (e == e1); }
            const int p0 = base[e0] + r0, p1 = base[e1] + r1;
            route[tok * 8 + 4] = p0; route[tok * 8 + 5] = p1; rowsrc[p0] = (int)tok; rowsrc[p1] = (int)tok; }
        __syncthreads();
        __syncthreads();
    }
}
__device__ __forceinline__ void cb_load(const Params& P, const unsigned char* ys, int m, int p0, int p1, int lane, u32x2 (&h)[4], unsigned (&a)[4], unsigned (&b2)[4]) {
    const u32x2* hr = (const u32x2*)((const bf16*)P.out + (size_t)m * HP) + lane; const unsigned* y0 = (const unsigned*)(ys + (size_t)p0 * D) + lane; const unsigned* y1 = (const unsigned*)(ys + (size_t)p1 * D) + lane;
#pragma unroll
    for (int j = 0; j < 4; ++j) { h[j] = hr[64 * j]; a[j] = y0[64 * j]; b2[j] = y1[64 * j]; }
}
__device__ __forceinline__ void ph_combine(const Params& P, int l, int lane, int wave) {
    const unsigned char* ys = (const unsigned char*)(P.ws + WS_PROJ); bf16* act = (bf16*)(P.ws + WS_ACT); const int* route = (const int*)(P.ws + WS_ROUTE);
    const float* gain = (l + 1 < NL) ? P.in[I_NORM1] + (size_t)(l + 1) * D : P.in[I_FNW];
    f32x4 gn[4];
#pragma unroll
    for (int j = 0; j < 4; ++j) gn[j] = *((const f32x4*)gain + lane + 64 * j);
    for (int tile = blockIdx.x; tile < NTOK / 256; tile += gridDim.x) {
        const int mb = tile * 256 + wave * 32;
        const int* rp = route + (size_t)(mb + (lane & 31)) * 8; const int rw0 = rp[2], rw1 = rp[3], rp0 = rp[4], rp1 = rp[5];
        u32x2 nh[4]; unsigned na[4], nb[4];
        cb_load(P, ys, mb, __builtin_amdgcn_readlane(rp0, 0), __builtin_amdgcn_readlane(rp1, 0), lane, nh, na, nb);
#pragma unroll 1
        for (int k = 0; k < 32; ++k) {
            const int m = mb + k; f32x4 v[4]; unsigned a[4], b2[4];
#pragma unroll
            for (int j = 0; j < 4; ++j) { v[j] = (f32x4){bflo(nh[j].x), bfhi(nh[j].x), bflo(nh[j].y), bfhi(nh[j].y)}; a[j] = na[j]; b2[j] = nb[j]; }
            const float w0 = __builtin_bit_cast(float, __builtin_amdgcn_readlane(rw0, k)) * 0.0625f, w1 = __builtin_bit_cast(float, __builtin_amdgcn_readlane(rw1, k)) * 0.0625f;
            if (k + 1 < 32) cb_load(P, ys, m + 1, __builtin_amdgcn_readlane(rp0, k + 1), __builtin_amdgcn_readlane(rp1, k + 1), lane, nh, na, nb);
            float s2 = 0.f;
#pragma unroll
            for (int j = 0; j < 4; ++j) { const f32x2 a01 = __builtin_amdgcn_cvt_pk_f32_fp8((int)a[j], false), a23 = __builtin_amdgcn_cvt_pk_f32_fp8((int)a[j], true), b01 = __builtin_amdgcn_cvt_pk_f32_fp8((int)b2[j], false), b23 = __builtin_amdgcn_cvt_pk_f32_fp8((int)b2[j], true);
                v[j].x += w0 * a01[0] + w1 * b01[0]; v[j].y += w0 * a01[1] + w1 * b01[1]; v[j].z += w0 * a23[0] + w1 * b23[0]; v[j].w += w0 * a23[1] + w1 * b23[1];
                s2 += (v[j].x * v[j].x + v[j].y * v[j].y) + (v[j].z * v[j].z + v[j].w * v[j].w); }
            const float rstd = 1.f / sqrtf(wave_sum(s2) * (1.f / D) + 1e-6f);
            f32x4* hr = (f32x4*)(P.out + (size_t)m * D) + lane;
            if (l + 1 < NL) { u32x2* o8 = (u32x2*)(act + (size_t)m * D) + lane; u32x2* hb = (u32x2*)((bf16*)P.out + (size_t)m * HP) + lane;
#pragma unroll
                for (int j = 0; j < 4; ++j) { u32x2 hw; hw.x = cvt2(v[j].x, v[j].y); hw.y = cvt2(v[j].z, v[j].w); hb[64 * j] = hw; u32x2 w; w.x = cvt2(v[j].x * rstd * gn[j].x, v[j].y * rstd * gn[j].y); w.y = cvt2(v[j].z * rstd * gn[j].z, v[j].w * rstd * gn[j].w); o8[64 * j] = w; }
            } else {
#pragma unroll
                for (int j = 0; j < 4; ++j) { f32x4 o; o.x = v[j].x * rstd * gn[j].x; o.y = v[j].y * rstd * gn[j].y; o.z = v[j].z * rstd * gn[j].z; o.w = v[j].w * rstd * gn[j].w; hr[64 * j] = o; }
            }
        }
    }
}

#ifndef MK_ONE_LAUNCH
#define MK_ONE_LAUNCH 1
#endif
constexpr int PH_PER_LAYER = 10, N_PHASES = 1 + NL * PH_PER_LAYER;
#ifndef PH_MASK
#ifdef DBG_NOMOE
#define PH_MASK 0x61f
#else
#define PH_MASK 0x7ff
#endif
#endif
#define PHE(j) (((PH_MASK) >> (j)) & 1)
#ifndef DUP_MASK
#define DUP_MASK 0
#endif
#define NREP(j) ((((DUP_MASK) >> (j)) & 1) ? 2 : 1)
#if MK_ONE_LAUNCH
#define GRID_BAR() xcd_barrier(bar)
#else
#define GRID_BAR() do {} while (0)
#endif
#define IN(k) (lo <= (k) && (k) < hi)
#define SEAM(k) do { if (IN(k) && IN((k) + 1)) GRID_BAR(); } while (0)
#ifndef DUP_ROLE
#define DUP_ROLE 0
#endif
#ifndef DUP_N
#define DUP_N 1
#endif
#define MIXBODY() do { \
            const int u_ = blockIdx.x; \
            if (u_ < 32) rwkv_consumer(P, l, u_ >> 2, u_ & 3, lds, tid, lane, wave); \
            else if (u_ < 64) role_hgrn(P, l, (u_ - 32) >> 2, u_ & 3, lds, tid, lane, wave); \
            else if (u_ < 96) { role_lru(P, l, (u_ - 64) >> 2, u_ & 3, lds, tid, lane, wave); __syncthreads(); rwkv_producer(P, l, u_ & 3, 40 + ((u_ - 64) >> 2), 40, lds, tid, lane, wave); } \
            else { rwkv_producer(P, l, (u_ - 96) & 3, (u_ - 96) >> 2, 40, lds, tid, lane, wave);        \
                   if (u_ < 224) { __syncthreads(); role_s5(P, l, (u_ - 96) >> 4, (u_ - 96) & 15, lds, tid, lane, wave); } } \
} while (0)
template <int l> __device__ __forceinline__ void layer_phases(const Params& P, LAS unsigned char* lds, const XcdBarrier& bar, int tid, int lane, int wave, int lo, int hi) {
        const int pb = 1 + l * PH_PER_LAYER;
        const unsigned char* wl = P.ws + WS_W + (size_t)l * WL_STRIDE;
        if (PHE(0) && IN(pb + 0)) {
            pg8::Gemm g{(const bf16*)(P.ws + WS_ACT), (const bf16*)(wl + WO_IN), NTOK, DIN, D}; pg8::StaticOrder S; S.init(NTOK / 256, DIN / 256, gridDim.x, blockIdx.x);
            pg8::EpiBf16 E{(bf16*)(P.ws + WS_PROJ), DIN};
            pg8::gemm_phase<pg8::EpiBf16, pg8::StaticOrder, true, true>(lds, g, S, E);
        } SEAM(pb + 0);
        if (PHE(1) && IN(pb + 1)) {
            MIXBODY();
            if (NREP(1) == 2) { GRID_BAR(); MIXBODY(); }
        } SEAM(pb + 1);
        if (PHE(2) && IN(pb + 2)) {
            pg8::EpiGated<1> E{(bf16*)(P.ws + WS_MIX) + 256, D};
            {   const int tile = blockIdx.x;
                pg8::Gemm g{(const bf16*)(P.ws + WS_YG), (const bf16*)(wl + WO_GLU), NTOK, 512, 256}; pg8::OwnOrder S{tile, 2};
                pg8::gemm_phase<pg8::EpiGated<1>, pg8::OwnOrder, true, true>(lds, g, S, E);
                if (PHE(3)) ph_fin(P, l, lane, wave, tile * 256 + wave * 32, 4, tile * 256 + wave * 32 + 32);
            }
        } SEAM(pb + 3);
        if (PHE(4) && IN(pb + 4)) {
            pg8::Gemm g{(const bf16*)(P.ws + WS_ACT), (const bf16*)(wl + WO_OUT), NTOK, D, D}; pg8::StaticOrder S; S.init(NTOK / 256, D / 256, gridDim.x, blockIdx.x);
            if (l == 0) { pg8::EpiResB<true> E{(bf16*)P.out, (const void*)P.in[I_X], HP, D}; pg8::gemm_phase<pg8::EpiResB<true>, pg8::StaticOrder, true, true>(lds, g, S, E); }
            else { pg8::EpiResB<false> E{(bf16*)P.out, (const void*)P.out, HP, HP}; pg8::gemm_phase<pg8::EpiResB<false>, pg8::StaticOrder, true, true>(lds, g, S, E); }
        } SEAM(pb + 4);
        if (PHE(5) && IN(pb + 5)) { ph_route(P, l, lds, tid, lane, wave); } SEAM(pb + 5);
        if (PHE(6) && IN(pb + 6)) { ph_scatter(P, l, lds, tid, lane, wave); } SEAM(pb + 6);
        if (PHE(7) && IN(pb + 7)) {
            const int R = build_tiles(P, l, lds, tid);
            pg8::Gemm g{(const bf16*)(P.ws + WS_ACT), (const bf16*)(wl + WO_GU), SROWS, D, D / 2  , (const int*)(P.ws + WS_TCNT + 65536), NTOK}; pg8::StaticOrder S; S.init(R, 4, gridDim.x, blockIdx.x);
            S.tile_e = (const LAS int*)(lds + LDS_TILE_E); S.estride = (size_t)D * D;
            pg8::EpiGatedF8 E{(unsigned char*)(P.ws + WS_MIX), DEXP};
            pg8::gemm_phase<pg8::EpiGatedF8, pg8::StaticOrder, true, true, true, true>(lds, g, S, E);
        } SEAM(pb + 7);
        if (PHE(8) && IN(pb + 8)) {
            const int R = build_tiles(P, l, lds, tid);
            pg8::Gemm g{(const bf16*)(P.ws + WS_MIX), (const bf16*)(wl + WO_DN), SROWS, D, DEXP / 2  }; pg8::StaticOrder S; S.init(R, 4, gridDim.x, blockIdx.x);
            S.tile_e = (const LAS int*)(lds + LDS_TILE_E); S.estride = (size_t)D * DEXP;
            pg8::EpiF8 E{(unsigned char*)(P.ws + WS_PROJ), D, 16.f};
            pg8::gemm_phase<pg8::EpiF8, pg8::StaticOrder, true, true, false, true>(lds, g, S, E);
        } SEAM(pb + 8);
        if (PHE(9) && IN(pb + 9)) { ph_combine(P, l, lane, wave); } SEAM(pb + 9);
    }
__global__ void __launch_bounds__(NTHR, 2) fwd_kernel(Params P) {
    extern __shared__ __attribute__((aligned(16))) unsigned char lds_raw[];
    LAS unsigned char* lds = (LAS unsigned char*)lds_raw;
    const int tid = threadIdx.x, lane = tid & 63, wave = __builtin_amdgcn_readfirstlane(tid >> 6);
    if (tid < 16) ((LAS unsigned*)(lds + LDSCTL_OFF))[tid] = 0u;
    __syncthreads();
#if MK_ONE_LAUNCH
    XcdBarrier bar = xcd_barrier_post((unsigned*)(P.ws + WS_CTL) + CW_BAR, (volatile LAS unsigned*)(lds + LDSCTL_OFF));
#else
    XcdBarrier bar; bar.bar = nullptr; bar.x = 0; bar.st = nullptr;
#endif
    const int lo = P.ph_lo, hi = P.ph_hi;
    if (PHE(10) && IN(0)) { ph_prologue(P, lds, tid, lane, wave); } SEAM(0);
    layer_phases<0>(P, lds, bar, tid, lane, wave, lo, hi);
    layer_phases<1>(P, lds, bar, tid, lane, wave, lo, hi);
}
#undef IN
#undef SEAM

extern "C" void kernel_launch(void* const* d_in, const int* in_sizes, int n_in, void* d_out, int out_size, void* d_ws, size_t ws_size, hipStream_t stream) {
    static int grid = 0;
    if (grid == 0) {
        if (n_in != 46 || out_size != NTOK * D || ws_size < WS_END) { fprintf(stderr, "kernel_launch: unexpected sizes n_in %d out %d ws %zu\n", n_in, out_size, ws_size); grid = -1; return; }
        int dev = 0, cus = 0;
        if (hipGetDevice(&dev) != hipSuccess || hipDeviceGetAttribute(&cus, hipDeviceAttributeMultiprocessorCount, dev) != hipSuccess) { grid = -1; return; }
        if (hipFuncSetAttribute((const void*)fwd_kernel, hipFuncAttributeMaxDynamicSharedMemorySize, LDS_BYTES) != hipSuccess) { grid = -1; return; }
        int per_cu = 0;
        if (hipOccupancyMaxActiveBlocksPerMultiprocessor(&per_cu, (const void*)fwd_kernel, NTHR, LDS_BYTES) != hipSuccess || per_cu < 1) { fprintf(stderr, "kernel_launch: occupancy query says %d\n", per_cu); }
        (void)hipGetLastError();
        (void)cus; grid = 256;
    }
    if (grid < 0) return;
    if (hipMemsetAsync((char*)d_ws + WS_CTL, 0, CTL_ZERO_BYTES, stream) != hipSuccess) return;
    Params p; memset(&p, 0, sizeof(p));
    for (int i = 0; i < 46; ++i) p.in[i] = (const float*)d_in[i];
    p.out = (float*)d_out; p.ws = (unsigned char*)d_ws;
#if MK_ONE_LAUNCH
    p.ph_lo = 0; p.ph_hi = N_PHASES;
    hipLaunchKernelGGL(fwd_kernel, dim3(grid), dim3(NTHR), LDS_BYTES, stream, p);
#else
    for (int k = 0; k < N_PHASES; ++k) { p.ph_lo = k; p.ph_hi = k + 1; hipLaunchKernelGGL(fwd_kernel, dim3(grid), dim3(NTHR), LDS_BYTES, stream, p); }
#endif
}
```
